# Optimizing an MI355X kernel written in HIP

```python
import jax, jax.numpy as jnp
from jax import lax
import numpy as np

D_MODEL = 1024
BATCH = 2
SEQ = 8192
DEPTH = 2

HEAD_DIM = 64
ATTN_WIDTH = D_MODEL // 2
ATTN_HEADS = ATTN_WIDTH // HEAD_DIM
DILATED_PATTERNS = ((128, 1), (512, 4), (2048, 16))
ROPE_THETA = 10000.0
POOL_WINDOWS = (2, 4, 8, 16)
POOL_WIDTH = D_MODEL // 4
POOL_GROUP = POOL_WIDTH // len(POOL_WINDOWS)
MEM_WIDTH = D_MODEL // 4
MEM_HEADS = 4
MEM_HEAD_DIM = MEM_WIDTH // MEM_HEADS
N_MEM = 256
MIX_WIDTH = ATTN_WIDTH + POOL_WIDTH + MEM_WIDTH
IN_COLS = 3 * ATTN_WIDTH + POOL_WIDTH + MEM_WIDTH
N_EXPERTS = 32
TOP_K = 4
D_EXPERT = D_MODEL
SWIGLU_ALPHA = 1.702
SWIGLU_LIMIT = 7.0
MOE_BLOCK = 256
NORM_EPS = 1e-5
NEG_INF = -1e30

kernel_name = 'hybrid_dilated_pool_memory_moe_encoder'


def rms_norm(x, g):
    x32 = x.astype(jnp.float32)
    y = x32 * lax.rsqrt(jnp.mean(x32 * x32, axis=-1, keepdims=True) + NORM_EPS)
    return (y * g.astype(jnp.float32)).astype(x.dtype)


def rope_tables(seq):
    half = HEAD_DIM // 2
    inv_freq = ROPE_THETA ** (-jnp.arange(half, dtype=jnp.float32) / half)
    ang = jnp.arange(seq, dtype=jnp.float32)[:, None] * inv_freq[None, :]
    return jnp.cos(ang), jnp.sin(ang)


def apply_rope(t, cos, sin):
    half = t.shape[-1] // 2
    t32 = t.astype(jnp.float32)
    t1, t2 = t32[..., :half], t32[..., half:]
    c, s = cos[None, :, None, :], sin[None, :, None, :]
    return jnp.concatenate([t1 * c - t2 * s, t1 * s + t2 * c], axis=-1).astype(t.dtype)


def dilated_window_attention(q, k, v, window, dilation):
    B, S, H, hd = q.shape
    half = (window // 2) // dilation
    L = S // dilation
    nb = -(-L // half)
    Lp = nb * half

    def split(t):
        return t.reshape(B, L, dilation, H, hd).transpose(0, 2, 3, 1, 4).astype(jnp.float32)

    qs, ks, vs = split(q), split(k), split(v)
    qb = jnp.pad(qs, ((0, 0), (0, 0), (0, 0), (0, Lp - L), (0, 0))).reshape(B, dilation, H, nb, half, hd)
    kv_pad = ((0, 0), (0, 0), (0, 0), (half, Lp - L + half), (0, 0))
    ks = jnp.pad(ks, kv_pad).reshape(B, dilation, H, nb + 2, half, hd)
    vs = jnp.pad(vs, kv_pad).reshape(B, dilation, H, nb + 2, half, hd)
    kb = jnp.concatenate([ks[:, :, :, 0:nb], ks[:, :, :, 1:nb + 1], ks[:, :, :, 2:nb + 2]], axis=4)
    vb = jnp.concatenate([vs[:, :, :, 0:nb], vs[:, :, :, 1:nb + 1], vs[:, :, :, 2:nb + 2]], axis=4)

    scores = jnp.einsum('bdhnqe,bdhnke->bdhnqk', qb, kb) * (hd ** -0.5)
    r = jnp.arange(half)[:, None]
    c = jnp.arange(3 * half)[None, :]
    rel = c - half - r
    key_idx = jnp.arange(nb)[:, None, None] * half + c[None] - half
    valid = (jnp.abs(rel)[None] <= half) & (key_idx >= 0) & (key_idx < L)
    scores = jnp.where(valid, scores, NEG_INF)
    m = jnp.max(scores, axis=-1, keepdims=True)
    p = jnp.exp(scores - m)
    den = jnp.sum(p, axis=-1, keepdims=True)
    out = jnp.einsum('bdhnqk,bdhnke->bdhnqe', p, vb) / den
    lse = (m + jnp.log(den))[..., 0]

    out = out.reshape(B, dilation, H, Lp, hd)[:, :, :, :L].transpose(0, 3, 1, 2, 4).reshape(B, S, H, hd)
    lse = lse.reshape(B, dilation, H, Lp)[..., :L].transpose(0, 3, 1, 2).reshape(B, S, H)
    return out, lse


def dilated_mixture(q, k, v):
    outs, lses = [], []
    for window, dilation in DILATED_PATTERNS:
        o, l = dilated_window_attention(q, k, v, window, dilation)
        outs.append(o)
        lses.append(l)
    wts = jax.nn.softmax(jnp.stack(lses, axis=0), axis=0)
    return jnp.sum(wts[..., None] * jnp.stack(outs, axis=0), axis=0)


def multiscale_pool(u, pool_w, pool_scale):
    B, S, C = u.shape
    u32 = u.astype(jnp.float32)
    cs = jnp.pad(jnp.cumsum(u32, axis=1), ((0, 0), (1, 0), (0, 0)))
    pos = jnp.arange(S)
    diffs = []
    for g, w in enumerate(POOL_WINDOWS):
        left, right = w // 2, w - 1 - w // 2
        lo = jnp.maximum(pos - left, 0)
        hi = jnp.minimum(pos + right, S - 1) + 1
        seg = cs[..., g * POOL_GROUP:(g + 1) * POOL_GROUP]
        mean = (seg[:, hi] - seg[:, lo]) / (hi - lo).astype(jnp.float32)[None, :, None]
        diffs.append(mean - u32[..., g * POOL_GROUP:(g + 1) * POOL_GROUP])
    d = jnp.stack(diffs, axis=2)
    y = jnp.einsum('bsgc,gcd->bsgd', d, pool_w.astype(jnp.float32)).reshape(B, S, C)
    return (y * pool_scale.astype(jnp.float32)).astype(u.dtype)


def memory_attention(q, mem, mem_norm_g, w_mem_kv):
    B, S, H, hd = q.shape
    n_mem = mem.shape[1]
    kv = rms_norm(mem, mem_norm_g) @ w_mem_kv
    k = kv[..., :MEM_WIDTH].reshape(B, n_mem, H, hd).astype(jnp.float32)
    v = kv[..., MEM_WIDTH:].reshape(B, n_mem, H, hd).astype(jnp.float32)
    s = jnp.einsum('bshe,bmhe->bhsm', q.astype(jnp.float32), k) * (hd ** -0.5)
    p = jax.nn.softmax(s, axis=-1)
    o = jnp.einsum('bhsm,bmhe->bshe', p, v)
    return o.reshape(B, S, H * hd).astype(q.dtype)


def parallel_mixers(h, mem, w_in, pool_w, pool_scale, mem_norm_g, w_mem_kv, grp_norm_g, w_out, cos, sin):
    B, S, _ = h.shape
    a, p = ATTN_WIDTH, POOL_WIDTH
    proj = h @ w_in
    q_a = apply_rope(proj[..., 0:a].reshape(B, S, ATTN_HEADS, HEAD_DIM), cos, sin)
    k_a = apply_rope(proj[..., a:2 * a].reshape(B, S, ATTN_HEADS, HEAD_DIM), cos, sin)
    v_a = proj[..., 2 * a:3 * a].reshape(B, S, ATTN_HEADS, HEAD_DIM)
    u_p = proj[..., 3 * a:3 * a + p]
    q_m = proj[..., 3 * a + p:].reshape(B, S, MEM_HEADS, MEM_HEAD_DIM)

    y_a = dilated_mixture(q_a, k_a, v_a).reshape(B, S, a).astype(h.dtype)
    y_p = multiscale_pool(u_p, pool_w, pool_scale)
    y_m = memory_attention(q_m, mem, mem_norm_g, w_mem_kv)
    y = jnp.concatenate([rms_norm(y_a, grp_norm_g[:a]),
                         rms_norm(y_p, grp_norm_g[a:a + p]),
                         rms_norm(y_m, grp_norm_g[a + p:])], axis=-1)
    return y @ w_out


def moe_ffn(h, router_w, router_b, w_gu, b_gu, w_down, b_down):
    B, S, D = h.shape
    T = B * S
    xt = h.reshape(T, D)
    logits = (xt @ router_w + router_b).astype(jnp.float32)
    top_val, top_idx = lax.top_k(logits, TOP_K)
    gates = jax.nn.softmax(top_val, axis=-1)

    n_assign = T * TOP_K
    flat_e = top_idx.reshape(-1)
    flat_tok = jnp.arange(n_assign, dtype=jnp.int32) // TOP_K
    order = jnp.argsort(flat_e, stable=True)
    e_sorted = flat_e[order]
    tok_sorted = flat_tok[order]
    gate_sorted = gates.reshape(-1)[order]

    counts = jnp.bincount(flat_e, length=N_EXPERTS)
    padded = (counts + MOE_BLOCK - 1) // MOE_BLOCK * MOE_BLOCK
    pad_end = jnp.cumsum(padded)
    pad_start = pad_end - padded
    start = jnp.cumsum(counts) - counts
    dest = pad_start[e_sorted] + jnp.arange(n_assign, dtype=jnp.int32) - start[e_sorted]
    n_blocks = -(-n_assign // MOE_BLOCK) + N_EXPERTS
    slot_tok = jnp.zeros((n_blocks * MOE_BLOCK,), jnp.int32).at[dest].set(tok_sorted)
    block_e = jnp.minimum(jnp.searchsorted(pad_end, jnp.arange(n_blocks) * MOE_BLOCK, side='right'), N_EXPERTS - 1)

    def expert_block(args):
        tok, e = args
        gu = xt[tok] @ w_gu[e] + b_gu[e]
        gate = jnp.minimum(gu[:, :D_EXPERT], SWIGLU_LIMIT)
        up = jnp.clip(gu[:, D_EXPERT:], -SWIGLU_LIMIT, SWIGLU_LIMIT)
        act = (up + 1) * gate * jax.nn.sigmoid(SWIGLU_ALPHA * gate)
        return act @ w_down[e] + b_down[e]

    y_slots = lax.map(expert_block, (slot_tok.reshape(n_blocks, MOE_BLOCK), block_e)).reshape(-1, D)
    y = y_slots[dest] * gate_sorted[:, None].astype(y_slots.dtype)
    return jax.ops.segment_sum(y, tok_sorted, num_segments=T).reshape(B, S, D)


def setup_inputs(seed: int = 0) -> dict:
    key = jax.random.key(seed)
    ks = jax.random.split(key, 18)
    f32 = jnp.float32

    def nrm(k, shape, scale):
        return jax.random.normal(k, shape, f32) * scale

    def gain(k, shape):
        return 1.0 + 0.02 * jax.random.normal(k, shape, f32)

    return {
        'x': nrm(ks[0], (BATCH, SEQ, D_MODEL), 1.0),
        'mem': nrm(ks[1], (BATCH, N_MEM, D_MODEL), 1.0),
        'norm1_g': gain(ks[2], (DEPTH, D_MODEL)),
        'w_in': nrm(ks[3], (DEPTH, D_MODEL, IN_COLS), D_MODEL ** -0.5),
        'pool_w': nrm(ks[4], (DEPTH, len(POOL_WINDOWS), POOL_GROUP, POOL_GROUP), POOL_GROUP ** -0.5),
        'pool_scale': gain(ks[5], (DEPTH, POOL_WIDTH)),
        'mem_norm_g': gain(ks[6], (DEPTH, D_MODEL)),
        'w_mem_kv': nrm(ks[7], (DEPTH, D_MODEL, 2 * MEM_WIDTH), D_MODEL ** -0.5),
        'grp_norm_g': gain(ks[8], (DEPTH, MIX_WIDTH)),
        'w_out': nrm(ks[9], (DEPTH, MIX_WIDTH, D_MODEL), MIX_WIDTH ** -0.5),
        'norm2_g': gain(ks[10], (DEPTH, D_MODEL)),
        'router_w': nrm(ks[11], (DEPTH, D_MODEL, N_EXPERTS), D_MODEL ** -0.5),
        'router_b': nrm(ks[12], (DEPTH, N_EXPERTS), 0.01),
        'w_gu': nrm(ks[13], (DEPTH, N_EXPERTS, D_MODEL, 2 * D_EXPERT), D_MODEL ** -0.5),
        'b_gu': nrm(ks[14], (DEPTH, N_EXPERTS, 2 * D_EXPERT), 0.01),
        'w_down': nrm(ks[15], (DEPTH, N_EXPERTS, D_EXPERT, D_MODEL), D_EXPERT ** -0.5),
        'b_down': nrm(ks[16], (DEPTH, N_EXPERTS, D_MODEL), 0.01),
        'final_g': gain(ks[17], (D_MODEL,)),
    }


def reference(x, mem, norm1_g, w_in, pool_w, pool_scale, mem_norm_g, w_mem_kv, grp_norm_g, w_out,
              norm2_g, router_w, router_b, w_gu, b_gu, w_down, b_down, final_g):
    cos, sin = rope_tables(x.shape[1])
    for l in range(DEPTH):
        h = rms_norm(x, norm1_g[l])
        x = x + parallel_mixers(h, mem, w_in[l], pool_w[l], pool_scale[l], mem_norm_g[l], w_mem_kv[l],
                                grp_norm_g[l], w_out[l], cos, sin)
        h = rms_norm(x, norm2_g[l])
        x = x + moe_ffn(h, router_w[l], router_b[l], w_gu[l], b_gu[l], w_down[l], b_down[l])
    return rms_norm(x, final_g)
```

```cpp
#include <hip/hip_runtime.h>
#include <hip/hip_cooperative_groups.h>
#include <cstdio>
#include <cstdint>
namespace cg = cooperative_groups;

#ifndef MK_ONE_LAUNCH
#define MK_ONE_LAUNCH 1
#endif

#define LAS __attribute__((address_space(3)))
typedef unsigned short bf16_t;
typedef short bf16x8 __attribute__((ext_vector_type(8)));
typedef short s16x4 __attribute__((ext_vector_type(4)));
typedef float f32x4 __attribute__((ext_vector_type(4)));
typedef float f32x2 __attribute__((ext_vector_type(2)));
typedef float f32x16 __attribute__((ext_vector_type(16)));
typedef unsigned u32x4 __attribute__((ext_vector_type(4)));
typedef unsigned u32x2 __attribute__((ext_vector_type(2)));

constexpr int BATCH = 2, SEQ = 8192, TOK = BATCH * SEQ, DM = 1024, NIN = 2048, NE = 32, TOPK = 4, NMEM = 256, DEPTH = 2;
constexpr float EPS = 1e-5f;
constexpr float QSCALE = 0.125f * 1.4426950408889634f;
constexpr int MAXT = 288;
constexpr float W8SCALE = 32.0f;

constexpr size_t MiB = 1u << 20;
constexpr size_t WS_CTL = 0, CTL_BYTES = 64 * 1024;
constexpr size_t WS_COS = 1 * MiB, WS_SIN = 2 * MiB;
constexpr size_t WS_WIN = 4 * MiB;
constexpr size_t WS_WOUT = 12 * MiB;
constexpr size_t WS_WMKV = 16 * MiB;
constexpr size_t WS_MEMKV = 18 * MiB;
constexpr size_t WS_MEMN = 20 * MiB;
constexpr size_t WS_RT = 22 * MiB;
constexpr size_t WS_LSE = 24 * MiB;
constexpr size_t WS_WGU = 32 * MiB;
constexpr size_t WS_WDN = 288 * MiB;
constexpr size_t WS_XN = 416 * MiB;
constexpr size_t WS_PROJ = 448 * MiB;
constexpr size_t WS_AO = 512 * MiB;
constexpr size_t WS_YRAW = 560 * MiB;
constexpr size_t WS_Y = 576 * MiB;
constexpr size_t WS_X1 = 608 * MiB;
constexpr size_t WS_X2 = 672 * MiB;
constexpr size_t WS_H2 = 736 * MiB;
constexpr size_t WS_ASLOT = 768 * MiB;
constexpr size_t WS_ACT = 912 * MiB;
constexpr size_t WS_YS = 1056 * MiB;
constexpr size_t WS_QKVH = 1200 * MiB;
constexpr size_t WS_ELIST = 1248 * MiB;
constexpr size_t WS_END = 1252 * MiB;
constexpr int CW_CNT = 1024;
constexpr int CW_BAR = 4096;
constexpr int CW_W8NEXT = 2048;
constexpr int CW_DONE = 2112;

constexpr int RING_BYTES = 131072, MISC_OFF = RING_BYTES, LDS_BYTES = 147456;

__device__ __forceinline__ unsigned cvtpk(float lo, float hi) { typedef __bf16 bf2 __attribute__((ext_vector_type(2))); f32x2 v = {lo, hi}; bf2 b = __builtin_convertvector(v, bf2); return __builtin_bit_cast(unsigned, b); }
__device__ __forceinline__ float bflo(unsigned u) { return __uint_as_float(u << 16); }
__device__ __forceinline__ float bfhi(unsigned u) { return __uint_as_float(u & 0xffff0000u); }
__device__ __forceinline__ float bf1(bf16_t u) { return __uint_as_float(((unsigned)u) << 16); }
__device__ __forceinline__ bf16_t f2bf(float f) { return (bf16_t)(cvtpk(f, 0.f) & 0xffffu); }
template <int M> __device__ __forceinline__ int swz_i(int v) { constexpr int ctrl = (M == 1) ? 0xB1 : (M == 2) ? 0x4E : (M == 4) ? 0x141 : 0x140; static_assert(M == 1 || M == 2 || M == 4 || M == 8, "dpp step");
    return __builtin_amdgcn_update_dpp(v, v, ctrl, 0xf, 0xf, true); }
template <int M> __device__ __forceinline__ float swz_f(float v) { return __int_as_float(swz_i<M>(__float_as_int(v))); }
__device__ __forceinline__ float xor16_sum(float v) { auto r = __builtin_amdgcn_permlane16_swap(__float_as_uint(v), __float_as_uint(v), false, false); return __uint_as_float(r[0]) + __uint_as_float(r[1]); }
__device__ __forceinline__ float xor32_sum(float v) { auto r = __builtin_amdgcn_permlane32_swap(__float_as_uint(v), __float_as_uint(v), false, false); return __uint_as_float(r[0]) + __uint_as_float(r[1]); }
__device__ __forceinline__ float xor32_max(float v) { auto r = __builtin_amdgcn_permlane32_swap(__float_as_uint(v), __float_as_uint(v), false, false); return fmaxf(__uint_as_float(r[0]), __uint_as_float(r[1])); }
__device__ __forceinline__ float wave_sum(float v) {
    v += swz_f<1>(v); v += swz_f<2>(v); v += swz_f<4>(v); v += swz_f<8>(v);
    return xor32_sum(xor16_sum(v));
}
#define LDS_WAIT() asm volatile("s_waitcnt lgkmcnt(0)" ::: "memory")

namespace pg8 {
typedef int i32x4_t __attribute__((ext_vector_type(4)));
typedef int i32x8_t __attribute__((ext_vector_type(8)));
constexpr int BM = 256, BK = 64, HALF = 128, HTB = HALF * BK * 2, STAGE_BYTES = 8 * HTB, NXCD = 8, WGM = 8;
__host__ __device__ __forceinline__ int lds_byte(int r, int c) { const int st = (r >> 4) * 2 + (c >> 5), rr = r & 15, cc = c & 31, ob = rr * 64 + cc * 2; return st * 1024 + (ob ^ (((ob >> 9) & 1) << 5)); }
__host__ __device__ __forceinline__ void stage_rc(int b, int& R, int& C) { const int st = b / 1024, sb = b % 1024, swz = sb ^ (((sb >> 9) & 1) << 5); R = (st >> 1) * 16 + swz / 64; C = (st & 1) * 32 + (swz % 64) / 2; }
__host__ __device__ __forceinline__ int perm32(int rho) { const int n = rho >> 4, i = rho & 15; return 8 * (i >> 2) + 4 * n + (i & 3); }

struct Unit { int pm, pn, e; };
struct Gemm { const bf16_t* A; const bf16_t* Bt; int K; size_t ebytes; const LAS int* gtok; };

struct StaticOrder {
    int nM, nN, nwg, G, c;
    __device__ void init(int M, int N, int G_, int c_) { nM = M / BM; nN = N / BM; nwg = nM * nN; G = G_; c = c_; }
    __device__ bool next(int i, Unit& u) const {
        const long L = (long)i * G + c; if (L >= nwg) return false;
        int wgid = (int)L; { const int q = nwg / NXCD, r = nwg % NXCD, xcd = wgid % NXCD, off = wgid / NXCD; wgid = (xcd < r ? xcd * (q + 1) : r * (q + 1) + (xcd - r) * q) + off; }
        const int nig = WGM * nN, gid = wgid / nig, fm = gid * WGM, gsz = (nM - fm) < WGM ? (nM - fm) : WGM;
        u.pm = fm + ((wgid % nig) % gsz); u.pn = (wgid % nig) / gsz; u.e = 0; return true;
    }
};
struct MoeOrder {
    const LAS int* tstart; int nN, GM, G, c;
    __device__ bool next(int i, Unit& u) const {
        const int total = tstart[32] * nN; const long L = (long)i * G + c; if (L >= total) return false;
        const int pmL = (int)L / nN; int e = 0;
#pragma unroll
        for (int k = 1; k < 32; ++k) e += (tstart[k] <= pmL) ? 1 : 0;
        const int t0 = tstart[e], mt = tstart[e + 1] - t0, w = (int)L - t0 * nN;
        const int grp = w / (GM * nN), wg = w - grp * GM * nN, rem = mt - grp * GM, gsz = rem < GM ? rem : GM;
        u.pm = __builtin_amdgcn_readfirstlane(t0 + grp * GM + wg % gsz); u.pn = __builtin_amdgcn_readfirstlane(wg / gsz); u.e = __builtin_amdgcn_readfirstlane(e); return true;
    }
};


__device__ __forceinline__ u32x4 pair16(u32x2 a, u32x2 b) {
    const auto rx = __builtin_amdgcn_permlane16_swap(a.x, b.x, false, false); const auto ry = __builtin_amdgcn_permlane16_swap(a.y, b.y, false, false);
    return (u32x4){rx[0], ry[0], rx[1], ry[1]};
}
struct EpiProj {
    static constexpr bool PERM = true, AFTER_DRAIN = false;
    bf16_t* O; const float* cs; const float* sn; bf16_t* QH;
    __device__ __forceinline__ void operator()(const f32x4 (&acc)[2][2][4][2], const Unit& u, int wr, int wc, int fr, int fq) const {
        const int row0 = u.pm * BM + wr * 64 + fr, colb = u.pn * BM + wc * 32 + 8 * fq;
        if (u.pn < 4) {
            const float sc = (u.pn < 2) ? QSCALE : 1.f;
#pragma unroll
            for (int ai = 0; ai < 2; ++ai) {
                f32x4 cv[4][2], sv[4][2];
#pragma unroll
                for (int m = 0; m < 4; ++m) { const int pos = (row0 + ai * HALF + m * 16) & (SEQ - 1);
#pragma unroll
                    for (int bj = 0; bj < 2; ++bj) { const int g8 = ((colb + bj * HALF) & 63) >> 3; cv[m][bj] = *(const f32x4*)(cs + pos * 32 + g8 * 4); sv[m][bj] = *(const f32x4*)(sn + pos * 32 + g8 * 4); } }
#pragma unroll
                for (int mp = 0; mp < 2; ++mp)
#pragma unroll
                    for (int bj = 0; bj < 2; ++bj) { const int col = colb + bj * HALF, head = col >> 6, g8 = (col & 63) >> 3;
                        u32x2 w1[2], w2[2];
#pragma unroll
                        for (int q = 0; q < 2; ++q) { const int m = 2 * mp + q; const f32x4 c = cv[m][bj], s = sv[m][bj];
                            const f32x4 t1 = acc[ai][bj][m][0], t2 = acc[ai][bj][m][1];
                            const f32x4 o1 = (t1 * c - t2 * s) * sc, o2 = (t1 * s + t2 * c) * sc;
                            w1[q].x = cvtpk(o1[0], o1[1]); w1[q].y = cvtpk(o1[2], o1[3]); w2[q].x = cvtpk(o2[0], o2[1]); w2[q].y = cvtpk(o2[2], o2[3]); }
                        const int msel = 2 * mp + (fq & 1), row = row0 + ai * HALF + msel * 16, pos = row & (SEQ - 1);
                        bf16_t* p = QH + ((size_t)((((head >> 3) * 2 + (row >> 13)) * 8 + (head & 7))) * SEQ + pos) * 64 + (g8 & ~1) * 4;
                        *(u32x4*)p = pair16(w1[0], w1[1]); *(u32x4*)(p + 32) = pair16(w2[0], w2[1]); }
                asm volatile("" ::: "memory");
            }
        } else if (u.pn < 6) {
#pragma unroll
            for (int ai = 0; ai < 2; ++ai)
#pragma unroll
                for (int m = 0; m < 4; ++m) { const int row = row0 + ai * HALF + m * 16;
#pragma unroll
                    for (int bj = 0; bj < 2; ++bj) { const int col = colb + bj * HALF - 1024, hh = col >> 6; const f32x4 v0 = acc[ai][bj][m][0], v1 = acc[ai][bj][m][1];
                        u32x4 w; w.x = cvtpk(v0[0], v0[1]); w.y = cvtpk(v0[2], v0[3]); w.z = cvtpk(v1[0], v1[1]); w.w = cvtpk(v1[2], v1[3]);
                        *(u32x4*)(QH + ((size_t)(((4 + (row >> 13)) * 8 + hh)) * SEQ + (row & (SEQ - 1))) * 64 + (col & 63)) = w; } }
        } else {
            const float sc = (u.pn == 7) ? QSCALE : 1.f;
#pragma unroll
            for (int ai = 0; ai < 2; ++ai)
#pragma unroll
                for (int m = 0; m < 4; ++m) { bf16_t* rowp = O + (size_t)(row0 + ai * HALF + m * 16) * NIN + colb;
#pragma unroll
                    for (int bj = 0; bj < 2; ++bj) { const f32x4 v0 = acc[ai][bj][m][0] * sc, v1 = acc[ai][bj][m][1] * sc;
                        u32x4 w; w.x = cvtpk(v0[0], v0[1]); w.y = cvtpk(v0[2], v0[3]); w.z = cvtpk(v1[0], v1[1]); w.w = cvtpk(v1[2], v1[3]);
                        *(u32x4*)(rowp + bj * HALF) = w; } }
        }
    }
};
struct EpiBf16 {
    static constexpr bool PERM = true, AFTER_DRAIN = false;
    bf16_t* O; int ldc; const float* bias; int bias_estride; float scale;
    __device__ __forceinline__ void operator()(const f32x4 (&acc)[2][2][4][2], const Unit& u, int wr, int wc, int fr, int fq) const {
        const int row0 = u.pm * BM + wr * 64 + fr, col0 = u.pn * BM + wc * 32 + 8 * fq;
        f32x4 bv[2][2];
#pragma unroll
        for (int bj = 0; bj < 2; ++bj)
#pragma unroll
            for (int n = 0; n < 2; ++n) bv[bj][n] = bias ? *(const f32x4*)(bias + (size_t)u.e * bias_estride + col0 + bj * HALF + 4 * n) : (f32x4){0.f, 0.f, 0.f, 0.f};
#pragma unroll
        for (int ai = 0; ai < 2; ++ai)
#pragma unroll
            for (int m = 0; m < 4; ++m) { bf16_t* rowp = O + (size_t)(row0 + ai * HALF + m * 16) * ldc + col0;
#pragma unroll
                for (int bj = 0; bj < 2; ++bj) { const f32x4 v0 = acc[ai][bj][m][0] * scale + bv[bj][0], v1 = acc[ai][bj][m][1] * scale + bv[bj][1];
                    u32x4 w; w.x = cvtpk(v0[0], v0[1]); w.y = cvtpk(v0[2], v0[3]); w.z = cvtpk(v1[0], v1[1]); w.w = cvtpk(v1[2], v1[3]);
                    *(u32x4*)(rowp + bj * HALF) = w; } }
    }
};
struct EpiF8 {
    static constexpr bool PERM = true, AFTER_DRAIN = false;
    unsigned char* O; int ldc; const float* bias; int bias_estride; float scale;
    __device__ __forceinline__ void operator()(const f32x4 (&acc)[2][2][4][2], const Unit& u, int wr, int wc, int fr, int fq) const {
        const int row0 = u.pm * BM + wr * 64 + fr, col0 = u.pn * BM + wc * 32 + 8 * fq;
        f32x4 bv[2][2];
#pragma unroll
        for (int bj = 0; bj < 2; ++bj)
#pragma unroll
            for (int n = 0; n < 2; ++n) bv[bj][n] = *(const f32x4*)(bias + (size_t)u.e * bias_estride + col0 + bj * HALF + 4 * n);
#pragma unroll
        for (int ai = 0; ai < 2; ++ai)
#pragma unroll
            for (int mp = 0; mp < 2; ++mp)
#pragma unroll
                for (int bj = 0; bj < 2; ++bj) { u32x2 w[2];
#pragma unroll
                    for (int q = 0; q < 2; ++q) { const int m = 2 * mp + q; const f32x4 v0 = acc[ai][bj][m][0] * scale + bv[bj][0], v1 = acc[ai][bj][m][1] * scale + bv[bj][1];
                        int w0 = 0, w1 = 0; w0 = __builtin_amdgcn_cvt_pk_fp8_f32(v0[0], v0[1], w0, false); w0 = __builtin_amdgcn_cvt_pk_fp8_f32(v0[2], v0[3], w0, true);
                        w1 = __builtin_amdgcn_cvt_pk_fp8_f32(v1[0], v1[1], w1, false); w1 = __builtin_amdgcn_cvt_pk_fp8_f32(v1[2], v1[3], w1, true);
                        w[q].x = (unsigned)w0; w[q].y = (unsigned)w1; }
                    const int msel = 2 * mp + (fq & 1);
                    *(u32x4*)(O + (size_t)(row0 + ai * HALF + msel * 16) * ldc + u.pn * BM + wc * 32 + 8 * (fq & ~1) + bj * HALF) = pair16(w[0], w[1]); }
    }
};
struct EpiSwiglu {
    static constexpr bool PERM = true, AFTER_DRAIN = false;
    unsigned char* O; const float* bias; float scale;
    __device__ __forceinline__ static float act1(float g, float up) {
        g = fminf(g, 7.0f); up = fminf(fmaxf(up, -7.0f), 7.0f);
        const float sg = __builtin_amdgcn_rcpf(1.0f + __builtin_amdgcn_exp2f(g * (-1.702f * 1.4426950408889634f)));
        return (up + 1.0f) * g * sg;
    }
    __device__ __forceinline__ static f32x2 act2(f32x2 g, f32x2 up) {
        g.x = fminf(g.x, 7.0f); g.y = fminf(g.y, 7.0f); up.x = fminf(fmaxf(up.x, -7.0f), 7.0f); up.y = fminf(fmaxf(up.y, -7.0f), 7.0f);
        const f32x2 z = g * (-1.702f * 1.4426950408889634f); f32x2 e; e.x = __builtin_amdgcn_exp2f(z.x); e.y = __builtin_amdgcn_exp2f(z.y);
        const f32x2 d = e + 1.0f; f32x2 r; r.x = __builtin_amdgcn_rcpf(d.x); r.y = __builtin_amdgcn_rcpf(d.y);
        return (up + 1.0f) * g * r;
    }
    __device__ __forceinline__ void operator()(const f32x4 (&acc)[2][2][4][2], const Unit& u, int wr, int wc, int fr, int fq) const {
        const int row0 = u.pm * BM + wr * 64 + fr, j0 = u.pn * HALF + wc * 32 + 8 * fq;
        const float* bg = bias + (size_t)u.e * 2048 + j0; const float* bu = bg + 1024;
        const f32x4 bg0 = *(const f32x4*)bg, bg1 = *(const f32x4*)(bg + 4), bu0 = *(const f32x4*)bu, bu1 = *(const f32x4*)(bu + 4);
#pragma unroll
        for (int ai = 0; ai < 2; ++ai)
#pragma unroll
            for (int mp = 0; mp < 2; ++mp) { u32x2 w[2];
#pragma unroll
                for (int q = 0; q < 2; ++q) { const int m = 2 * mp + q;
                    const f32x4 g0 = acc[ai][0][m][0] * scale + bg0, g1 = acc[ai][0][m][1] * scale + bg1, u0 = acc[ai][1][m][0] * scale + bu0, u1 = acc[ai][1][m][1] * scale + bu1;
                    int w0 = 0, w1 = 0;
                    const f32x2 a0 = act2((f32x2){g0[0], g0[1]}, (f32x2){u0[0], u0[1]}), a1 = act2((f32x2){g0[2], g0[3]}, (f32x2){u0[2], u0[3]}), a2 = act2((f32x2){g1[0], g1[1]}, (f32x2){u1[0], u1[1]}), a3 = act2((f32x2){g1[2], g1[3]}, (f32x2){u1[2], u1[3]});
                    w0 = __builtin_amdgcn_cvt_pk_fp8_f32(a0.x, a0.y, w0, false); w0 = __builtin_amdgcn_cvt_pk_fp8_f32(a1.x, a1.y, w0, true);
                    w1 = __builtin_amdgcn_cvt_pk_fp8_f32(a2.x, a2.y, w1, false); w1 = __builtin_amdgcn_cvt_pk_fp8_f32(a3.x, a3.y, w1, true);
                    w[q].x = (unsigned)w0; w[q].y = (unsigned)w1; }
                const int msel = 2 * mp + (fq & 1);
                *(u32x4*)(O + (size_t)(row0 + ai * HALF + msel * 16) * DM + u.pn * HALF + wc * 32 + 8 * (fq & ~1)) = pair16(w[0], w[1]); }
    }
};
template <bool BASE_BF16>
struct EpiRes {
    static constexpr bool PERM = true, AFTER_DRAIN = false;
    const void* base; bf16_t* out;
    __device__ __forceinline__ void operator()(const f32x4 (&acc)[2][2][4][2], const Unit& u, int wr, int wc, int fr, int fq) const {
        const int row0 = u.pm * BM + wr * 64 + fr, col0 = u.pn * BM + wc * 32 + 8 * fq;
#pragma unroll
        for (int ai = 0; ai < 2; ++ai) {
            f32x4 bs[4][2][2];
#pragma unroll
            for (int m = 0; m < 4; ++m) { const size_t off = (size_t)(row0 + ai * HALF + m * 16) * DM + col0;
#pragma unroll
                for (int bj = 0; bj < 2; ++bj) {
                    if constexpr (BASE_BF16) { const u32x4 r = __builtin_nontemporal_load((const u32x4*)((const bf16_t*)base + off + bj * HALF));
                        bs[m][bj][0] = (f32x4){bflo(r.x), bfhi(r.x), bflo(r.y), bfhi(r.y)}; bs[m][bj][1] = (f32x4){bflo(r.z), bfhi(r.z), bflo(r.w), bfhi(r.w)}; }
                    else { bs[m][bj][0] = __builtin_nontemporal_load((const f32x4*)((const float*)base + off + bj * HALF)); bs[m][bj][1] = __builtin_nontemporal_load((const f32x4*)((const float*)base + off + bj * HALF + 4)); } } }
#pragma unroll
            for (int m = 0; m < 4; ++m) { const size_t off = (size_t)(row0 + ai * HALF + m * 16) * DM + col0;
#pragma unroll
                for (int bj = 0; bj < 2; ++bj) { const f32x4 v0 = bs[m][bj][0] + acc[ai][bj][m][0], v1 = bs[m][bj][1] + acc[ai][bj][m][1];
                    u32x4 w; w.x = cvtpk(v0[0], v0[1]); w.y = cvtpk(v0[2], v0[3]); w.z = cvtpk(v1[0], v1[1]); w.w = cvtpk(v1[2], v1[3]);
                    *(u32x4*)(out + off + bj * HALF) = w; } }
            asm volatile("" ::: "memory");
        }
    }
};

template <class Epi, class Sched, bool ALIGN_EPI = false, bool SP2 = true, bool FP8 = false, bool GATHER = false>
__device__ __forceinline__ void gemm_phase(LAS unsigned char* lds, const int tid, const Gemm g, const Sched& S, const Epi& E) {
    const int wid = __builtin_amdgcn_readfirstlane(tid >> 6), lane = tid & 63, wr = wid >> 2, wc = wid & 3, fr = lane & 15, fq = lane >> 4;
    const int K = g.K, rowb = FP8 ? K : 2 * K, nt = rowb / 128;
    unsigned voffA[2], voffB[2];
#pragma unroll
    for (int i = 0; i < 2; ++i) { int R, C; stage_rc(tid * 16 + i * 8192, R, C); const int Rb = Epi::PERM ? ((R & ~31) + perm32(R & 31)) : R;
        voffA[i] = (unsigned)(R * rowb + C * 2); voffB[i] = (unsigned)(Rb * rowb + C * 2); }
    const size_t kstep = (size_t)(BK * 2);
    const size_t hstep = (size_t)HALF * rowb;
    const size_t tstep = 2 * hstep;
    const unsigned ldsw = (unsigned)wid * 1024u;
    const int aoff = lds_byte(wr * 64 + fr, fq * 8), boff = lds_byte(wc * 32 + fr, fq * 8);
#define PG8_SA(b, h) (((b) * 2 + (h)) * HTB)
#define PG8_SB(b, h) ((4 + (b) * 2 + (h)) * HTB)
#define PG8_STAGE(bufoff, gbase, voff) do { _Pragma("unroll") for (int _i = 0; _i < 2; ++_i) \
        __builtin_amdgcn_global_load_lds((const unsigned*)((const char*)(gbase) + (voff)[_i]), (LAS unsigned*)(lds + (bufoff) + ldsw + _i * 8192), 16, 0, 0); } while (0)
#define PG8_STAGE_A(bufoff, gbase, h, nx) do { if constexpr (GATHER) { unsigned vo_[2]; vo_[0] = (nx) ? gAn[h][0] : gAc[h][0]; vo_[1] = (nx) ? gAn[h][1] : gAc[h][1]; PG8_STAGE(bufoff, gbase, vo_); } \
        else PG8_STAGE(bufoff, (gbase) + (h) * hstep, voffA); } while (0)
#define PG8_LDA(dst, b, h) do { if constexpr (FP8) { _Pragma("unroll") for (int m = 0; m < 4; ++m) { const i32x4_t lo_ = *(const LAS i32x4_t*)(lds + PG8_SA(b, h) + aoff + m * 2048), hi_ = *(const LAS i32x4_t*)(lds + PG8_SA(b, h) + aoff + m * 2048 + 1024); \
            dst##8[m] = __builtin_shufflevector(lo_, hi_, 0, 1, 2, 3, 4, 5, 6, 7); } } \
        else { _Pragma("unroll") for (int m = 0; m < 4; ++m) _Pragma("unroll") for (int k = 0; k < 2; ++k) dst[m][k] = *(const LAS bf16x8*)(lds + PG8_SA(b, h) + aoff + m * 2048 + k * 1024); } } while (0)
#define PG8_LDB(dst, b, h) do { if constexpr (FP8) { _Pragma("unroll") for (int n = 0; n < 2; ++n) { const i32x4_t lo_ = *(const LAS i32x4_t*)(lds + PG8_SB(b, h) + boff + n * 2048), hi_ = *(const LAS i32x4_t*)(lds + PG8_SB(b, h) + boff + n * 2048 + 1024); \
            dst##8[n] = __builtin_shufflevector(lo_, hi_, 0, 1, 2, 3, 4, 5, 6, 7); } } \
        else { _Pragma("unroll") for (int n = 0; n < 2; ++n) _Pragma("unroll") for (int k = 0; k < 2; ++k) dst[n][k] = *(const LAS bf16x8*)(lds + PG8_SB(b, h) + boff + n * 2048 + k * 1024); } } while (0)
#define PG8_MMA(ai, bj, At, Bt) do { __builtin_amdgcn_s_setprio(1); \
        if constexpr (FP8) { _Pragma("unroll") for (int m = 0; m < 4; ++m) _Pragma("unroll") for (int n = 0; n < 2; ++n) \
            asm volatile("v_mfma_scale_f32_16x16x128_f8f6f4 %0, %1, %2, %0, %3, %3 op_sel_hi:[0,0,0]" : "+v"(acc[ai][bj][m][n]) : "v"(Bt##8[n]), "v"(At##8[m]), "v"(0x7f7f7f7f)); } \
        else { _Pragma("unroll") for (int m = 0; m < 4; ++m) _Pragma("unroll") for (int n = 0; n < 2; ++n) _Pragma("unroll") for (int k = 0; k < 2; ++k) \
            acc[ai][bj][m][n] = __builtin_amdgcn_mfma_f32_16x16x32_bf16(Bt[n][k], At[m][k], acc[ai][bj][m][n], 0, 0, 0); } \
        __builtin_amdgcn_s_setprio(0); } while (0)
#define PG8_WAIT_V(n) asm volatile("s_waitcnt vmcnt(" #n ")" ::: "memory")
#define PG8_WAIT_L(n) asm volatile("s_waitcnt lgkmcnt(" #n ")" ::: "memory")
#define PG8_BAR __builtin_amdgcn_s_barrier()
#define PG8_SCHED __builtin_amdgcn_sched_barrier(0)
#define PG8_UA(u) (GATHER ? (const char*)g.A : (const char*)g.A + (size_t)(u).pm * tstep)
    unsigned gAc[2][2], gAn[2][2];
#define PG8_GLOAD(dst, ui_) do { if constexpr (GATHER) { _Pragma("unroll") for (int h = 0; h < 2; ++h) _Pragma("unroll") for (int i = 0; i < 2; ++i) { int R, C; stage_rc(tid * 16 + i * 8192, R, C); \
            dst[h][i] = (unsigned)(g.gtok[(ui_) * 256 + h * HALF + R] * rowb + C * 2); } } } while (0)
#define PG8_UB(u) ((const char*)g.Bt + (size_t)(u).e * g.ebytes + (size_t)(u).pn * tstep)
    Unit cur, nxt; int ui = 0;
    if (!S.next(0, cur)) return;
    f32x4 acc[2][2][4][2];
#pragma unroll
    for (int a = 0; a < 2; ++a)
#pragma unroll
        for (int b = 0; b < 2; ++b)
#pragma unroll
            for (int m = 0; m < 4; ++m)
#pragma unroll
                for (int n = 0; n < 2; ++n) acc[a][b][m][n] = (f32x4){0.f, 0.f, 0.f, 0.f};
    bf16x8 At[4][2], B0[2][2], B1[2][2]; i32x8_t At8[4], B08[2], B18[2];
    const char* cA = PG8_UA(cur); const char* cB = PG8_UB(cur);
    PG8_GLOAD(gAc, 0);
    if constexpr (SP2) {
        PG8_STAGE(PG8_SB(0, 0), cB, voffB); PG8_STAGE(PG8_SB(0, 1), cB + hstep, voffB); PG8_STAGE_A(PG8_SA(0, 0), cA, 0, false); PG8_STAGE_A(PG8_SA(0, 1), cA, 1, false);
        if (wr == 1) PG8_BAR;
        PG8_WAIT_V(2); PG8_BAR;
        PG8_STAGE(PG8_SB(1, 0), cB + kstep, voffB); PG8_STAGE_A(PG8_SA(1, 0), cA + kstep, 0, false); PG8_STAGE(PG8_SB(1, 1), cB + hstep + kstep, voffB);
        PG8_WAIT_V(6); PG8_BAR;
    } else {
        PG8_STAGE(PG8_SB(0, 0), cB, voffB); PG8_STAGE_A(PG8_SA(0, 0), cA, 0, false); PG8_STAGE(PG8_SB(0, 1), cB + hstep, voffB); PG8_STAGE_A(PG8_SA(0, 1), cA, 1, false);
        if (wr == 1) PG8_BAR;
        PG8_WAIT_V(4); PG8_BAR;
        PG8_STAGE(PG8_SB(1, 0), cB + kstep, voffB); PG8_STAGE_A(PG8_SA(1, 0), cA + kstep, 0, false); PG8_STAGE(PG8_SB(1, 1), cB + hstep + kstep, voffB);
        PG8_WAIT_V(6); PG8_BAR;
    }
    for (;;) {
        const bool has_next = S.next(ui + 1, nxt);
        if constexpr (GATHER) { if (has_next) PG8_GLOAD(gAn, ui + 1); else { gAn[0][0] = gAc[0][0]; gAn[0][1] = gAc[0][1]; gAn[1][0] = gAc[1][0]; gAn[1][1] = gAc[1][1]; } }
        const char* nA = has_next ? PG8_UA(nxt) : cA; const char* nB = has_next ? PG8_UB(nxt) : cB;
#pragma unroll 1
        for (int t = 0; t < nt; t += 2) {
            const bool last = (t == nt - 2);
            const char* a1 = cA + (size_t)(t + 1) * kstep;
            const char* a2 = last ? nA : cA + (size_t)(t + 2) * kstep; const char* b2 = last ? nB : cB + (size_t)(t + 2) * kstep;
            const char* a3 = a2 + kstep; const char* b3 = b2 + kstep;
            if constexpr (SP2) {
            PG8_LDB(B0, 0, 0); PG8_LDB(B1, 0, 1); PG8_SCHED; PG8_LDA(At, 0, 0); PG8_STAGE_A(PG8_SA(1, 1), a1, 1, false);
            PG8_WAIT_V(8); PG8_WAIT_L(0); PG8_BAR; PG8_MMA(0, 0, At, B0); PG8_MMA(0, 1, At, B1); PG8_BAR; PG8_SCHED;
            PG8_LDA(At, 0, 1); PG8_STAGE(PG8_SB(0, 0), b2, voffB); PG8_STAGE(PG8_SB(0, 1), b2 + hstep, voffB); PG8_STAGE_A(PG8_SA(0, 0), a2, 0, last);
            PG8_WAIT_V(8); PG8_WAIT_L(0); PG8_BAR; PG8_MMA(1, 0, At, B0); PG8_MMA(1, 1, At, B1); PG8_BAR; PG8_SCHED;
            PG8_LDB(B0, 1, 0); PG8_LDB(B1, 1, 1); PG8_SCHED; PG8_LDA(At, 1, 0); PG8_STAGE_A(PG8_SA(0, 1), a2, 1, last);
            PG8_WAIT_V(8); PG8_WAIT_L(0); PG8_BAR; PG8_MMA(0, 0, At, B0); PG8_MMA(0, 1, At, B1); PG8_BAR; PG8_SCHED;
            PG8_LDA(At, 1, 1); PG8_STAGE(PG8_SB(1, 0), b3, voffB); PG8_STAGE(PG8_SB(1, 1), b3 + hstep, voffB); PG8_STAGE_A(PG8_SA(1, 0), a3, 0, last);
            PG8_WAIT_V(8); PG8_WAIT_L(0); PG8_BAR; PG8_MMA(1, 0, At, B0); PG8_MMA(1, 1, At, B1); PG8_BAR; PG8_SCHED;
            } else {
            PG8_LDB(B0, 0, 0); PG8_SCHED; PG8_LDA(At, 0, 0); PG8_STAGE_A(PG8_SA(1, 1), a1, 1, false);
            PG8_WAIT_L(8); PG8_BAR; PG8_WAIT_L(0); PG8_MMA(0, 0, At, B0); PG8_BAR; PG8_SCHED;
            PG8_LDB(B1, 0, 1); PG8_STAGE(PG8_SB(0, 0), b2, voffB);
            PG8_BAR; PG8_WAIT_L(0); PG8_MMA(0, 1, At, B1); PG8_BAR;
            PG8_LDA(At, 0, 1); PG8_STAGE_A(PG8_SA(0, 0), a2, 0, last);
            PG8_BAR; PG8_WAIT_L(0); PG8_MMA(1, 0, At, B0); PG8_BAR; PG8_SCHED;
            PG8_STAGE(PG8_SB(0, 1), b2 + hstep, voffB);
            PG8_WAIT_V(6); PG8_BAR; PG8_MMA(1, 1, At, B1); PG8_BAR;
            PG8_LDB(B0, 1, 0); PG8_SCHED; PG8_LDA(At, 1, 0); PG8_STAGE_A(PG8_SA(0, 1), a2, 1, last);
            PG8_WAIT_L(8); PG8_BAR; PG8_WAIT_L(0); PG8_MMA(0, 0, At, B0); PG8_BAR; PG8_SCHED;
            PG8_LDB(B1, 1, 1); PG8_STAGE(PG8_SB(1, 0), b3, voffB);
            PG8_BAR; PG8_WAIT_L(0); PG8_MMA(0, 1, At, B1); PG8_BAR;
            PG8_LDA(At, 1, 1); PG8_STAGE_A(PG8_SA(1, 0), a3, 0, last);
            PG8_BAR; PG8_WAIT_L(0); PG8_MMA(1, 0, At, B0); PG8_BAR; PG8_SCHED;
            PG8_STAGE(PG8_SB(1, 1), b3 + hstep, voffB);
            PG8_WAIT_V(6); PG8_BAR; PG8_MMA(1, 1, At, B1); PG8_BAR;
            }
        }
        if constexpr (ALIGN_EPI) { if (wr == 0) PG8_BAR; }
        if constexpr (FP8) asm volatile("s_nop 15\n\ts_nop 15" ::: "memory");
        E(acc, cur, wr, wc, fr, fq);
        if (!has_next) break;
#pragma unroll
        for (int a = 0; a < 2; ++a)
#pragma unroll
            for (int b = 0; b < 2; ++b)
#pragma unroll
                for (int m = 0; m < 4; ++m)
#pragma unroll
                    for (int n = 0; n < 2; ++n) acc[a][b][m][n] = (f32x4){0.f, 0.f, 0.f, 0.f};
        cur = nxt; cA = nA; cB = nB; ++ui;
        if constexpr (GATHER) { gAc[0][0] = gAn[0][0]; gAc[0][1] = gAn[0][1]; gAc[1][0] = gAn[1][0]; gAc[1][1] = gAn[1][1]; }
        if constexpr (ALIGN_EPI) { if (wr == 1) PG8_BAR; }
    }
    PG8_WAIT_V(0);
    if constexpr (!ALIGN_EPI) { if (wr == 0) PG8_BAR; }
    PG8_BAR;
#undef PG8_SA
#undef PG8_SB
#undef PG8_STAGE
#undef PG8_STAGE_A
#undef PG8_GLOAD
#undef PG8_LDA
#undef PG8_LDB
#undef PG8_MMA
#undef PG8_WAIT_V
#undef PG8_WAIT_L
#undef PG8_BAR
#undef PG8_SCHED
#undef PG8_UA
#undef PG8_UB
}
}


#define XB_TMO      128
#define XB_XCNT(j)  (256  + 64 * (j))
#define XB_XSUB(j)  (1280 + 64 * (j))
#define XB_XGEN(j)  (2304 + 64 * (j))
#define XB_TOP      3328
#define XB_TOPGEN   3392
#define XCD_BAR_WORDS 3456
#define XB_SPIN_CAP (1u << 18)
__device__ __forceinline__ unsigned xb_ld(unsigned* p)              { return __hip_atomic_load(p, __ATOMIC_RELAXED, __HIP_MEMORY_SCOPE_AGENT); }
__device__ __forceinline__ unsigned xb_add(unsigned* p, unsigned v) { return __hip_atomic_fetch_add(p, v, __ATOMIC_RELAXED, __HIP_MEMORY_SCOPE_AGENT); }
__device__ __forceinline__ unsigned xb_xcc_id() { return (unsigned)__builtin_amdgcn_s_getreg((3 << 11) | 20) & 0xFu; }
#define XB_SPIN(cond, bar) do { unsigned _sp = 0; while (cond) { __builtin_amdgcn_s_sleep(1); \
    if ((++_sp & 255u) == 0u) { if (xb_ld(&(bar)[XB_TMO])) break; if (_sp > XB_SPIN_CAP) { atomicAdd(&(bar)[XB_TMO], 1u); break; } } } } while (0)
struct XcdBarrier { unsigned* bar; unsigned x; volatile LAS unsigned* st; };
__device__ __forceinline__ XcdBarrier xcd_barrier_post(unsigned* bar, volatile LAS unsigned* st, int tid) {
    XcdBarrier b; b.bar = bar; b.x = xb_xcc_id(); b.st = st;
    if (tid == 0) (void)xb_add(&bar[XB_XCNT(b.x)], 1u);
    return b;
}
__device__ __forceinline__ void xcd_barrier_complete(unsigned* bar, unsigned x, unsigned& nloc, unsigned& nx) {
    const unsigned G = gridDim.x * gridDim.y * gridDim.z;
    unsigned sum, cnt, mine, sp = 0u;
    for (;;) {
        sum = 0u; cnt = 0u; mine = 0u;
#pragma unroll
        for (unsigned j = 0; j < 16; ++j) { const unsigned c = xb_ld(&bar[XB_XCNT(j)]); sum += c; cnt += (c > 0u) ? 1u : 0u; mine = (j == x) ? c : mine; }
        if (sum == G) break;
        __builtin_amdgcn_s_sleep(1);
        if ((++sp & 255u) == 0u) { if (xb_ld(&bar[XB_TMO])) break; if (sp > XB_SPIN_CAP) { atomicAdd(&bar[XB_TMO], 1u); break; } }
    }
    nloc = mine > 0u ? mine : 1u; nx = cnt > 0u ? cnt : 1u;
}
__device__ __forceinline__ void xcd_barrier(const XcdBarrier& b, int tid) {
    asm volatile("s_waitcnt vmcnt(0)" ::: "memory");
    __syncthreads();
    if (tid == 0) {
        unsigned* bar = b.bar;
        __builtin_amdgcn_s_waitcnt(0);
        unsigned nloc = b.st[0], nx = b.st[1];
        if (nloc == 0u) { xcd_barrier_complete(bar, b.x, nloc, nx); b.st[0] = nloc; b.st[1] = nx; }
        const unsigned old = xb_add(&bar[XB_XSUB(b.x)], 1u);
        const unsigned gen = old / nloc;
        if (old + 1u == (gen + 1u) * nloc) {
            __builtin_amdgcn_fence(__ATOMIC_RELEASE, "agent");
            asm volatile("s_waitcnt vmcnt(0)" ::: "memory");
            const unsigned og = xb_add(&bar[XB_TOP], 1u);
            const unsigned tg = og / nx;
            if (og + 1u == (tg + 1u) * nx) xb_add(&bar[XB_TOPGEN], 1u);
            else XB_SPIN(xb_ld(&bar[XB_TOPGEN]) == tg, bar);
            __builtin_amdgcn_fence(__ATOMIC_ACQUIRE, "agent");
            xb_add(&bar[XB_XGEN(b.x)], 1u);
            asm volatile("s_waitcnt vmcnt(0)" ::: "memory");
        } else {
            XB_SPIN(xb_ld(&bar[XB_XGEN(b.x)]) == gen, bar);
            __builtin_amdgcn_fence(__ATOMIC_ACQUIRE, "agent");
            asm volatile("s_waitcnt vmcnt(0)" ::: "memory");
        }
    }
    __syncthreads();
}

struct Args { const float* in[18]; float* out; unsigned char* ws; int ph_lo, ph_hi; };
enum { IN_X = 0, IN_MEM, IN_N1G, IN_WIN, IN_POOLW, IN_POOLS, IN_MEMNG, IN_WMKV, IN_GRPG, IN_WOUT, IN_N2G, IN_RW, IN_RB, IN_WGU, IN_BGU, IN_WDN, IN_BDN, IN_FING };

#define GAS __attribute__((address_space(1)))
#define CAS __attribute__((address_space(4)))
struct Frame {
    LAS unsigned char* lds; int tid, lane, wave, G, bid;
    const CAS unsigned char* kp;
    __device__ __forceinline__ const float* in(int i) const { return (const float*)*(GAS const float* const CAS*)(kp + 8 * i); }
    __device__ __forceinline__ float* out() const { return (float*)*(GAS float* const CAS*)(kp + 144); }
    __device__ __forceinline__ unsigned char* ws() const { return (unsigned char*)*(GAS unsigned char* const CAS*)(kp + 152); }
};

template <int MODE> __device__ __forceinline__ int perm_col(int c) {
    if (MODE == 1) { if (c >= 1024) return c; const int head = c >> 6, d = c & 63, g8 = (d & 31) >> 2, i = (d & 3) + ((d >> 5) << 2); return (head << 6) + (g8 << 3) + i; }
    if (MODE == 2) { const int up = c >> 10, cc = c & 1023; return ((cc >> 7) << 8) + (up << 7) + (cc & 127); }
    return c;
}
struct TItem { const float* W; bf16_t* WT; int N, mode, k0, n0; };
__device__ __forceinline__ int perm_col_rt(int mode, int c) { return mode == 1 ? perm_col<1>(c) : (mode == 2 ? perm_col<2>(c) : c); }
__device__ __forceinline__ void titem_load(const TItem& I, float (&tmp)[32], int lane) {
#pragma unroll
    for (int i = 0; i < 32; ++i) { const int kk = 2 * i + (lane >> 5); tmp[i] = I.W[(size_t)(I.k0 + kk) * I.N + I.n0 + (lane & 31)]; }
}
__device__ __forceinline__ void titem_store(const TItem& I, const float (&tmp)[32], LAS float* scr, int lane) {
#pragma unroll
    for (int i = 0; i < 32; ++i) { const int kk = 2 * i + (lane >> 5); scr[kk * 33 + (lane & 31)] = tmp[i]; }
    LDS_WAIT();
    if (I.mode >= 2) {
        const int c = lane & 3; unsigned char* W8 = (unsigned char*)I.WT;
#pragma unroll
        for (int j = 0; j < 2; ++j) { const int n = (lane >> 2) + 16 * j; const LAS float* s = scr + (16 * c) * 33 + n; u32x4 o;
#pragma unroll
            for (int q = 0; q < 4; ++q) { int w = 0; w = __builtin_amdgcn_cvt_pk_fp8_f32(s[(4 * q) * 33] * W8SCALE, s[(4 * q + 1) * 33] * W8SCALE, w, false);
                w = __builtin_amdgcn_cvt_pk_fp8_f32(s[(4 * q + 2) * 33] * W8SCALE, s[(4 * q + 3) * 33] * W8SCALE, w, true); o[q] = (unsigned)w; }
            const int row = (I.mode == 2) ? perm_col<2>(I.n0 + n) : (I.n0 + n);
            *(u32x4*)(W8 + (size_t)row * DM + I.k0 + 16 * c) = o; }
    } else {
        const int c = lane & 7;
#pragma unroll
        for (int j = 0; j < 4; ++j) { const int n = (lane >> 3) + 8 * j; const LAS float* s = scr + (8 * c) * 33 + n;
            u32x4 o; o.x = cvtpk(s[0 * 33], s[1 * 33]); o.y = cvtpk(s[2 * 33], s[3 * 33]); o.z = cvtpk(s[4 * 33], s[5 * 33]); o.w = cvtpk(s[6 * 33], s[7 * 33]);
            *(u32x4*)(I.WT + (size_t)perm_col_rt(I.mode, I.n0 + n) * DM + I.k0 + 8 * c) = o; }
    }
    LDS_WAIT();
}
struct W8Step { const float* W; unsigned char* W8; int N, gu, k0, n0; };
__device__ __forceinline__ void w8_load(const W8Step& I, f32x4 (&r)[16], int wave, int lane) {
#pragma unroll
    for (int h = 0; h < 2; ++h)
#pragma unroll
        for (int i = 0; i < 8; ++i) r[8 * h + i] = __builtin_nontemporal_load((const f32x4*)(I.W + (size_t)(I.k0 + 8 * (wave + 8 * h) + i) * I.N + I.n0 + 4 * lane));
}
__device__ __forceinline__ void w8_store(const W8Step& I, const f32x4 (&r)[16], LAS unsigned char* T, int tid, int wave, int lane) {
#pragma unroll
    for (int h = 0; h < 2; ++h) { const int a = wave + 8 * h;
#pragma unroll
        for (int j = 0; j < 4; ++j) { int w0 = 0, w1 = 0;
            w0 = __builtin_amdgcn_cvt_pk_fp8_f32(r[8 * h + 0][j] * W8SCALE, r[8 * h + 1][j] * W8SCALE, w0, false); w0 = __builtin_amdgcn_cvt_pk_fp8_f32(r[8 * h + 2][j] * W8SCALE, r[8 * h + 3][j] * W8SCALE, w0, true);
            w1 = __builtin_amdgcn_cvt_pk_fp8_f32(r[8 * h + 4][j] * W8SCALE, r[8 * h + 5][j] * W8SCALE, w1, false); w1 = __builtin_amdgcn_cvt_pk_fp8_f32(r[8 * h + 6][j] * W8SCALE, r[8 * h + 7][j] * W8SCALE, w1, true);
            u32x2 w; w.x = (unsigned)w0; w.y = (unsigned)w1;
            *(LAS u32x2*)(T + (4 * lane + j) * 128 + ((a ^ (lane & 15)) << 3)) = w; } }
    __syncthreads();
#pragma unroll
    for (int i = 0; i < 4; ++i) { const int p = tid + 512 * i, row = p >> 3, c16 = p & 7, f = (row >> 2) & 15;
        u32x4 v = *(const LAS u32x4*)(T + row * 128 + ((c16 ^ (f >> 1)) << 4));
        if (f & 1) v = (u32x4){v.z, v.w, v.x, v.y};
        const int orow = I.gu ? perm_col<2>(I.n0 + row) : (I.n0 + row);
        *(u32x4*)(I.W8 + (size_t)orow * DM + I.k0 + 16 * c16) = v; }
}
constexpr int W8_GU_STEPS = 32 * 64, W8_PER_LAYER = W8_GU_STEPS + 32 * 32;
__device__ __forceinline__ void w8_decode(Frame& F, W8Step& I, int layer, int j) {
    if (j < W8_GU_STEPS) { const int le = layer * NE + (j >> 6), r_ = j & 63; I.W = F.in(IN_WGU) + (size_t)le * DM * 2048; I.W8 = F.ws() + WS_WGU + (size_t)le * 2048 * DM; I.N = 2048; I.gu = 1; I.k0 = 128 * (r_ >> 3); I.n0 = 256 * (r_ & 7); }
    else { const int q_ = j - W8_GU_STEPS, le = layer * NE + (q_ >> 5), r_ = q_ & 31; I.W = F.in(IN_WDN) + (size_t)le * DM * DM; I.W8 = F.ws() + WS_WDN + (size_t)le * DM * DM; I.N = DM; I.gu = 0; I.k0 = 128 * (r_ >> 2); I.n0 = 256 * (r_ & 3); }
}
constexpr int W8_Q_DN0 = 32 * 32, W8_Q_TOTAL = W8_Q_DN0 + W8_PER_LAYER;
__device__ __forceinline__ void w8_decode_q(Frame& F, W8Step& I, int q) { if (q < W8_Q_DN0) w8_decode(F, I, 0, W8_GU_STEPS + q); else w8_decode(F, I, 1, q - W8_Q_DN0); }
__device__ __forceinline__ int w8_grab(Frame& F, unsigned* next, unsigned* done, int limit) {
    volatile LAS int* bc = (volatile LAS int*)(F.lds + MISC_OFF + 128);
    __syncthreads();
    if (F.tid == 0) { int go = 1; if (done != nullptr && __hip_atomic_load(done, __ATOMIC_RELAXED, __HIP_MEMORY_SCOPE_AGENT) >= (unsigned)F.G) go = 0;
        if (go && limit < W8_Q_TOTAL && __hip_atomic_load(next, __ATOMIC_RELAXED, __HIP_MEMORY_SCOPE_AGENT) >= (unsigned)limit) go = 0;
        int j = W8_Q_TOTAL; if (go) j = (int)__hip_atomic_fetch_add(next, 1u, __ATOMIC_RELAXED, __HIP_MEMORY_SCOPE_AGENT); bc[0] = j; }
    __syncthreads();
    return bc[0];
}
__device__ __forceinline__ void w8_help(Frame& F, unsigned* next, unsigned* done, int limit = W8_Q_TOTAL) {
    f32x4 ra[16], rb[16]; W8Step A, B; LAS unsigned char* T0 = F.lds; LAS unsigned char* T1 = F.lds + 32768;
    int j = w8_grab(F, next, done, limit);
    if (j < W8_Q_TOTAL) { w8_decode_q(F, A, j); w8_load(A, ra, F.wave, F.lane); }
    while (j < W8_Q_TOTAL) {
        int jn = w8_grab(F, next, done, limit); if (jn < W8_Q_TOTAL) { w8_decode_q(F, B, jn); w8_load(B, rb, F.wave, F.lane); }
        w8_store(A, ra, T0, F.tid, F.wave, F.lane); j = jn; if (j >= W8_Q_TOTAL) break;
        jn = w8_grab(F, next, done, limit); if (jn < W8_Q_TOTAL) { w8_decode_q(F, A, jn); w8_load(A, ra, F.wave, F.lane); }
        w8_store(B, rb, T1, F.tid, F.wave, F.lane); j = jn;
    }
    __syncthreads();
}
__device__ __forceinline__ void rms_row_bf16(const float* xrow, const float* g, bf16_t* orow, int lane) {
    f32x4 v[4]; float ss = 0.f;
#pragma unroll
    for (int j = 0; j < 4; ++j) { v[j] = ((const f32x4*)xrow)[lane + 64 * j]; ss += (v[j].x * v[j].x + v[j].y * v[j].y) + (v[j].z * v[j].z + v[j].w * v[j].w); }
    const float rs = rsqrtf(wave_sum(ss) * (1.f / DM) + EPS);
#pragma unroll
    for (int j = 0; j < 4; ++j) { const f32x4 gv = ((const f32x4*)g)[lane + 64 * j]; const f32x4 o = v[j] * rs * gv;
        u32x2 w; w.x = cvtpk(o.x, o.y); w.y = cvtpk(o.z, o.w); ((u32x2*)orow)[lane + 64 * j] = w; }
}
__device__ __forceinline__ void prologue(Frame& F) {
    LAS float* scr = (LAS float*)(F.lds + F.wave * 16384);
    const int gw = F.bid * 8 + F.wave, NGW = F.G * 8;
    { f32x4 ra[16], rb[16]; W8Step A, B; int st = F.bid; LAS unsigned char* T0 = F.lds; LAS unsigned char* T1 = F.lds + 32768;
      if (st < W8_GU_STEPS) { w8_decode(F, A, 0, st); w8_load(A, ra, F.wave, F.lane); }
      while (st < W8_GU_STEPS) {
          int nx = st + F.G; if (nx < W8_GU_STEPS) { w8_decode(F, B, 0, nx); w8_load(B, rb, F.wave, F.lane); }
          w8_store(A, ra, T0, F.tid, F.wave, F.lane); st = nx; if (st >= W8_GU_STEPS) break;
          nx = st + F.G; if (nx < W8_GU_STEPS) { w8_decode(F, A, 0, nx); w8_load(A, ra, F.wave, F.lane); }
          w8_store(B, rb, T1, F.tid, F.wave, F.lane); st = nx;
      }
      __syncthreads();
    }
    constexpr int I_IN = 16 * 64, I_OUT = 16 * 32, I_MKV = 16 * 16;
    constexpr int S0 = 2 * I_IN, S1 = S0 + 2 * I_OUT, S2 = S1 + 2 * I_MKV, S4 = S2;
#define TI_DECODE(I, it_) do { const int it__ = (it_); int r_, N_; \
        if (it__ < S0) { const int l = it__ / I_IN; r_ = it__ % I_IN; N_ = NIN; (I).W = F.in(IN_WIN) + (size_t)l * DM * NIN; (I).WT = (bf16_t*)(F.ws() + WS_WIN) + (size_t)l * NIN * DM; (I).mode = 1; } \
        else if (it__ < S1) { const int q = it__ - S0, l = q / I_OUT; r_ = q % I_OUT; N_ = DM; (I).W = F.in(IN_WOUT) + (size_t)l * DM * DM; (I).WT = (bf16_t*)(F.ws() + WS_WOUT) + (size_t)l * DM * DM; (I).mode = 0; } \
        else { const int q = it__ - S1, l = q / I_MKV; r_ = q % I_MKV; N_ = 512; (I).W = F.in(IN_WMKV) + (size_t)l * DM * 512; (I).WT = (bf16_t*)(F.ws() + WS_WMKV) + (size_t)l * 512 * DM; (I).mode = 0; } \
        const int nblk_ = N_ / 32; (I).N = N_; (I).k0 = 64 * (r_ / nblk_); (I).n0 = 32 * (r_ % nblk_); } while (0)
    { float ta[32], tb[32]; TItem A, B; int it = gw;
      if (it < S4) { TI_DECODE(A, it); titem_load(A, ta, F.lane); }
      while (it < S4) {
          int nx = it + NGW; if (nx < S4) { TI_DECODE(B, nx); titem_load(B, tb, F.lane); }
          titem_store(A, ta, scr, F.lane); it = nx; if (it >= S4) break;
          nx = it + NGW; if (nx < S4) { TI_DECODE(A, nx); titem_load(A, ta, F.lane); }
          titem_store(B, tb, scr, F.lane); it = nx;
      } }
#undef TI_DECODE
    { float* cs = (float*)(F.ws() + WS_COS); float* sn = (float*)(F.ws() + WS_SIN);
      for (int i = F.bid * 512 + F.tid; i < SEQ * 32; i += F.G * 512) { const int pos = i >> 5, f = i & 31;
          const float inv = exp2f(-(float)f * (13.287712379549449f / 32.0f));
          const float angf = (float)pos * inv; const double rev = (double)angf * 0.15915494309189535; const float fr = (float)(rev - rint(rev));
          cs[i] = __builtin_amdgcn_cosf(fr); sn[i] = __builtin_amdgcn_sinf(fr); } }
    for (int r = gw; r < 2 * 512; r += NGW) { const int l = r >> 9, m = r & 511; rms_row_bf16(F.in(IN_MEM) + (size_t)m * DM, F.in(IN_MEMNG) + l * DM, (bf16_t*)(F.ws() + WS_MEMN) + (size_t)r * DM, F.lane); }
    { const float* xin = F.in(IN_X); const float* g1 = F.in(IN_N1G); bf16_t* XN = (bf16_t*)(F.ws() + WS_XN);
      for (int r0 = gw; r0 < TOK; r0 += 2 * NGW) {
          f32x4 v[2][4]; float ss[2] = {0.f, 0.f};
#pragma unroll
          for (int a = 0; a < 2; ++a) { const int r = min(r0 + a * NGW, TOK - 1);
#pragma unroll
              for (int j = 0; j < 4; ++j) { v[a][j] = ((const f32x4*)(xin + (size_t)r * DM))[F.lane + 64 * j]; ss[a] += (v[a][j].x * v[a][j].x + v[a][j].y * v[a][j].y) + (v[a][j].z * v[a][j].z + v[a][j].w * v[a][j].w); } }
#pragma unroll
          for (int a = 0; a < 2; ++a) { const int r = r0 + a * NGW; if (r >= TOK) break; const float rs = rsqrtf(wave_sum(ss[a]) * (1.f / DM) + EPS);
#pragma unroll
              for (int j = 0; j < 4; ++j) { const f32x4 gv = ((const f32x4*)g1)[F.lane + 64 * j]; const f32x4 o = v[a][j] * rs * gv;
                  u32x2 w; w.x = cvtpk(o.x, o.y); w.y = cvtpk(o.z, o.w); ((u32x2*)(XN + (size_t)r * DM))[F.lane + 64 * j] = w; } } } }
}

__device__ __forceinline__ int crow(int r, int hi) { return (r & 3) + 8 * (r >> 2) + 4 * hi; }
__device__ __forceinline__ s16x4 vtr(LAS const unsigned char* p) { typedef short v4i16_t __attribute__((ext_vector_type(4))); return __builtin_bit_cast(s16x4, __builtin_amdgcn_ds_read_tr16_b64_v4i16((LAS v4i16_t*)p)); }

struct AttnJob {
    const bf16_t* Q; int qpitch, qrow0, qstep;
    const bf16_t* K; const bf16_t* V; int kvpitch, krow0, kstep;
    int t0, ntiles;
    bf16_t* O; int opitch; float* lse; int lsepitch;
};
template <bool MEM> struct AttnStage { static constexpr int NSLOT = MEM ? 8 : 12, NL = NSLOT * 256 / 512; u32x4 k[NL], v[NL]; };

template <bool MEM>
__device__ __forceinline__ void attn_issue_loads(const AttnJob& J, AttnStage<MEM>& S, int tid) {
#pragma unroll
    for (int i = 0; i < AttnStage<MEM>::NL; ++i) { const int q = tid + 512 * i, slot = q >> 8, row = (q >> 3) & 31, c = q & 7;
        const int t = min(max(J.t0 + slot, 0), J.ntiles - 1); const size_t off = (size_t)(J.krow0 + (t * 32 + row) * J.kstep) * J.kvpitch + c * 8;
        S.k[i] = *(const u32x4*)(J.K + off); S.v[i] = *(const u32x4*)(J.V + off); }
}
template <bool MEM>
__device__ __forceinline__ void attn_write_lds(const AttnStage<MEM>& S, LAS unsigned char* lds, int tid) {
#pragma unroll
    for (int i = 0; i < AttnStage<MEM>::NL; ++i) { const int q = tid + 512 * i, slot = q >> 8, row = (q >> 3) & 31, c = q & 7;
        *(LAS u32x4*)(lds + slot * 4096 + row * 128 + ((c ^ ((row >> 1) & 7)) << 4)) = S.k[i];
        *(LAS u32x4*)(lds + 49152 + slot * 4096 + row * 128 + ((c << 4) ^ (((row >> 1) & 1) << 6))) = S.v[i]; }
}
template <bool MEM, int NTC, int LI0>
__device__ __forceinline__ void attn_chunk(const AttnJob& J, const bf16x8 (&qf)[4], LAS unsigned char* lds, int wave, const int (&ka)[4], int tv0, int tv1, int mt,
                                           f32x16 (&o)[2], float& m_run, f32x2& l_run) {
    f32x16 s[NTC];
#pragma unroll
    for (int kt = 0; kt < NTC; ++kt) {
        constexpr int dummy = 0; (void)dummy;
        const int li = LI0 + kt, slot = MEM ? li : (wave + li);
        bf16x8 kf[4];
#pragma unroll
        for (int d0 = 0; d0 < 4; ++d0) kf[d0] = *(const LAS bf16x8*)(lds + ka[d0] + li * 4096);
        f32x16 a;
#pragma unroll
        for (int r = 0; r < 16; ++r) a[r] = 0.f;
#pragma unroll
        for (int d0 = 0; d0 < 4; ++d0) a = __builtin_amdgcn_mfma_f32_32x32x16_bf16(kf[d0], qf[d0], a, 0, 0, 0);
        if (!MEM) { const int traw = J.t0 + slot;
            if (li == 0 || li == 4) {
#pragma unroll
                for (int r = 0; r < 16; ++r) { const int cr = (r & 3) + 8 * (r >> 2); const bool keep = (li == 0) ? (cr >= mt) : (cr <= mt); a[r] = keep ? a[r] : -1e30f; } }
            if (traw < 0 || traw >= J.ntiles) {
                asm volatile("" ::: "memory");
#pragma unroll
                for (int r = 0; r < 16; ++r) a[r] = -1e30f; } }
        s[kt] = a;
    }
    float mx = -1e30f;
#pragma unroll
    for (int kt = 0; kt < NTC; ++kt)
#pragma unroll
        for (int r = 0; r < 16; ++r) mx = fmaxf(mx, s[kt][r]);
    mx = xor32_max(mx);
    const float m_new = fmaxf(m_run, mx);
    if (LI0 > 0) { const float alpha = __builtin_amdgcn_exp2f(m_run - m_new); const f32x2 al2 = {alpha, alpha}; l_run *= al2;
#pragma unroll
        for (int r = 0; r < 16; r += 2) { const f32x2 x0 = (f32x2){o[0][r], o[0][r + 1]} * al2, x1 = (f32x2){o[1][r], o[1][r + 1]} * al2; o[0][r] = x0.x; o[0][r + 1] = x0.y; o[1][r] = x1.x; o[1][r + 1] = x1.y; } }
    m_run = m_new; const f32x2 mn2 = {m_new, m_new};
#pragma unroll
    for (int kt = 0; kt < NTC; ++kt) {
        const int li = LI0 + kt;
#pragma unroll
        for (int r = 0; r < 16; r += 2) { f32x2 d = (f32x2){s[kt][r], s[kt][r + 1]} - mn2; d.x = __builtin_amdgcn_exp2f(d.x); d.y = __builtin_amdgcn_exp2f(d.y); s[kt][r] = d.x; s[kt][r + 1] = d.y; l_run += d; }
        bf16x8 pb[2];
#pragma unroll
        for (int s2 = 0; s2 < 2; ++s2) { u32x4 w; w.x = cvtpk(s[kt][8 * s2 + 0], s[kt][8 * s2 + 1]); w.y = cvtpk(s[kt][8 * s2 + 2], s[kt][8 * s2 + 3]);
            w.z = cvtpk(s[kt][8 * s2 + 4], s[kt][8 * s2 + 5]); w.w = cvtpk(s[kt][8 * s2 + 6], s[kt][8 * s2 + 7]); pb[s2] = __builtin_bit_cast(bf16x8, w); }
#pragma unroll
        for (int db = 0; db < 2; ++db)
#pragma unroll
            for (int s2 = 0; s2 < 2; ++s2) { const int tb = (db == 0) ? tv0 : tv1;
                const s16x4 lo = vtr(lds + tb + li * 4096 + s2 * 2048), h8 = vtr(lds + tb + li * 4096 + s2 * 2048 + 1024);
                const bf16x8 va = (bf16x8){lo[0], lo[1], lo[2], lo[3], h8[0], h8[1], h8[2], h8[3]};
                o[db] = __builtin_amdgcn_mfma_f32_32x32x16_bf16(va, pb[s2], o[db], 0, 0, 0); }
    }
}
template <bool MEM>
__device__ __forceinline__ void attn_compute(const AttnJob& J, const bf16x8 (&qf)[4], LAS unsigned char* lds, int wave, int lane) {
    const int r32 = lane & 31, hi = lane >> 5;
    f32x16 o[2];
#pragma unroll
    for (int r = 0; r < 16; ++r) { o[0][r] = 0.f; o[1][r] = 0.f; }
    float m_run = -1e30f; f32x2 l_run = {0.f, 0.f};
    const int ksw = (r32 >> 1) & 7, koff = r32 * 128 + (MEM ? 0 : wave * 4096);
    const int q4 = (lane & 15) >> 2, sw = (q4 >> 1) & 1, trow = (4 * hi + q4) * 128, tcol = ((lane >> 4) & 1) * 32 + (lane & 3) * 8;
    const int tv0 = 49152 + (MEM ? 0 : wave * 4096) + trow + ((sw << 6) | tcol), tv1 = 49152 + (MEM ? 0 : wave * 4096) + trow + (((1 ^ sw) << 6) | tcol);
    int ka[4];
#pragma unroll
    for (int d0 = 0; d0 < 4; ++d0) ka[d0] = koff + (((2 * d0 + hi) ^ ksw) << 4);
    int mt = r32 - 4 * hi; asm volatile("" : "+v"(mt));
    if (MEM) { attn_chunk<MEM, 3, 0>(J, qf, lds, wave, ka, tv0, tv1, mt, o, m_run, l_run); attn_chunk<MEM, 3, 3>(J, qf, lds, wave, ka, tv0, tv1, mt, o, m_run, l_run);
               attn_chunk<MEM, 2, 6>(J, qf, lds, wave, ka, tv0, tv1, mt, o, m_run, l_run); }
    else     { attn_chunk<MEM, 3, 0>(J, qf, lds, wave, ka, tv0, tv1, mt, o, m_run, l_run); attn_chunk<MEM, 2, 3>(J, qf, lds, wave, ka, tv0, tv1, mt, o, m_run, l_run); }
    const float l = xor32_sum(l_run.x + l_run.y);
    const float inv = 1.0f / l;
    const int qrow = J.qrow0 + (wave * 32 + r32) * J.qstep;
    LAS unsigned char* ot = lds + 98304 + wave * 4096;
#pragma unroll
    for (int db = 0; db < 2; ++db)
#pragma unroll
        for (int g = 0; g < 4; ++g) { u32x2 w; w.x = cvtpk(o[db][4 * g] * inv, o[db][4 * g + 1] * inv); w.y = cvtpk(o[db][4 * g + 2] * inv, o[db][4 * g + 3] * inv);
            *(LAS u32x2*)(ot + r32 * 128 + (32 * db + 8 * g + 4 * hi) * 2) = w; }
    if (J.lse != nullptr && hi == 0) J.lse[(size_t)qrow * J.lsepitch] = m_run + __builtin_amdgcn_logf(l);
    LDS_WAIT();
    { const int c = lane & 7, rr = lane >> 3; const size_t obase = (size_t)(J.qrow0 + wave * 32 * J.qstep) * J.opitch;
#pragma unroll
      for (int i = 0; i < 4; ++i) { const int row = rr + 8 * i; *(u32x4*)(J.O + obase + (size_t)(row * J.qstep) * J.opitch + c * 8) = *(const LAS u32x4*)(ot + row * 128 + c * 16); } }
}
template <bool MEM, class MakeJob>
__device__ __forceinline__ void attn_block_units(Frame& F, int first, int count, int stride, const MakeJob& mk) {
    if (first >= count) return;
    AttnStage<MEM> S; AttnJob J = mk(first); bf16x8 qn[4];
#define ATTN_LOAD_Q(JJ) do { const int qrow_ = (JJ).qrow0 + (F.wave * 32 + (F.lane & 31)) * (JJ).qstep; const bf16_t* qp_ = (JJ).Q + (size_t)qrow_ * (JJ).qpitch + (F.lane >> 5) * 8; \
        _Pragma("unroll") for (int d0 = 0; d0 < 4; ++d0) qn[d0] = *(const bf16x8*)(qp_ + d0 * 16); } while (0)
    attn_issue_loads<MEM>(J, S, F.tid); ATTN_LOAD_Q(J);
    for (int u = first; u < count; u += stride) {
        bf16x8 qf[4];
#pragma unroll
        for (int d0 = 0; d0 < 4; ++d0) qf[d0] = qn[d0];
        __syncthreads();
        attn_write_lds<MEM>(S, F.lds, F.tid);
        __syncthreads();
        const int un = u + stride; AttnJob Jn = J;
        if (un < count) { Jn = mk(un); attn_issue_loads<MEM>(Jn, S, F.tid); ATTN_LOAD_Q(Jn); }
        attn_compute<MEM>(J, qf, F.lds, F.wave, F.lane);
        J = Jn;
    }
    __syncthreads();
#undef ATTN_LOAD_Q
}

template <class MkMem, class MkDil>
__device__ __forceinline__ void attn_mem_then_dil(Frame& F, int memu, int memcount, int first, int count, int stride, const MkMem& mkm, const MkDil& mkd) {
    AttnStage<false> S; AttnJob J = mkd(min(first, count - 1)); bf16x8 qn[4];
#define ATTN_LOAD_Q(JJ) do { const int qrow_ = (JJ).qrow0 + (F.wave * 32 + (F.lane & 31)) * (JJ).qstep; const bf16_t* qp_ = (JJ).Q + (size_t)qrow_ * (JJ).qpitch + (F.lane >> 5) * 8; \
        _Pragma("unroll") for (int d0 = 0; d0 < 4; ++d0) qn[d0] = *(const bf16x8*)(qp_ + d0 * 16); } while (0)
    if (memu < memcount) {
        AttnStage<true> Sm; const AttnJob Jm = mkm(memu);
        attn_issue_loads<true>(Jm, Sm, F.tid); ATTN_LOAD_Q(Jm);
        bf16x8 qf[4];
#pragma unroll
        for (int d0 = 0; d0 < 4; ++d0) qf[d0] = qn[d0];
        __syncthreads();
        attn_write_lds<true>(Sm, F.lds, F.tid);
        __syncthreads();
        if (first < count) { attn_issue_loads<false>(J, S, F.tid); ATTN_LOAD_Q(J); }
        attn_compute<true>(Jm, qf, F.lds, F.wave, F.lane);
    } else if (first < count) { attn_issue_loads<false>(J, S, F.tid); ATTN_LOAD_Q(J); }
    for (int u = first; u < count; u += stride) {
        bf16x8 qf[4];
#pragma unroll
        for (int d0 = 0; d0 < 4; ++d0) qf[d0] = qn[d0];
        __syncthreads();
        attn_write_lds<false>(S, F.lds, F.tid);
        __syncthreads();
        const int un = u + stride; AttnJob Jn = J;
        if (un < count) { Jn = mkd(un); attn_issue_loads<false>(Jn, S, F.tid); ATTN_LOAD_Q(Jn); }
        attn_compute<false>(J, qf, F.lds, F.wave, F.lane);
        J = Jn;
    }
    __syncthreads();
#undef ATTN_LOAD_Q
}

constexpr int POOL_DH = 40960, POOL_WT = POOL_DH + 64 * 528, POOL_DPITCH = 528, POOL_WPITCH = 144;
__device__ __forceinline__ void pool_unit(Frame& F, const bf16_t* PROJ, const float* pw, const float* pscale, bf16_t* YRAW, int tile) {
    const int tid = F.tid, row0 = tile * 64, pos0 = row0 & (SEQ - 1);
    LAS bf16_t* U = (LAS bf16_t*)F.lds;
    LAS unsigned char* Dh = F.lds + POOL_DH; LAS unsigned char* WT = F.lds + POOL_WT;
    { u32x4 uv[5];
#pragma unroll
      for (int q = 0; q < 5; ++q) { const int i = tid + 512 * q, r = i >> 5, ch = i & 31, pos = min(max(pos0 - 8 + r, 0), SEQ - 1);
          uv[q] = *(const u32x4*)(PROJ + (size_t)(row0 - pos0 + pos) * NIN + 1536 + ch * 8); }
#pragma unroll
      for (int q = 0; q < 5; ++q) { const int i = tid + 512 * q, r = i >> 5, ch = i & 31, pos = pos0 - 8 + r;
          *(LAS u32x4*)(U + r * 256 + ch * 8) = (pos >= 0 && pos < SEQ) ? uv[q] : (u32x4){0u, 0u, 0u, 0u}; } }
    { float pwv[32];
#pragma unroll
      for (int i = 0; i < 32; ++i) pwv[i] = pw[tid + 512 * i];
#pragma unroll
      for (int i = 0; i < 32; ++i) { const int idx = tid + 512 * i, dout = idx & 63, c = (idx >> 6) & 63, g = idx >> 12;
          *(LAS bf16_t*)(WT + (g * 64 + dout) * POOL_WPITCH + c * 2) = f2bf(pwv[i]); } }
    __syncthreads();
    { const int ch = tid & 255, g = ch >> 6, half = tid >> 8, w = 2 << g, left = w >> 1, right = w - 1 - left, i0 = half * 32;
      float s = 0.f;
#pragma unroll
      for (int k = 0; k < 16; ++k) if (k < w) s += bf1(U[(i0 - left + k + 8) * 256 + ch]);
#pragma unroll 2
      for (int ii = 0; ii < 32; ++ii) { const int i = i0 + ii, pos = pos0 + i; const int lo = max(pos - left, 0), hi = min(pos + right, SEQ - 1);
          *(LAS bf16_t*)(Dh + i * POOL_DPITCH + ch * 2) = f2bf(s / (float)(hi - lo + 1) - bf1(U[(i + 8) * 256 + ch]));
          s += bf1(U[(i + 1 + right + 8) * 256 + ch]) - bf1(U[(i - left + 8) * 256 + ch]); } }
    __syncthreads();
    { const int lane = F.lane, r32 = lane & 31, hi = lane >> 5, g = F.wave & 3, th = F.wave >> 2;
      bf16x8 af[4];
#pragma unroll
      for (int s = 0; s < 4; ++s) af[s] = *(const LAS bf16x8*)(Dh + (th * 32 + r32) * POOL_DPITCH + (g * 64 + 16 * s + 8 * hi) * 2);
#pragma unroll 1
      for (int nt = 0; nt < 2; ++nt) {
          f32x16 acc;
#pragma unroll
          for (int r = 0; r < 16; ++r) acc[r] = 0.f;
#pragma unroll
          for (int s = 0; s < 4; ++s) { const bf16x8 bfr = *(const LAS bf16x8*)(WT + (g * 64 + nt * 32 + r32) * POOL_WPITCH + (16 * s + 8 * hi) * 2);
              acc = __builtin_amdgcn_mfma_f32_32x32x16_bf16(bfr, af[s], acc, 0, 0, 0); }
          LAS unsigned char* yt = F.lds + (th * 32 + r32) * 528 + (g * 64 + nt * 32 + 4 * hi) * 2; const float* ps = pscale + g * 64 + nt * 32 + 4 * hi;
#pragma unroll
          for (int gq = 0; gq < 4; ++gq) { const f32x4 sc = *(const f32x4*)(ps + 8 * gq);
              u32x2 w; w.x = cvtpk(acc[4 * gq] * sc.x, acc[4 * gq + 1] * sc.y); w.y = cvtpk(acc[4 * gq + 2] * sc.z, acc[4 * gq + 3] * sc.w); *(LAS u32x2*)(yt + 16 * gq) = w; }
      } }
    __syncthreads();
#pragma unroll
    for (int i = 0; i < 4; ++i) { const int q = tid + 512 * i, tok = q >> 5, c = q & 31;
        *(u32x4*)(YRAW + (size_t)(row0 + tok) * 512 + c * 8) = *(const LAS u32x4*)(F.lds + tok * 528 + c * 16); }
    __syncthreads();
}

struct DilJob { const bf16_t* QH; bf16_t* AO; float* LSE;
    __device__ __forceinline__ AttnJob operator()(int bu) const {
        const int i8 = bu & 31, bhp = bu >> 5, p = bhp % 3, bh = bhp / 3, h = bh & 7, b = bh >> 3;
        const int dil = (p == 0) ? 1 : (p == 1 ? 4 : 16), tpr = 256 / dil, g8 = tpr >> 3, r = i8 / g8, jt0 = 8 * (i8 % g8);
        const size_t hs = (size_t)SEQ * 64;
        AttnJob J; J.Q = QH + (size_t)(b * 8 + h) * hs; J.qpitch = 64; J.qrow0 = r + jt0 * 32 * dil; J.qstep = dil;
        J.K = QH + (size_t)((2 + b) * 8 + h) * hs; J.V = QH + (size_t)((4 + b) * 8 + h) * hs; J.kvpitch = 64; J.krow0 = r; J.kstep = dil; J.t0 = jt0 - 2; J.ntiles = tpr;
        J.O = AO + (size_t)p * TOK * 512 + (size_t)b * SEQ * 512 + h * 64; J.opitch = 512; J.lse = LSE + (size_t)p * TOK * 8 + (size_t)b * SEQ * 8 + h; J.lsepitch = 8; return J; } };
struct MemJob { const bf16_t* PROJ; const bf16_t* MKV; bf16_t* YRAW;
    __device__ __forceinline__ AttnJob operator()(int mu) const {
        const int q8 = mu & 31, bh = mu >> 5, hm = bh & 3, b = bh >> 2;
        AttnJob J; J.Q = PROJ + 1792 + hm * 64; J.qpitch = NIN; J.qrow0 = b * SEQ + q8 * 256; J.qstep = 1;
        J.K = MKV + hm * 64; J.V = MKV + 256 + hm * 64; J.kvpitch = 512; J.krow0 = b * NMEM; J.kstep = 1; J.t0 = 0; J.ntiles = 8;
        J.O = YRAW + 256 + hm * 64; J.opitch = 512; J.lse = nullptr; J.lsepitch = 0; return J; } };

__device__ __forceinline__ void phase_mixers(Frame& F, int l, int parts = 7) {
    const bf16_t* PROJ = (const bf16_t*)(F.ws() + WS_PROJ); const bf16_t* QH = (const bf16_t*)(F.ws() + WS_QKVH);
    bf16_t* AO = (bf16_t*)(F.ws() + WS_AO); float* LSE = (float*)(F.ws() + WS_LSE); bf16_t* YRAW = (bf16_t*)(F.ws() + WS_YRAW);
    const bf16_t* MKV = (const bf16_t*)(F.ws() + WS_MEMKV) + (size_t)l * 512 * 512;
    if ((parts & 3) == 3) { DilJob mkd{QH, AO, LSE}; MemJob mkm{PROJ, MKV, YRAW};
        if (F.bid + F.G < 256) attn_block_units<true>(F, F.bid + F.G, 256, F.G, mkm);
        attn_mem_then_dil(F, F.bid, 256, F.bid, 1536, F.G, mkm, mkd); }
    else {
        if (parts & 1) { DilJob mk{QH, AO, LSE}; attn_block_units<false>(F, F.bid, 1536, F.G, mk); }
        if (parts & 2) { MemJob mk{PROJ, MKV, YRAW}; attn_block_units<true>(F, F.bid, 256, F.G, mk); } }
    if (parts & 4) for (int tile = F.bid; tile < TOK / 64; tile += F.G) pool_unit(F, PROJ, F.in(IN_POOLW) + (size_t)l * 4 * 64 * 64, F.in(IN_POOLS) + l * 256, YRAW, tile);
}

__device__ __forceinline__ void phase_combine_norm(Frame& F, int l) {
    const bf16_t* AO = (const bf16_t*)(F.ws() + WS_AO); const float* LSE = (const float*)(F.ws() + WS_LSE); const bf16_t* YRAW = (const bf16_t*)(F.ws() + WS_YRAW);
    bf16_t* Y = (bf16_t*)(F.ws() + WS_Y); const float* gg = F.in(IN_GRPG) + l * DM;
    const int gw = F.bid * 8 + F.wave, NGW = F.G * 8, lane = F.lane, head = lane >> 3;
    float lsn[2][3]; u32x4 avn[2][3]; u32x2 pvn[2], mvn[2];
#define CN_LOAD(r0_) do { _Pragma("unroll") for (int a = 0; a < 2; ++a) { const size_t row = (size_t)min((r0_) + a * NGW, TOK - 1); \
            _Pragma("unroll") for (int p = 0; p < 3; ++p) { lsn[a][p] = LSE[(size_t)p * TOK * 8 + row * 8 + head]; avn[a][p] = __builtin_nontemporal_load((const u32x4*)(AO + (size_t)p * TOK * 512 + row * 512 + lane * 8)); } \
            pvn[a] = *(const u32x2*)(YRAW + row * 512 + lane * 4); mvn[a] = *(const u32x2*)(YRAW + row * 512 + 256 + lane * 4); } } while (0)
    CN_LOAD(gw);
    for (int r0 = gw; r0 < TOK; r0 += 2 * NGW) {
        float ls[2][3]; u32x4 av[2][3]; u32x2 pv[2], mv[2];
#pragma unroll
        for (int a = 0; a < 2; ++a) { pv[a] = pvn[a]; mv[a] = mvn[a];
#pragma unroll
            for (int p = 0; p < 3; ++p) { ls[a][p] = lsn[a][p]; av[a][p] = avn[a][p]; } }
        if (r0 + 2 * NGW < TOK) CN_LOAD(r0 + 2 * NGW);
#pragma unroll
        for (int a = 0; a < 2; ++a) { const int rowi = r0 + a * NGW; if (rowi >= TOK) break; const size_t row = (size_t)rowi;
            const float l0 = ls[a][0], l1 = ls[a][1], l2 = ls[a][2]; const u32x4 a0 = av[a][0], a1 = av[a][1], a2 = av[a][2];
            const float mx = fmaxf(l0, fmaxf(l1, l2));
            float w0 = __builtin_amdgcn_exp2f(l0 - mx), w1 = __builtin_amdgcn_exp2f(l1 - mx), w2 = __builtin_amdgcn_exp2f(l2 - mx);
            const float wi = 1.0f / (w0 + w1 + w2); w0 *= wi; w1 *= wi; w2 *= wi;
            float y[8]; float ss = 0.f;
#pragma unroll
            for (int i = 0; i < 4; ++i) { y[2 * i] = w0 * bflo(a0[i]) + w1 * bflo(a1[i]) + w2 * bflo(a2[i]); y[2 * i + 1] = w0 * bfhi(a0[i]) + w1 * bfhi(a1[i]) + w2 * bfhi(a2[i]); ss += y[2 * i] * y[2 * i] + y[2 * i + 1] * y[2 * i + 1]; }
            const float p0 = bflo(pv[a].x), p1 = bfhi(pv[a].x), p2 = bflo(pv[a].y), p3 = bfhi(pv[a].y);
            const float q0 = bflo(mv[a].x), q1 = bfhi(mv[a].x), q2 = bflo(mv[a].y), q3 = bfhi(mv[a].y);
            float sp = p0 * p0 + p1 * p1 + p2 * p2 + p3 * p3, sq = q0 * q0 + q1 * q1 + q2 * q2 + q3 * q3;
            ss = wave_sum(ss); sp = wave_sum(sp); sq = wave_sum(sq);
            const float rs = rsqrtf(ss * (1.f / 512.f) + EPS), rp = rsqrtf(sp * (1.f / 256.f) + EPS), rq = rsqrtf(sq * (1.f / 256.f) + EPS);
            const f32x4 g0 = *(const f32x4*)(gg + lane * 8), g1 = *(const f32x4*)(gg + lane * 8 + 4), gp = *(const f32x4*)(gg + 512 + lane * 4), gq = *(const f32x4*)(gg + 768 + lane * 4);
            u32x4 wv; wv.x = cvtpk(y[0] * rs * g0.x, y[1] * rs * g0.y); wv.y = cvtpk(y[2] * rs * g0.z, y[3] * rs * g0.w); wv.z = cvtpk(y[4] * rs * g1.x, y[5] * rs * g1.y); wv.w = cvtpk(y[6] * rs * g1.z, y[7] * rs * g1.w);
            *(u32x4*)(Y + row * DM + lane * 8) = wv;
            u32x2 op; op.x = cvtpk(p0 * rp * gp.x, p1 * rp * gp.y); op.y = cvtpk(p2 * rp * gp.z, p3 * rp * gp.w); *(u32x2*)(Y + row * DM + 512 + lane * 4) = op;
            u32x2 oq; oq.x = cvtpk(q0 * rq * gq.x, q1 * rq * gq.y); oq.y = cvtpk(q2 * rq * gq.z, q3 * rq * gq.w); *(u32x2*)(Y + row * DM + 768 + lane * 4) = oq; }
    }
}

#undef CN_LOAD
__device__ __forceinline__ void phase_router(Frame& F, int l) {
    const bf16_t* X1 = (const bf16_t*)(F.ws() + WS_X1); unsigned char* H2 = F.ws() + WS_H2;
    const float* g2 = F.in(IN_N2G) + l * DM; const float* Wr = F.in(IN_RW) + (size_t)l * DM * NE; const float* rb = F.in(IN_RB) + l * NE;
    int* rt_e = (int*)(F.ws() + WS_RT); int* rt_rank = rt_e + TOK * TOPK; float* rt_gate = (float*)(rt_rank + TOK * TOPK); int* elist = (int*)(F.ws() + WS_ELIST);
    unsigned* gcnt = (unsigned*)(F.ws() + WS_CTL) + CW_CNT + 64 * l;
    LAS float* hb = (LAS float*)F.lds;
    LAS float* pl = (LAS float*)(F.lds + 65536);
    LAS int* lcnt = (LAS int*)(F.lds + MISC_OFF + 1024);
    LAS int* lbase = lcnt + 32;
    LAS int* le = lcnt + 64;
    LAS int* lrank = le + 256;
    const int lane = F.lane, e = lane & 31, half = lane >> 5, w = F.wave;
    f32x2 wreg[32];
#pragma unroll
    for (int i = 0; i < 32; ++i) { wreg[i].x = Wr[(size_t)(128 * w + 64 * half + 2 * i) * NE + e]; wreg[i].y = Wr[(size_t)(128 * w + 64 * half + 2 * i + 1) * NE + e]; }
    const float bias = rb[e];
    for (int tg = F.bid; tg < TOK / 64; tg += F.G) {
        if (F.tid < 32) lcnt[F.tid] = 0;
        __syncthreads();
        u32x2 xv[2][4];
#pragma unroll
        for (int i2 = 0; i2 < 2; ++i2)
#pragma unroll
            for (int j = 0; j < 4; ++j) xv[i2][j] = ((const u32x2*)(X1 + ((size_t)tg * 64 + 2 * w + i2) * DM))[lane + 64 * j];
#pragma unroll 1
        for (int b = 0; b < 4; ++b) {
#pragma unroll
            for (int i2 = 0; i2 < 2; ++i2) { const int ti = 2 * w + i2; const size_t row = (size_t)tg * 64 + 16 * b + ti;
                f32x4 v[4]; float ss = 0.f;
#pragma unroll
                for (int j = 0; j < 4; ++j) { v[j] = (f32x4){bflo(xv[i2][j].x), bfhi(xv[i2][j].x), bflo(xv[i2][j].y), bfhi(xv[i2][j].y)}; ss += (v[j].x * v[j].x + v[j].y * v[j].y) + (v[j].z * v[j].z + v[j].w * v[j].w); }
                const float rs = rsqrtf(wave_sum(ss) * (1.f / DM) + EPS);
#pragma unroll
                for (int j = 0; j < 4; ++j) { const f32x4 gv = ((const f32x4*)g2)[lane + 64 * j]; const f32x4 o = v[j] * rs * gv;
                    int w8 = 0; w8 = __builtin_amdgcn_cvt_pk_fp8_f32(o.x, o.y, w8, false); w8 = __builtin_amdgcn_cvt_pk_fp8_f32(o.z, o.w, w8, true); ((int*)(H2 + row * DM))[lane + 64 * j] = w8;
                    *(LAS f32x4*)(hb + ti * 1024 + (lane + 64 * j) * 4) = o; } }
            if (b < 3) {
#pragma unroll
                for (int i2 = 0; i2 < 2; ++i2)
#pragma unroll
                    for (int j = 0; j < 4; ++j) xv[i2][j] = ((const u32x2*)(X1 + ((size_t)tg * 64 + 16 * (b + 1) + 2 * w + i2) * DM))[lane + 64 * j]; }
            __syncthreads();
#pragma unroll 2
            for (int t = 0; t < 16; ++t) { const LAS float* hp = hb + t * 1024 + 128 * w + 64 * half; f32x2 a0 = {0.f, 0.f}, a1 = {0.f, 0.f};
#pragma unroll
                for (int i = 0; i < 64; i += 4) { const f32x4 hv = *(const LAS f32x4*)(hp + i); a0 += (f32x2){hv.x, hv.y} * wreg[i >> 1]; a1 += (f32x2){hv.z, hv.w} * wreg[(i >> 1) + 1]; }
                const float p = xor32_sum((a0.x + a0.y) + (a1.x + a1.y));
                if (lane < 32) pl[(w * 16 + t) * 32 + e] = p; }
            __syncthreads();
#pragma unroll
            for (int i2 = 0; i2 < 2; ++i2) { const int ti = 2 * w + i2, tl = 16 * b + ti;
                float v = bias;
#pragma unroll
                for (int ww = 0; ww < 8; ++ww) v += pl[(ww * 16 + ti) * 32 + e];
                float tv[4]; int tix[4];
#pragma unroll
                for (int k = 0; k < 4; ++k) { float bv = v; int bi = e;
#define TOPK_STEP(M) { const float ov = swz_f<M>(bv); const int oi = swz_i<M>(bi); if (ov > bv || (ov == bv && oi < bi)) { bv = ov; bi = oi; } }
                    TOPK_STEP(1) TOPK_STEP(2) TOPK_STEP(4) TOPK_STEP(8)
#undef TOPK_STEP
                    { const auto rv = __builtin_amdgcn_permlane16_swap(__float_as_uint(bv), __float_as_uint(bv), false, false); const auto ri = __builtin_amdgcn_permlane16_swap((unsigned)bi, (unsigned)bi, false, false);
                      const float v0 = __uint_as_float(rv[0]), v1 = __uint_as_float(rv[1]); const int i0 = (int)ri[0], i1 = (int)ri[1];
                      const bool t1 = (v1 > v0) || (v1 == v0 && i1 < i0); bv = t1 ? v1 : v0; bi = t1 ? i1 : i0; }
                    tv[k] = bv; tix[k] = bi; if (e == bi) v = -3.0e38f; }
                const float e1 = __expf(tv[1] - tv[0]), e2 = __expf(tv[2] - tv[0]), e3 = __expf(tv[3] - tv[0]); const float isum = 1.0f / (1.0f + e1 + e2 + e3);
                if (lane < 4) { const int me = (lane == 0) ? tix[0] : (lane == 1) ? tix[1] : (lane == 2) ? tix[2] : tix[3];
                    const float gt = ((lane == 0) ? 1.0f : (lane == 1) ? e1 : (lane == 2) ? e2 : e3) * isum;
                    const int lr = __hip_atomic_fetch_add(lcnt + me, 1, __ATOMIC_RELAXED, __HIP_MEMORY_SCOPE_WORKGROUP);
                    le[tl * 4 + lane] = me; lrank[tl * 4 + lane] = lr; rt_gate[((size_t)tg * 64 + tl) * 4 + lane] = gt; } }
        }
        __syncthreads();
        if (F.tid < 32) lbase[F.tid] = (int)__hip_atomic_fetch_add(gcnt + F.tid, (unsigned)lcnt[F.tid], __ATOMIC_RELAXED, __HIP_MEMORY_SCOPE_AGENT);
        __syncthreads();
        if (F.tid < 256) { const int me = le[F.tid], rk = lbase[me] + lrank[F.tid]; rt_e[(size_t)tg * 256 + F.tid] = me; rt_rank[(size_t)tg * 256 + F.tid] = rk; elist[(size_t)me * TOK + rk] = tg * 64 + (F.tid >> 2); }
        __syncthreads();
    }
}

__device__ __forceinline__ LAS int* moe_tile_table(Frame& F, int l) {
    LAS int* tstart = (LAS int*)(F.lds + MISC_OFF + 512);
    const unsigned* gcnt = (const unsigned*)(F.ws() + WS_CTL) + CW_CNT + 64 * l;
    if (F.tid < 64) {
        const int e = F.lane & 31; const int cnt = (int)__hip_atomic_load(gcnt + e, __ATOMIC_RELAXED, __HIP_MEMORY_SCOPE_AGENT); const int mt = (cnt + 255) >> 8;
        int inc = mt;
#pragma unroll
        for (int o = 1; o < 32; o <<= 1) { const int t = __builtin_amdgcn_ds_bpermute(((F.lane - o) & 63) << 2, inc); if (e >= o) inc += t; }
        if (F.lane < 32) { tstart[80 + e] = cnt; tstart[40 + e] = mt; tstart[e] = inc - mt; if (e == 31) tstart[32] = inc; } }
    __syncthreads();
    return tstart;
}

__device__ __forceinline__ void phase_moe_combine(Frame& F, int l) {
    const bf16_t* X1 = (const bf16_t*)(F.ws() + WS_X1); bf16_t* X2 = (bf16_t*)(F.ws() + WS_X2); const unsigned char* YS = F.ws() + WS_YS;
    LAS int* tstart = moe_tile_table(F, l);
    const int* rt_e = (const int*)(F.ws() + WS_RT); const int* rt_rank = rt_e + TOK * TOPK; const float* rt_gate = (const float*)(F.ws() + WS_RT) + 2 * TOK * TOPK;
    bf16_t* XN = (bf16_t*)(F.ws() + WS_XN);
    const bool lastl = (l == DEPTH - 1);
    const float* gn = lastl ? F.in(IN_FING) : (F.in(IN_N1G) + (l + 1) * DM);
    const int gw = F.bid * 8 + F.wave, NGW = F.G * 8, lane = F.lane;
    typedef int i32x4 __attribute__((ext_vector_type(4)));
    i32x4 een[2], sln[2]; f32x4 gtn[2];
#pragma unroll
    for (int a = 0; a < 2; ++a) { const int t = min(gw + a * NGW, TOK - 1); een[a] = *(const i32x4*)(rt_e + (size_t)t * 4); sln[a] = *(const i32x4*)(rt_rank + (size_t)t * 4); gtn[a] = *(const f32x4*)(rt_gate + (size_t)t * 4); }
    for (int t0 = gw; t0 < TOK; t0 += 2 * NGW) {
        i32x4 sl[2]; f32x4 gt[2]; f32x4 v[2][4]; u32x4 xb[2][2]; u32x2 y[2][4][2];
#pragma unroll
        for (int a = 0; a < 2; ++a) { const int t = min(t0 + a * NGW, TOK - 1); const i32x4 ee = een[a]; sl[a] = sln[a]; gt[a] = gtn[a];
            sl[a].x += tstart[ee.x] * 256; sl[a].y += tstart[ee.y] * 256; sl[a].z += tstart[ee.z] * 256; sl[a].w += tstart[ee.w] * 256;
            const bf16_t* xr = X1 + (size_t)t * DM + lane * 8; xb[a][0] = *(const u32x4*)xr; xb[a][1] = *(const u32x4*)(xr + 512); }
#pragma unroll
        for (int a = 0; a < 2; ++a)
#pragma unroll
            for (int k = 0; k < 4; ++k) { const unsigned char* yr = YS + (size_t)sl[a][k] * DM + lane * 8; y[a][k][0] = __builtin_nontemporal_load((const u32x2*)yr); y[a][k][1] = __builtin_nontemporal_load((const u32x2*)(yr + 512)); }
#pragma unroll
        for (int a = 0; a < 2; ++a) { const int t = min(t0 + 2 * NGW + a * NGW, TOK - 1); een[a] = *(const i32x4*)(rt_e + (size_t)t * 4); sln[a] = *(const i32x4*)(rt_rank + (size_t)t * 4); gtn[a] = *(const f32x4*)(rt_gate + (size_t)t * 4); }
#pragma unroll
        for (int a = 0; a < 2; ++a) { const int t = t0 + a * NGW; if (t >= TOK) break;
#pragma unroll
            for (int hf = 0; hf < 2; ++hf) { const u32x4 r = xb[a][hf]; v[a][2 * hf] = (f32x4){bflo(r.x), bfhi(r.x), bflo(r.y), bfhi(r.y)}; v[a][2 * hf + 1] = (f32x4){bflo(r.z), bfhi(r.z), bflo(r.w), bfhi(r.w)}; }
#pragma unroll
            for (int k = 0; k < 4; ++k) { const float g = gt[a][k];
#pragma unroll
                for (int hf = 0; hf < 2; ++hf) { const u32x2 yy = y[a][k][hf];
                    const f32x2 p0 = __builtin_amdgcn_cvt_pk_f32_fp8((int)yy.x, false), p1 = __builtin_amdgcn_cvt_pk_f32_fp8((int)yy.x, true), p2 = __builtin_amdgcn_cvt_pk_f32_fp8((int)yy.y, false), p3 = __builtin_amdgcn_cvt_pk_f32_fp8((int)yy.y, true);
                    v[a][2 * hf][0] += g * p0.x; v[a][2 * hf][1] += g * p0.y; v[a][2 * hf][2] += g * p1.x; v[a][2 * hf][3] += g * p1.y;
                    v[a][2 * hf + 1][0] += g * p2.x; v[a][2 * hf + 1][1] += g * p2.y; v[a][2 * hf + 1][2] += g * p3.x; v[a][2 * hf + 1][3] += g * p3.y; } }
            float ss = 0.f;
#pragma unroll
            for (int j = 0; j < 4; ++j) ss += (v[a][j].x * v[a][j].x + v[a][j].y * v[a][j].y) + (v[a][j].z * v[a][j].z + v[a][j].w * v[a][j].w);
            const float rs = rsqrtf(wave_sum(ss) * (1.f / DM) + EPS);
            const float* gr = gn + lane * 8; f32x4 o[4];
            o[0] = v[a][0] * rs * *(const f32x4*)gr; o[1] = v[a][1] * rs * *(const f32x4*)(gr + 4); o[2] = v[a][2] * rs * *(const f32x4*)(gr + 512); o[3] = v[a][3] * rs * *(const f32x4*)(gr + 516);
            if (lastl) { float* orow = F.out() + (size_t)t * DM + lane * 8; *(f32x4*)orow = o[0]; *(f32x4*)(orow + 4) = o[1]; *(f32x4*)(orow + 512) = o[2]; *(f32x4*)(orow + 516) = o[3]; }
            else { bf16_t* xr = X2 + (size_t)t * DM + lane * 8; u32x4 x0, x1;
                x0.x = cvtpk(v[a][0].x, v[a][0].y); x0.y = cvtpk(v[a][0].z, v[a][0].w); x0.z = cvtpk(v[a][1].x, v[a][1].y); x0.w = cvtpk(v[a][1].z, v[a][1].w);
                x1.x = cvtpk(v[a][2].x, v[a][2].y); x1.y = cvtpk(v[a][2].z, v[a][2].w); x1.z = cvtpk(v[a][3].x, v[a][3].y); x1.w = cvtpk(v[a][3].z, v[a][3].w);
                *(u32x4*)xr = x0; *(u32x4*)(xr + 512) = x1;
                bf16_t* nr = XN + (size_t)t * DM + lane * 8; u32x4 w0, w1;
                w0.x = cvtpk(o[0].x, o[0].y); w0.y = cvtpk(o[0].z, o[0].w); w0.z = cvtpk(o[1].x, o[1].y); w0.w = cvtpk(o[1].z, o[1].w);
                w1.x = cvtpk(o[2].x, o[2].y); w1.y = cvtpk(o[2].z, o[2].w); w1.z = cvtpk(o[3].x, o[3].y); w1.w = cvtpk(o[3].z, o[3].w);
                *(u32x4*)nr = w0; *(u32x4*)(nr + 512) = w1; }
        }
    }
}

constexpr int PH_PER_LAYER = 8, N_PHASES = 1 + DEPTH * PH_PER_LAYER;

__global__ void __launch_bounds__(512, 2) enc_fwd(Args args) {
    extern __shared__ __attribute__((aligned(16))) unsigned char lds_raw[];
    Frame F;
    const int wave0 = __builtin_amdgcn_readfirstlane((int)threadIdx.x >> 6);
    F.lds = (LAS unsigned char*)lds_raw; F.lane = (int)__builtin_amdgcn_mbcnt_hi(~0u, __builtin_amdgcn_mbcnt_lo(~0u, 0u)); F.wave = wave0; F.tid = wave0 * 64 + F.lane; F.G = gridDim.x; F.bid = blockIdx.x;
    static_assert(sizeof(Args) == 168, "kernarg layout: in[18] | out | ws | ph_lo, ph_hi");
    F.kp = (const CAS unsigned char*)__builtin_amdgcn_kernarg_segment_ptr();
    const int lo = args.ph_lo, hi = args.ph_hi;
    volatile LAS unsigned* bst = (volatile LAS unsigned*)(F.lds + MISC_OFF + 64);
    if (F.tid < 2) bst[F.tid] = 0u;
    __syncthreads();
    XcdBarrier xbar; xbar.bar = (unsigned*)(F.ws() + WS_CTL) + CW_BAR; xbar.x = 0; xbar.st = bst;
    if (hi - lo > 1) xbar = xcd_barrier_post((unsigned*)(F.ws() + WS_CTL) + CW_BAR, bst, F.tid);
    for (int ph = lo; ph < hi; ++ph) {
        int phv = ph; asm volatile("" : "+s"(phv));
        { int lv = (int)__builtin_amdgcn_mbcnt_hi(~0u, __builtin_amdgcn_mbcnt_lo(~0u, 0u)); asm volatile("" : "+v"(lv)); F.lane = lv; F.wave = wave0; F.tid = wave0 * 64 + lv;
          int bv = blockIdx.x; asm volatile("" : "+s"(bv)); F.bid = bv;
          const CAS unsigned char* kpv = (const CAS unsigned char*)__builtin_amdgcn_kernarg_segment_ptr(); asm volatile("" : "+s"(kpv)); F.kp = kpv; }
        if (phv == 0) prologue(F);
#ifdef PROBE_VARIANT
        else if (phv >= 100) phase_mixers(F, 0, phv - 100);
#endif
        else {
            const int l = (phv - 1) / PH_PER_LAYER, k = (phv - 1) % PH_PER_LAYER;
            const int vcu = (F.G % 8 == 0) ? (F.bid % 8) * (F.G / 8) + F.bid / 8 : F.bid;
            if (k == 0) {
                { pg8::Gemm g{(const bf16_t*)(F.ws() + WS_XN), (const bf16_t*)(F.ws() + WS_WIN) + (size_t)l * NIN * DM, DM, 0}; pg8::StaticOrder S; S.init(TOK, NIN, F.G, F.bid);
                  pg8::EpiProj E{(bf16_t*)(F.ws() + WS_PROJ), (const float*)(F.ws() + WS_COS), (const float*)(F.ws() + WS_SIN), (bf16_t*)(F.ws() + WS_QKVH)};
                  pg8::gemm_phase<pg8::EpiProj, pg8::StaticOrder, true, true>(F.lds, F.tid, g, S, E); }
                if (l == 0) {
                    for (int ll = 0; ll < DEPTH; ++ll) {
                        pg8::Gemm g{(const bf16_t*)(F.ws() + WS_MEMN) + (size_t)ll * 512 * DM, (const bf16_t*)(F.ws() + WS_WMKV) + (size_t)ll * 512 * DM, DM, 0}; pg8::StaticOrder S; S.init(512, 512, F.G, (F.bid + F.G - 8 - 8 * ll) % F.G);
                        pg8::EpiBf16 E{(bf16_t*)(F.ws() + WS_MEMKV) + (size_t)ll * 512 * 512, 512, nullptr, 0, 1.0f};
                        pg8::gemm_phase<pg8::EpiBf16, pg8::StaticOrder, false, true>(F.lds, F.tid, g, S, E); }
                    { unsigned* ctl = (unsigned*)(F.ws() + WS_CTL); __syncthreads(); if (F.tid == 0) __hip_atomic_fetch_add(ctl + CW_DONE, 1u, __ATOMIC_RELAXED, __HIP_MEMORY_SCOPE_AGENT); w8_help(F, ctl + CW_W8NEXT, ctl + CW_DONE); }
                }
            } else if (k == 1) phase_mixers(F, l);
            else if (k == 2) phase_combine_norm(F, l);
            else if (k == 3) {
                pg8::Gemm g{(const bf16_t*)(F.ws() + WS_Y), (const bf16_t*)(F.ws() + WS_WOUT) + (size_t)l * DM * DM, DM, 0}; pg8::StaticOrder S; S.init(TOK, DM, F.G, F.bid);
                if (l == 0) { pg8::EpiRes<false> E{F.in(IN_X), (bf16_t*)(F.ws() + WS_X1)}; pg8::gemm_phase<pg8::EpiRes<false>, pg8::StaticOrder, false, true>(F.lds, F.tid, g, S, E); }
                else        { pg8::EpiRes<true> E{F.ws() + WS_X2, (bf16_t*)(F.ws() + WS_X1)}; pg8::gemm_phase<pg8::EpiRes<true>, pg8::StaticOrder, false, true>(F.lds, F.tid, g, S, E); }
            } else if (k == 4) { w8_help(F, (unsigned*)(F.ws() + WS_CTL) + CW_W8NEXT, nullptr, (l == 0) ? W8_Q_DN0 : W8_Q_TOTAL); phase_router(F, l); }
            else if (k == 5) {
                LAS int* tstart = moe_tile_table(F, l);
                pg8::MoeOrder S{tstart, 8, 4, F.G, vcu};
                LAS int* gtok = (LAS int*)(F.lds + MISC_OFF + 4096);
                { const int* elist = (const int*)(F.ws() + WS_ELIST); int tkv[9];
#pragma unroll
                  for (int i = 0; i < 9; ++i) { pg8::Unit u; const bool ok = S.next(i, u); const int ee = ok ? u.e : 0, idx = ok ? (u.pm - tstart[ee]) * 256 + (F.tid & 255) : 0;
                      const int tk = elist[(size_t)ee * TOK + idx]; tkv[i] = (ok && idx < tstart[80 + ee]) ? tk : 0; }
                  if (F.tid < 256) {
#pragma unroll
                      for (int i = 0; i < 9; ++i) gtok[i * 256 + F.tid] = tkv[i]; }
                  __syncthreads(); }
                pg8::Gemm g{(const bf16_t*)(F.ws() + WS_H2), (const bf16_t*)(F.ws() + WS_WGU + (size_t)l * NE * 2048 * DM), DM, (size_t)2048 * DM, gtok};
                pg8::EpiSwiglu E{F.ws() + WS_ACT, F.in(IN_BGU) + (size_t)l * NE * 2048, 1.0f / W8SCALE};
                pg8::gemm_phase<pg8::EpiSwiglu, pg8::MoeOrder, true, true, true, true>(F.lds, F.tid, g, S, E);
                if (l == 0) { unsigned* ctl = (unsigned*)(F.ws() + WS_CTL); __syncthreads(); if (F.tid == 0) __hip_atomic_fetch_add(ctl + CW_DONE + 64 * 5, 1u, __ATOMIC_RELAXED, __HIP_MEMORY_SCOPE_AGENT); w8_help(F, ctl + CW_W8NEXT, ctl + CW_DONE + 64 * 5); }
            } else if (k == 6) {
                LAS int* tstart = moe_tile_table(F, l);
                pg8::Gemm g{(const bf16_t*)(F.ws() + WS_ACT), (const bf16_t*)(F.ws() + WS_WDN + (size_t)l * NE * DM * DM), DM, (size_t)DM * DM};
                pg8::MoeOrder S{tstart, 4, 8, F.G, vcu};
                pg8::EpiF8 E{F.ws() + WS_YS, DM, F.in(IN_BDN) + (size_t)l * NE * DM, DM, 1.0f / W8SCALE};
                pg8::gemm_phase<pg8::EpiF8, pg8::MoeOrder, true, true, true>(F.lds, F.tid, g, S, E);
                if (l == 0) { unsigned* ctl = (unsigned*)(F.ws() + WS_CTL); __syncthreads(); if (F.tid == 0) __hip_atomic_fetch_add(ctl + CW_DONE + 64 * 6, 1u, __ATOMIC_RELAXED, __HIP_MEMORY_SCOPE_AGENT); w8_help(F, ctl + CW_W8NEXT, ctl + CW_DONE + 64 * 6); }
            } else phase_moe_combine(F, l);
        }
        if (ph + 1 < hi) { if (lo < 0) cg::this_grid().sync(); else { xbar.bar = (unsigned*)(F.ws() + WS_CTL) + CW_BAR; xcd_barrier(xbar, F.tid); } }
    }
}

extern "C" void kernel_launch(void* const* d_in, const int* in_sizes, int n_in, void* d_out, int out_size, void* d_ws, size_t ws_size, hipStream_t stream) {
    static int grid = 0;
    if (grid == 0) {
        if (n_in != 18 || in_sizes[0] != TOK * DM || out_size != TOK * DM || ws_size < WS_END) { fprintf(stderr, "kernel_launch: unexpected shapes / workspace (n_in %d, ws %zu)\n", n_in, ws_size); grid = -1; return; }
        int dev = 0, cus = 0, per_cu = 0;
        if (hipGetDevice(&dev) != hipSuccess || hipDeviceGetAttribute(&cus, hipDeviceAttributeMultiprocessorCount, dev) != hipSuccess) { grid = -1; return; }
        if (hipFuncSetAttribute((const void*)enc_fwd, hipFuncAttributeMaxDynamicSharedMemorySize, LDS_BYTES) != hipSuccess) { fprintf(stderr, "kernel_launch: hipFuncSetAttribute failed\n"); grid = -1; return; }
        if (hipOccupancyMaxActiveBlocksPerMultiprocessor(&per_cu, (const void*)enc_fwd, 512, LDS_BYTES) != hipSuccess || per_cu < 1) { fprintf(stderr, "kernel_launch: note: occupancy query says %d blocks/CU\n", per_cu); (void)hipGetLastError(); }
        grid = cus;
    }
    if (grid < 0) return;
    (void)hipMemsetAsync((char*)d_ws + WS_CTL, 0, CTL_BYTES, stream);
    Args a{};
    for (int i = 0; i < 18; ++i) a.in[i] = (const float*)d_in[i];
    a.out = (float*)d_out; a.ws = (unsigned char*)d_ws;
#if MK_ONE_LAUNCH
    a.ph_lo = 0; a.ph_hi = N_PHASES;
    void* kargs[] = {&a};
    hipError_t e = hipLaunchCooperativeKernel((const void*)enc_fwd, dim3(grid), dim3(512), kargs, LDS_BYTES, stream);
    if (e != hipSuccess) fprintf(stderr, "cooperative launch failed: %s (grid %d)\n", hipGetErrorString(e), grid);
#else
    for (int p = 0; p < N_PHASES; ++p) { a.ph_lo = p; a.ph_hi = p + 1; hipLaunchKernelGGL(enc_fwd, dim3(grid), dim3(512), LDS_BYTES, stream, a);
#ifdef PROBE_PH
        if (p == PROBE_PH) for (int r = 0; r < PROBE_REP; ++r) {
#ifdef PROBE_VARIANT
            a.ph_lo = PROBE_VARIANT; a.ph_hi = PROBE_VARIANT + 1;
#endif
            hipLaunchKernelGGL(enc_fwd, dim3(grid), dim3(512), LDS_BYTES, stream, a); }
#endif
    }
#endif
}
```

```cpp
#include <hip/hip_runtime.h>
#include <hip/hip_cooperative_groups.h>
#include <cstdio>
#include <cstdint>
namespace cg = cooperative_groups;

#ifndef MK_ONE_LAUNCH
#define MK_ONE_LAUNCH 1
#endif

#define LAS __attribute__((address_space(3)))
typedef unsigned short bf16_t;
typedef short bf16x8 __attribute__((ext_vector_type(8)));
typedef short s16x4 __attribute__((ext_vector_type(4)));
typedef float f32x4 __attribute__((ext_vector_type(4)));
typedef float f32x2 __attribute__((ext_vector_type(2)));
typedef float f32x16 __attribute__((ext_vector_type(16)));
typedef unsigned u32x4 __attribute__((ext_vector_type(4)));
typedef unsigned u32x2 __attribute__((ext_vector_type(2)));

constexpr int BATCH = 2, SEQ = 8192, TOK = BATCH * SEQ, DM = 1024, NIN = 2048, NE = 32, TOPK = 4, NMEM = 256, DEPTH = 2;
constexpr float EPS = 1e-5f;
constexpr float QSCALE = 0.125f * 1.4426950408889634f;
constexpr int MAXT = 288;
constexpr float W8SCALE = 32.0f;

constexpr size_t MiB = 1u << 20;
constexpr size_t WS_CTL = 0, CTL_BYTES = 64 * 1024;
constexpr size_t WS_COS = 1 * MiB, WS_SIN = 2 * MiB;
constexpr size_t WS_WIN = 4 * MiB;
constexpr size_t WS_WOUT = 12 * MiB;
constexpr size_t WS_WMKV = 16 * MiB;
constexpr size_t WS_MEMKV = 18 * MiB;
constexpr size_t WS_MEMN = 20 * MiB;
constexpr size_t WS_RT = 22 * MiB;
constexpr size_t WS_LSE = 24 * MiB;
constexpr size_t WS_WGU = 32 * MiB;
constexpr size_t WS_WDN = 288 * MiB;
constexpr size_t WS_XN = 416 * MiB;
constexpr size_t WS_PROJ = 448 * MiB;
constexpr size_t WS_AO = 512 * MiB;
constexpr size_t WS_YRAW = 560 * MiB;
constexpr size_t WS_Y = 576 * MiB;
constexpr size_t WS_X1 = 608 * MiB;
constexpr size_t WS_X2 = 672 * MiB;
constexpr size_t WS_H2 = 736 * MiB;
constexpr size_t WS_ASLOT = 768 * MiB;
constexpr size_t WS_ACT = 912 * MiB;
constexpr size_t WS_YS = 1056 * MiB;
constexpr size_t WS_QKVH = 1200 * MiB;
constexpr size_t WS_ELIST = 1248 * MiB;
constexpr size_t WS_END = 1252 * MiB;
constexpr int CW_CNT = 1024;
constexpr int CW_BAR = 4096;
constexpr int CW_W8NEXT = 2048;
constexpr int CW_DONE = 2112;

constexpr int RING_BYTES = 131072, MISC_OFF = RING_BYTES, LDS_BYTES = 147456;

__device__ __forceinline__ unsigned cvtpk(float lo, float hi) { typedef __bf16 bf2 __attribute__((ext_vector_type(2))); f32x2 v = {lo, hi}; bf2 b = __builtin_convertvector(v, bf2); return __builtin_bit_cast(unsigned, b); }
__device__ __forceinline__ float bflo(unsigned u) { return __uint_as_float(u << 16); }
__device__ __forceinline__ float bfhi(unsigned u) { return __uint_as_float(u & 0xffff0000u); }
__device__ __forceinline__ float bf1(bf16_t u) { return __uint_as_float(((unsigned)u) << 16); }
__device__ __forceinline__ bf16_t f2bf(float f) { return (bf16_t)(cvtpk(f, 0.f) & 0xffffu); }
template <int M> __device__ __forceinline__ int swz_i(int v) { constexpr int ctrl = (M == 1) ? 0xB1 : (M == 2) ? 0x4E : (M == 4) ? 0x141 : 0x140; static_assert(M == 1 || M == 2 || M == 4 || M == 8, "dpp step");
    return __builtin_amdgcn_update_dpp(v, v, ctrl, 0xf, 0xf, true); }
template <int M> __device__ __forceinline__ float swz_f(float v) { return __int_as_float(swz_i<M>(__float_as_int(v))); }
__device__ __forceinline__ float xor16_sum(float v) { auto r = __builtin_amdgcn_permlane16_swap(__float_as_uint(v), __float_as_uint(v), false, false); return __uint_as_float(r[0]) + __uint_as_float(r[1]); }
__device__ __forceinline__ float xor32_sum(float v) { auto r = __builtin_amdgcn_permlane32_swap(__float_as_uint(v), __float_as_uint(v), false, false); return __uint_as_float(r[0]) + __uint_as_float(r[1]); }
__device__ __forceinline__ float xor32_max(float v) { auto r = __builtin_amdgcn_permlane32_swap(__float_as_uint(v), __float_as_uint(v), false, false); return fmaxf(__uint_as_float(r[0]), __uint_as_float(r[1])); }
__device__ __forceinline__ float wave_sum(float v) {
    v += swz_f<1>(v); v += swz_f<2>(v); v += swz_f<4>(v); v += swz_f<8>(v);
    return xor32_sum(xor16_sum(v));
}
#define LDS_WAIT() asm volatile("s_waitcnt lgkmcnt(0)" ::: "memory")

namespace pg8 {
typedef int i32x4_t __attribute__((ext_vector_type(4)));
typedef int i32x8_t __attribute__((ext_vector_type(8)));
constexpr int BM = 256, BK = 64, HALF = 128, HTB = HALF * BK * 2, STAGE_BYTES = 8 * HTB, NXCD = 8, WGM = 8;
__host__ __device__ __forceinline__ int lds_byte(int r, int c) { const int st = (r >> 4) * 2 + (c >> 5), rr = r & 15, cc = c & 31, ob = rr * 64 + cc * 2; return st * 1024 + (ob ^ (((ob >> 9) & 1) << 5)); }
__host__ __device__ __forceinline__ void stage_rc(int b, int& R, int& C) { const int st = b / 1024, sb = b % 1024, swz = sb ^ (((sb >> 9) & 1) << 5); R = (st >> 1) * 16 + swz / 64; C = (st & 1) * 32 + (swz % 64) / 2; }
__host__ __device__ __forceinline__ int perm32(int rho) { const int n = rho >> 4, i = rho & 15; return 8 * (i >> 2) + 4 * n + (i & 3); }

struct Unit { int pm, pn, e; };
struct Gemm { const bf16_t* A; const bf16_t* Bt; int K; size_t ebytes; const LAS int* gtok; };

struct StaticOrder {
    int nM, nN, nwg, G, c;
    __device__ void init(int M, int N, int G_, int c_) { nM = M / BM; nN = N / BM; nwg = nM * nN; G = G_; c = c_; }
    __device__ bool next(int i, Unit& u) const {
        const long L = (long)i * G + c; if (L >= nwg) return false;
        int wgid = (int)L; { const int q = nwg / NXCD, r = nwg % NXCD, xcd = wgid % NXCD, off = wgid / NXCD; wgid = (xcd < r ? xcd * (q + 1) : r * (q + 1) + (xcd - r) * q) + off; }
        const int nig = WGM * nN, gid = wgid / nig, fm = gid * WGM, gsz = (nM - fm) < WGM ? (nM - fm) : WGM;
        u.pm = fm + ((wgid % nig) % gsz); u.pn = (wgid % nig) / gsz; u.e = 0; return true;
    }
};
struct MoeOrder {
    const LAS int* tstart; int nN, GM, G, c;
    __device__ bool next(int i, Unit& u) const {
        const int total = tstart[32] * nN; const long L = (long)i * G + c; if (L >= total) return false;
        const int pmL = (int)L / nN; int e = 0;
#pragma unroll
        for (int k = 1; k < 32; ++k) e += (tstart[k] <= pmL) ? 1 : 0;
        const int t0 = tstart[e], mt = tstart[e + 1] - t0, w = (int)L - t0 * nN;
        const int grp = w / (GM * nN), wg = w - grp * GM * nN, rem = mt - grp * GM, gsz = rem < GM ? rem : GM;
        u.pm = __builtin_amdgcn_readfirstlane(t0 + grp * GM + wg % gsz); u.pn = __builtin_amdgcn_readfirstlane(wg / gsz); u.e = __builtin_amdgcn_readfirstlane(e); return true;
    }
};


__device__ __forceinline__ u32x4 pair16(u32x2 a, u32x2 b) {
    const auto rx = __builtin_amdgcn_permlane16_swap(a.x, b.x, false, false); const auto ry = __builtin_amdgcn_permlane16_swap(a.y, b.y, false, false);
    return (u32x4){rx[0], ry[0], rx[1], ry[1]};
}
struct EpiProj {
    static constexpr bool PERM = true, AFTER_DRAIN = false;
    bf16_t* O; const float* cs; const float* sn; bf16_t* QH;
    __device__ __forceinline__ void operator()(const f32x4 (&acc)[2][2][4][2], const Unit& u, int wr, int wc, int fr, int fq) const {
        const int row0 = u.pm * BM + wr * 64 + fr, colb = u.pn * BM + wc * 32 + 8 * fq;
        if (u.pn < 4) {
            const float sc = (u.pn < 2) ? QSCALE : 1.f;
#pragma unroll
            for (int ai = 0; ai < 2; ++ai) {
                f32x4 cv[4][2], sv[4][2];
#pragma unroll
                for (int m = 0; m < 4; ++m) { const int pos = (row0 + ai * HALF + m * 16) & (SEQ - 1);
#pragma unroll
                    for (int bj = 0; bj < 2; ++bj) { const int g8 = ((colb + bj * HALF) & 63) >> 3; cv[m][bj] = *(const f32x4*)(cs + pos * 32 + g8 * 4); sv[m][bj] = *(const f32x4*)(sn + pos * 32 + g8 * 4); } }
#pragma unroll
                for (int mp = 0; mp < 2; ++mp)
#pragma unroll
                    for (int bj = 0; bj < 2; ++bj) { const int col = colb + bj * HALF, head = col >> 6, g8 = (col & 63) >> 3;
                        u32x2 w1[2], w2[2];
#pragma unroll
                        for (int q = 0; q < 2; ++q) { const int m = 2 * mp + q; const f32x4 c = cv[m][bj], s = sv[m][bj];
                            const f32x4 t1 = acc[ai][bj][m][0], t2 = acc[ai][bj][m][1];
                            const f32x4 o1 = (t1 * c - t2 * s) * sc, o2 = (t1 * s + t2 * c) * sc;
                            w1[q].x = cvtpk(o1[0], o1[1]); w1[q].y = cvtpk(o1[2], o1[3]); w2[q].x = cvtpk(o2[0], o2[1]); w2[q].y = cvtpk(o2[2], o2[3]); }
                        const int msel = 2 * mp + (fq & 1), row = row0 + ai * HALF + msel * 16, pos = row & (SEQ - 1);
                        bf16_t* p = QH + ((size_t)((((head >> 3) * 2 + (row >> 13)) * 8 + (head & 7))) * SEQ + pos) * 64 + (g8 & ~1) * 4;
                        *(u32x4*)p = pair16(w1[0], w1[1]); *(u32x4*)(p + 32) = pair16(w2[0], w2[1]); }
                asm volatile("" ::: "memory");
            }
        } else if (u.pn < 6) {
#pragma unroll
            for (int ai = 0; ai < 2; ++ai)
#pragma unroll
                for (int m = 0; m < 4; ++m) { const int row = row0 + ai * HALF + m * 16;
#pragma unroll
                    for (int bj = 0; bj < 2; ++bj) { const int col = colb + bj * HALF - 1024, hh = col >> 6; const f32x4 v0 = acc[ai][bj][m][0], v1 = acc[ai][bj][m][1];
                        u32x4 w; w.x = cvtpk(v0[0], v0[1]); w.y = cvtpk(v0[2], v0[3]); w.z = cvtpk(v1[0], v1[1]); w.w = cvtpk(v1[2], v1[3]);
                        *(u32x4*)(QH + ((size_t)(((4 + (row >> 13)) * 8 + hh)) * SEQ + (row & (SEQ - 1))) * 64 + (col & 63)) = w; } }
        } else {
            const float sc = (u.pn == 7) ? QSCALE : 1.f;
#pragma unroll
            for (int ai = 0; ai < 2; ++ai)
#pragma unroll
                for (int m = 0; m < 4; ++m) { bf16_t* rowp = O + (size_t)(row0 + ai * HALF + m * 16) * NIN + colb;
#pragma unroll
                    for (int bj = 0; bj < 2; ++bj) { const f32x4 v0 = acc[ai][bj][m][0] * sc, v1 = acc[ai][bj][m][1] * sc;
                        u32x4 w; w.x = cvtpk(v0[0], v0[1]); w.y = cvtpk(v0[2], v0[3]); w.z = cvtpk(v1[0], v1[1]); w.w = cvtpk(v1[2], v1[3]);
                        *(u32x4*)(rowp + bj * HALF) = w; } }
        }
    }
};
struct EpiBf16 {
    static constexpr bool PERM = true, AFTER_DRAIN = false;
    bf16_t* O; int ldc; const float* bias; int bias_estride; float scale;
    __device__ __forceinline__ void operator()(const f32x4 (&acc)[2][2][4][2], const Unit& u, int wr, int wc, int fr, int fq) const {
        const int row0 = u.pm * BM + wr * 64 + fr, col0 = u.pn * BM + wc * 32 + 8 * fq;
        f32x4 bv[2][2];
#pragma unroll
        for (int bj = 0; bj < 2; ++bj)
#pragma unroll
            for (int n = 0; n < 2; ++n) bv[bj][n] = bias ? *(const f32x4*)(bias + (size_t)u.e * bias_estride + col0 + bj * HALF + 4 * n) : (f32x4){0.f, 0.f, 0.f, 0.f};
#pragma unroll
        for (int ai = 0; ai < 2; ++ai)
#pragma unroll
            for (int m = 0; m < 4; ++m) { bf16_t* rowp = O + (size_t)(row0 + ai * HALF + m * 16) * ldc + col0;
#pragma unroll
                for (int bj = 0; bj < 2; ++bj) { const f32x4 v0 = acc[ai][bj][m][0] * scale + bv[bj][0], v1 = acc[ai][bj][m][1] * scale + bv[bj][1];
                    u32x4 w; w.x = cvtpk(v0[0], v0[1]); w.y = cvtpk(v0[2], v0[3]); w.z = cvtpk(v1[0], v1[1]); w.w = cvtpk(v1[2], v1[3]);
                    *(u32x4*)(rowp + bj * HALF) = w; } }
    }
};
struct EpiF8 {
    static constexpr bool PERM = true, AFTER_DRAIN = false;
    unsigned char* O; int ldc; const float* bias; int bias_estride; float scale;
    __device__ __forceinline__ void operator()(const f32x4 (&acc)[2][2][4][2], const Unit& u, int wr, int wc, int fr, int fq) const {
        const int row0 = u.pm * BM + wr * 64 + fr, col0 = u.pn * BM + wc * 32 + 8 * fq;
        f32x4 bv[2][2];
#pragma unroll
        for (int bj = 0; bj < 2; ++bj)
#pragma unroll
            for (int n = 0; n < 2; ++n) bv[bj][n] = *(const f32x4*)(bias + (size_t)u.e * bias_estride + col0 + bj * HALF + 4 * n);
#pragma unroll
        for (int ai = 0; ai < 2; ++ai)
#pragma unroll
            for (int mp = 0; mp < 2; ++mp)
#pragma unroll
                for (int bj = 0; bj < 2; ++bj) { u32x2 w[2];
#pragma unroll
                    for (int q = 0; q < 2; ++q) { const int m = 2 * mp + q; const f32x4 v0 = acc[ai][bj][m][0] * scale + bv[bj][0], v1 = acc[ai][bj][m][1] * scale + bv[bj][1];
                        int w0 = 0, w1 = 0; w0 = __builtin_amdgcn_cvt_pk_fp8_f32(v0[0], v0[1], w0, false); w0 = __builtin_amdgcn_cvt_pk_fp8_f32(v0[2], v0[3], w0, true);
                        w1 = __builtin_amdgcn_cvt_pk_fp8_f32(v1[0], v1[1], w1, false); w1 = __builtin_amdgcn_cvt_pk_fp8_f32(v1[2], v1[3], w1, true);
                        w[q].x = (unsigned)w0; w[q].y = (unsigned)w1; }
                    const int msel = 2 * mp + (fq & 1);
                    *(u32x4*)(O + (size_t)(row0 + ai * HALF + msel * 16) * ldc + u.pn * BM + wc * 32 + 8 * (fq & ~1) + bj * HALF) = pair16(w[0], w[1]); }
    }
};
struct EpiSwiglu {
    static constexpr bool PERM = true, AFTER_DRAIN = false;
    unsigned char* O; const float* bias; float scale;
    __device__ __forceinline__ static float act1(float g, float up) {
        g = fminf(g, 7.0f); up = fminf(fmaxf(up, -7.0f), 7.0f);
        const float sg = __builtin_amdgcn_rcpf(1.0f + __builtin_amdgcn_exp2f(g * (-1.702f * 1.4426950408889634f)));
        return (up + 1.0f) * g * sg;
    }
    __device__ __forceinline__ static f32x2 act2(f32x2 g, f32x2 up) {
        g.x = fminf(g.x, 7.0f); g.y = fminf(g.y, 7.0f); up.x = fminf(fmaxf(up.x, -7.0f), 7.0f); up.y = fminf(fmaxf(up.y, -7.0f), 7.0f);
        const f32x2 z = g * (-1.702f * 1.4426950408889634f); f32x2 e; e.x = __builtin_amdgcn_exp2f(z.x); e.y = __builtin_amdgcn_exp2f(z.y);
        const f32x2 d = e + 1.0f; f32x2 r; r.x = __builtin_amdgcn_rcpf(d.x); r.y = __builtin_amdgcn_rcpf(d.y);
        return (up + 1.0f) * g * r;
    }
    __device__ __forceinline__ void operator()(const f32x4 (&acc)[2][2][4][2], const Unit& u, int wr, int wc, int fr, int fq) const {
        const int row0 = u.pm * BM + wr * 64 + fr, j0 = u.pn * HALF + wc * 32 + 8 * fq;
        const float* bg = bias + (size_t)u.e * 2048 + j0; const float* bu = bg + 1024;
        const f32x4 bg0 = *(const f32x4*)bg, bg1 = *(const f32x4*)(bg + 4), bu0 = *(const f32x4*)bu, bu1 = *(const f32x4*)(bu + 4);
#pragma unroll
        for (int ai = 0; ai < 2; ++ai)
#pragma unroll
            for (int mp = 0; mp < 2; ++mp) { u32x2 w[2];
#pragma unroll
                for (int q = 0; q < 2; ++q) { const int m = 2 * mp + q;
                    const f32x4 g0 = acc[ai][0][m][0] * scale + bg0, g1 = acc[ai][0][m][1] * scale + bg1, u0 = acc[ai][1][m][0] * scale + bu0, u1 = acc[ai][1][m][1] * scale + bu1;
                    int w0 = 0, w1 = 0;
                    const f32x2 a0 = act2((f32x2){g0[0], g0[1]}, (f32x2){u0[0], u0[1]}), a1 = act2((f32x2){g0[2], g0[3]}, (f32x2){u0[2], u0[3]}), a2 = act2((f32x2){g1[0], g1[1]}, (f32x2){u1[0], u1[1]}), a3 = act2((f32x2){g1[2], g1[3]}, (f32x2){u1[2], u1[3]});
                    w0 = __builtin_amdgcn_cvt_pk_fp8_f32(a0.x, a0.y, w0, false); w0 = __builtin_amdgcn_cvt_pk_fp8_f32(a1.x, a1.y, w0, true);
                    w1 = __builtin_amdgcn_cvt_pk_fp8_f32(a2.x, a2.y, w1, false); w1 = __builtin_amdgcn_cvt_pk_fp8_f32(a3.x, a3.y, w1, true);
                    w[q].x = (unsigned)w0; w[q].y = (unsigned)w1; }
                const int msel = 2 * mp + (fq & 1);
                *(u32x4*)(O + (size_t)(row0 + ai * HALF + msel * 16) * DM + u.pn * HALF + wc * 32 + 8 * (fq & ~1)) = pair16(w[0], w[1]); }
    }
};
template <bool BASE_BF16>
struct EpiRes {
    static constexpr bool PERM = true, AFTER_DRAIN = false;
    const void* base; bf16_t* out;
    __device__ __forceinline__ void operator()(const f32x4 (&acc)[2][2][4][2], const Unit& u, int wr, int wc, int fr, int fq) const {
        const int row0 = u.pm * BM + wr * 64 + fr, col0 = u.pn * BM + wc * 32 + 8 * fq;
#pragma unroll
        for (int ai = 0; ai < 2; ++ai) {
            f32x4 bs[4][2][2];
#pragma unroll
            for (int m = 0; m < 4; ++m) { const size_t off = (size_t)(row0 + ai * HALF + m * 16) * DM + col0;
#pragma unroll
                for (int bj = 0; bj < 2; ++bj) {
                    if constexpr (BASE_BF16) { const u32x4 r = __builtin_nontemporal_load((const u32x4*)((const bf16_t*)base + off + bj * HALF));
                        bs[m][bj][0] = (f32x4){bflo(r.x), bfhi(r.x), bflo(r.y), bfhi(r.y)}; bs[m][bj][1] = (f32x4){bflo(r.z), bfhi(r.z), bflo(r.w), bfhi(r.w)}; }
                    else { bs[m][bj][0] = __builtin_nontemporal_load((const f32x4*)((const float*)base + off + bj * HALF)); bs[m][bj][1] = __builtin_nontemporal_load((const f32x4*)((const float*)base + off + bj * HALF + 4)); } } }
#pragma unroll
            for (int m = 0; m < 4; ++m) { const size_t off = (size_t)(row0 + ai * HALF + m * 16) * DM + col0;
#pragma unroll
                for (int bj = 0; bj < 2; ++bj) { const f32x4 v0 = bs[m][bj][0] + acc[ai][bj][m][0], v1 = bs[m][bj][1] + acc[ai][bj][m][1];
                    u32x4 w; w.x = cvtpk(v0[0], v0[1]); w.y = cvtpk(v0[2], v0[3]); w.z = cvtpk(v1[0], v1[1]); w.w = cvtpk(v1[2], v1[3]);
                    *(u32x4*)(out + off + bj * HALF) = w; } }
            asm volatile("" ::: "memory");
        }
    }
};

template <class Epi, class Sched, bool ALIGN_EPI = false, bool SP2 = true, bool FP8 = false, bool GATHER = false>
__device__ __forceinline__ void gemm_phase(LAS unsigned char* lds, const int tid, const Gemm g, const Sched& S, const Epi& E) {
    const int wid = __builtin_amdgcn_readfirstlane(tid >> 6), lane = tid & 63, wr = wid >> 2, wc = wid & 3, fr = lane & 15, fq = lane >> 4;
    const int K = g.K, rowb = FP8 ? K : 2 * K, nt = rowb / 128;
    unsigned voffA[2], voffB[2];
#pragma unroll
    for (int i = 0; i < 2; ++i) { int R, C; stage_rc(tid * 16 + i * 8192, R, C); const int Rb = Epi::PERM ? ((R & ~31) + perm32(R & 31)) : R;
        voffA[i] = (unsigned)(R * rowb + C * 2); voffB[i] = (unsigned)(Rb * rowb + C * 2); }
    const size_t kstep = (size_t)(BK * 2);
    const size_t hstep = (size_t)HALF * rowb;
    const size_t tstep = 2 * hstep;
    const unsigned ldsw = (unsigned)wid * 1024u;
    const int aoff = lds_byte(wr * 64 + fr, fq * 8), boff = lds_byte(wc * 32 + fr, fq * 8);
#define PG8_SA(b, h) (((b) * 2 + (h)) * HTB)
#define PG8_SB(b, h) ((4 + (b) * 2 + (h)) * HTB)
#define PG8_STAGE(bufoff, gbase, voff) do { _Pragma("unroll") for (int _i = 0; _i < 2; ++_i) \
        __builtin_amdgcn_global_load_lds((const unsigned*)((const char*)(gbase) + (voff)[_i]), (LAS unsigned*)(lds + (bufoff) + ldsw + _i * 8192), 16, 0, 0); } while (0)
#define PG8_STAGE_A(bufoff, gbase, h, nx) do { if constexpr (GATHER) { unsigned vo_[2]; vo_[0] = (nx) ? gAn[h][0] : gAc[h][0]; vo_[1] = (nx) ? gAn[h][1] : gAc[h][1]; PG8_STAGE(bufoff, gbase, vo_); } \
        else PG8_STAGE(bufoff, (gbase) + (h) * hstep, voffA); } while (0)
#define PG8_LDA(dst, b, h) do { if constexpr (FP8) { _Pragma("unroll") for (int m = 0; m < 4; ++m) { const i32x4_t lo_ = *(const LAS i32x4_t*)(lds + PG8_SA(b, h) + aoff + m * 2048), hi_ = *(const LAS i32x4_t*)(lds + PG8_SA(b, h) + aoff + m * 2048 + 1024); \
            dst##8[m] = __builtin_shufflevector(lo_, hi_, 0, 1, 2, 3, 4, 5, 6, 7); } } \
        else { _Pragma("unroll") for (int m = 0; m < 4; ++m) _Pragma("unroll") for (int k = 0; k < 2; ++k) dst[m][k] = *(const LAS bf16x8*)(lds + PG8_SA(b, h) + aoff + m * 2048 + k * 1024); } } while (0)
#define PG8_LDB(dst, b, h) do { if constexpr (FP8) { _Pragma("unroll") for (int n = 0; n < 2; ++n) { const i32x4_t lo_ = *(const LAS i32x4_t*)(lds + PG8_SB(b, h) + boff + n * 2048), hi_ = *(const LAS i32x4_t*)(lds + PG8_SB(b, h) + boff + n * 2048 + 1024); \
            dst##8[n] = __builtin_shufflevector(lo_, hi_, 0, 1, 2, 3, 4, 5, 6, 7); } } \
        else { _Pragma("unroll") for (int n = 0; n < 2; ++n) _Pragma("unroll") for (int k = 0; k < 2; ++k) dst[n][k] = *(const LAS bf16x8*)(lds + PG8_SB(b, h) + boff + n * 2048 + k * 1024); } } while (0)
#define PG8_MMA(ai, bj, At, Bt) do { __builtin_amdgcn_s_setprio(1); \
        if constexpr (FP8) { _Pragma("unroll") for (int m = 0; m < 4; ++m) _Pragma("unroll") for (int n = 0; n < 2; ++n) \
            asm volatile("v_mfma_scale_f32_16x16x128_f8f6f4 %0, %1, %2, %0, %3, %3 op_sel_hi:[0,0,0]" : "+v"(acc[ai][bj][m][n]) : "v"(Bt##8[n]), "v"(At##8[m]), "v"(0x7f7f7f7f)); } \
        else { _Pragma("unroll") for (int m = 0; m < 4; ++m) _Pragma("unroll") for (int n = 0; n < 2; ++n) _Pragma("unroll") for (int k = 0; k < 2; ++k) \
            acc[ai][bj][m][n] = __builtin_amdgcn_mfma_f32_16x16x32_bf16(Bt[n][k], At[m][k], acc[ai][bj][m][n], 0, 0, 0); } \
        __builtin_amdgcn_s_setprio(0); } while (0)
#define PG8_WAIT_V(n) asm volatile("s_waitcnt vmcnt(" #n ")" ::: "memory")
#define PG8_WAIT_L(n) asm volatile("s_waitcnt lgkmcnt(" #n ")" ::: "memory")
#define PG8_BAR __builtin_amdgcn_s_barrier()
#define PG8_SCHED __builtin_amdgcn_sched_barrier(0)
#define PG8_UA(u) (GATHER ? (const char*)g.A : (const char*)g.A + (size_t)(u).pm * tstep)
    unsigned gAc[2][2], gAn[2][2];
#define PG8_GLOAD(dst, ui_) do { if constexpr (GATHER) { _Pragma("unroll") for (int h = 0; h < 2; ++h) _Pragma("unroll") for (int i = 0; i < 2; ++i) { int R, C; stage_rc(tid * 16 + i * 8192, R, C); \
            dst[h][i] = (unsigned)(g.gtok[(ui_) * 256 + h * HALF + R] * rowb + C * 2); } } } while (0)
#define PG8_UB(u) ((const char*)g.Bt + (size_t)(u).e * g.ebytes + (size_t)(u).pn * tstep)
    Unit cur, nxt; int ui = 0;
    if (!S.next(0, cur)) return;
    f32x4 acc[2][2][4][2];
#pragma unroll
    for (int a = 0; a < 2; ++a)
#pragma unroll
        for (int b = 0; b < 2; ++b)
#pragma unroll
            for (int m = 0; m < 4; ++m)
#pragma unroll
                for (int n = 0; n < 2; ++n) acc[a][b][m][n] = (f32x4){0.f, 0.f, 0.f, 0.f};
    bf16x8 At[4][2], B0[2][2], B1[2][2]; i32x8_t At8[4], B08[2], B18[2];
    const char* cA = PG8_UA(cur); const char* cB = PG8_UB(cur);
    PG8_GLOAD(gAc, 0);
    if constexpr (SP2) {
        PG8_STAGE(PG8_SB(0, 0), cB, voffB); PG8_STAGE(PG8_SB(0, 1), cB + hstep, voffB); PG8_STAGE_A(PG8_SA(0, 0), cA, 0, false); PG8_STAGE_A(PG8_SA(0, 1), cA, 1, false);
        if (wr == 1) PG8_BAR;
        PG8_WAIT_V(2); PG8_BAR;
        PG8_STAGE(PG8_SB(1, 0), cB + kstep, voffB); PG8_STAGE_A(PG8_SA(1, 0), cA + kstep, 0, false); PG8_STAGE(PG8_SB(1, 1), cB + hstep + kstep, voffB);
        PG8_WAIT_V(6); PG8_BAR;
    } else {
        PG8_STAGE(PG8_SB(0, 0), cB, voffB); PG8_STAGE_A(PG8_SA(0, 0), cA, 0, false); PG8_STAGE(PG8_SB(0, 1), cB + hstep, voffB); PG8_STAGE_A(PG8_SA(0, 1), cA, 1, false);
        if (wr == 1) PG8_BAR;
        PG8_WAIT_V(4); PG8_BAR;
        PG8_STAGE(PG8_SB(1, 0), cB + kstep, voffB); PG8_STAGE_A(PG8_SA(1, 0), cA + kstep, 0, false); PG8_STAGE(PG8_SB(1, 1), cB + hstep + kstep, voffB);
        PG8_WAIT_V(6); PG8_BAR;
    }
    for (;;) {
        const bool has_next = S.next(ui + 1, nxt);
        if constexpr (GATHER) { if (has_next) PG8_GLOAD(gAn, ui + 1); else { gAn[0][0] = gAc[0][0]; gAn[0][1] = gAc[0][1]; gAn[1][0] = gAc[1][0]; gAn[1][1] = gAc[1][1]; } }
        const char* nA = has_next ? PG8_UA(nxt) : cA; const char* nB = has_next ? PG8_UB(nxt) : cB;
#pragma unroll 1
        for (int t = 0; t < nt; t += 2) {
            const bool last = (t == nt - 2);
            const char* a1 = cA + (size_t)(t + 1) * kstep;
            const char* a2 = last ? nA : cA + (size_t)(t + 2) * kstep; const char* b2 = last ? nB : cB + (size_t)(t + 2) * kstep;
            const char* a3 = a2 + kstep; const char* b3 = b2 + kstep;
            if constexpr (SP2) {
            PG8_LDB(B0, 0, 0); PG8_LDB(B1, 0, 1); PG8_SCHED; PG8_LDA(At, 0, 0); PG8_STAGE_A(PG8_SA(1, 1), a1, 1, false);
            PG8_WAIT_V(8); PG8_WAIT_L(0); PG8_BAR; PG8_MMA(0, 0, At, B0); PG8_MMA(0, 1, At, B1); PG8_BAR; PG8_SCHED;
            PG8_LDA(At, 0, 1); PG8_STAGE(PG8_SB(0, 0), b2, voffB); PG8_STAGE(PG8_SB(0, 1), b2 + hstep, voffB); PG8_STAGE_A(PG8_SA(0, 0), a2, 0, last);
            PG8_WAIT_V(8); PG8_WAIT_L(0); PG8_BAR; PG8_MMA(1, 0, At, B0); PG8_MMA(1, 1, At, B1); PG8_BAR; PG8_SCHED;
            PG8_LDB(B0, 1, 0); PG8_LDB(B1, 1, 1); PG8_SCHED; PG8_LDA(At, 1, 0); PG8_STAGE_A(PG8_SA(0, 1), a2, 1, last);
            PG8_WAIT_V(8); PG8_WAIT_L(0); PG8_BAR; PG8_MMA(0, 0, At, B0); PG8_MMA(0, 1, At, B1); PG8_BAR; PG8_SCHED;
            PG8_LDA(At, 1, 1); PG8_STAGE(PG8_SB(1, 0), b3, voffB); PG8_STAGE(PG8_SB(1, 1), b3 + hstep, voffB); PG8_STAGE_A(PG8_SA(1, 0), a3, 0, last);
            PG8_WAIT_V(8); PG8_WAIT_L(0); PG8_BAR; PG8_MMA(1, 0, At, B0); PG8_MMA(1, 1, At, B1); PG8_BAR; PG8_SCHED;
            } else {
            PG8_LDB(B0, 0, 0); PG8_SCHED; PG8_LDA(At, 0, 0); PG8_STAGE_A(PG8_SA(1, 1), a1, 1, false);
            PG8_WAIT_L(8); PG8_BAR; PG8_WAIT_L(0); PG8_MMA(0, 0, At, B0); PG8_BAR; PG8_SCHED;
            PG8_LDB(B1, 0, 1); PG8_STAGE(PG8_SB(0, 0), b2, voffB);
            PG8_BAR; PG8_WAIT_L(0); PG8_MMA(0, 1, At, B1); PG8_BAR;
            PG8_LDA(At, 0, 1); PG8_STAGE_A(PG8_SA(0, 0), a2, 0, last);
            PG8_BAR; PG8_WAIT_L(0); PG8_MMA(1, 0, At, B0); PG8_BAR; PG8_SCHED;
            PG8_STAGE(PG8_SB(0, 1), b2 + hstep, voffB);
            PG8_WAIT_V(6); PG8_BAR; PG8_MMA(1, 1, At, B1); PG8_BAR;
            PG8_LDB(B0, 1, 0); PG8_SCHED; PG8_LDA(At, 1, 0); PG8_STAGE_A(PG8_SA(0, 1), a2, 1, last);
            PG8_WAIT_L(8); PG8_BAR; PG8_WAIT_L(0); PG8_MMA(0, 0, At, B0); PG8_BAR; PG8_SCHED;
            PG8_LDB(B1, 1, 1); PG8_STAGE(PG8_SB(1, 0), b3, voffB);
            PG8_BAR; PG8_WAIT_L(0); PG8_MMA(0, 1, At, B1); PG8_BAR;
            PG8_LDA(At, 1, 1); PG8_STAGE_A(PG8_SA(1, 0), a3, 0, last);
            PG8_BAR; PG8_WAIT_L(0); PG8_MMA(1, 0, At, B0); PG8_BAR; PG8_SCHED;
            PG8_STAGE(PG8_SB(1, 1), b3 + hstep, voffB);
            PG8_WAIT_V(6); PG8_BAR; PG8_MMA(1, 1, At, B1); PG8_BAR;
            }
        }
        if constexpr (ALIGN_EPI) { if (wr == 0) PG8_BAR; }
        if constexpr (FP8) asm volatile("s_nop 15\n\ts_nop 15" ::: "memory");
        E(acc, cur, wr, wc, fr, fq);
        if (!has_next) break;
#pragma unroll
        for (int a = 0; a < 2; ++a)
#pragma unroll
            for (int b = 0; b < 2; ++b)
#pragma unroll
                for (int m = 0; m < 4; ++m)
#pragma unroll
                    for (int n = 0; n < 2; ++n) acc[a][b][m][n] = (f32x4){0.f, 0.f, 0.f, 0.f};
        cur = nxt; cA = nA; cB = nB; ++ui;
        if constexpr (GATHER) { gAc[0][0] = gAn[0][0]; gAc[0][1] = gAn[0][1]; gAc[1][0] = gAn[1][0]; gAc[1][1] = gAn[1][1]; }
        if constexpr (ALIGN_EPI) { if (wr == 1) PG8_BAR; }
    }
    PG8_WAIT_V(0);
    if constexpr (!ALIGN_EPI) { if (wr == 0) PG8_BAR; }
    PG8_BAR;
#undef PG8_SA
#undef PG8_SB
#undef PG8_STAGE
#undef PG8_STAGE_A
#undef PG8_GLOAD
#undef PG8_LDA
#undef PG8_LDB
#undef PG8_MMA
#undef PG8_WAIT_V
#undef PG8_WAIT_L
#undef PG8_BAR
#undef PG8_SCHED
#undef PG8_UA
#undef PG8_UB
}
}


#define XB_TMO      128
#define XB_XCNT(j)  (256  + 64 * (j))
#define XB_XSUB(j)  (1280 + 64 * (j))
#define XB_XGEN(j)  (2304 + 64 * (j))
#define XB_TOP      3328
#define XB_TOPGEN   3392
#define XCD_BAR_WORDS 3456
#define XB_SPIN_CAP (1u << 18)
__device__ __forceinline__ unsigned xb_ld(unsigned* p)              { return __hip_atomic_load(p, __ATOMIC_RELAXED, __HIP_MEMORY_SCOPE_AGENT); }
__device__ __forceinline__ unsigned xb_add(unsigned* p, unsigned v) { return __hip_atomic_fetch_add(p, v, __ATOMIC_RELAXED, __HIP_MEMORY_SCOPE_AGENT); }
__device__ __forceinline__ unsigned xb_xcc_id() { return (unsigned)__builtin_amdgcn_s_getreg((3 << 11) | 20) & 0xFu; }
#define XB_SPIN(cond, bar) do { unsigned _sp = 0; while (cond) { __builtin_amdgcn_s_sleep(1); \
    if ((++_sp & 255u) == 0u) { if (xb_ld(&(bar)[XB_TMO])) break; if (_sp > XB_SPIN_CAP) { atomicAdd(&(bar)[XB_TMO], 1u); break; } } } } while (0)
struct XcdBarrier { unsigned* bar; unsigned x; volatile LAS unsigned* st; };
__device__ __forceinline__ XcdBarrier xcd_barrier_post(unsigned* bar, volatile LAS unsigned* st, int tid) {
    XcdBarrier b; b.bar = bar; b.x = xb_xcc_id(); b.st = st;
    if (tid == 0) (void)xb_add(&bar[XB_XCNT(b.x)], 1u);
    return b;
}
__device__ __forceinline__ void xcd_barrier_complete(unsigned* bar, unsigned x, unsigned& nloc, unsigned& nx) {
    const unsigned G = gridDim.x * gridDim.y * gridDim.z;
    unsigned sum, cnt, mine, sp = 0u;
    for (;;) {
        sum = 0u; cnt = 0u; mine = 0u;
#pragma unroll
        for (unsigned j = 0; j < 16; ++j) { const unsigned c = xb_ld(&bar[XB_XCNT(j)]); sum += c; cnt += (c > 0u) ? 1u : 0u; mine = (j == x) ? c : mine; }
        if (sum == G) break;
        __builtin_amdgcn_s_sleep(1);
        if ((++sp & 255u) == 0u) { if (xb_ld(&bar[XB_TMO])) break; if (sp > XB_SPIN_CAP) { atomicAdd(&bar[XB_TMO], 1u); break; } }
    }
    nloc = mine > 0u ? mine : 1u; nx = cnt > 0u ? cnt : 1u;
}
__device__ __forceinline__ void xcd_barrier(const XcdBarrier& b, int tid) {
    asm volatile("s_waitcnt vmcnt(0)" ::: "memory");
    __syncthreads();
    if (tid == 0) {
        unsigned* bar = b.bar;
        __builtin_amdgcn_s_waitcnt(0);
        unsigned nloc = b.st[0], nx = b.st[1];
        if (nloc == 0u) { xcd_barrier_complete(bar, b.x, nloc, nx); b.st[0] = nloc; b.st[1] = nx; }
        const unsigned old = xb_add(&bar[XB_XSUB(b.x)], 1u);
        const unsigned gen = old / nloc;
        if (old + 1u == (gen + 1u) * nloc) {
            __builtin_amdgcn_fence(__ATOMIC_RELEASE, "agent");
            asm volatile("s_waitcnt vmcnt(0)" ::: "memory");
            const unsigned og = xb_add(&bar[XB_TOP], 1u);
            const unsigned tg = og / nx;
            if (og + 1u == (tg + 1u) * nx) xb_add(&bar[XB_TOPGEN], 1u);
            else XB_SPIN(xb_ld(&bar[XB_TOPGEN]) == tg, bar);
            __builtin_amdgcn_fence(__ATOMIC_ACQUIRE, "agent");
            xb_add(&bar[XB_XGEN(b.x)], 1u);
            asm volatile("s_waitcnt vmcnt(0)" ::: "memory");
        } else {
            XB_SPIN(xb_ld(&bar[XB_XGEN(b.x)]) == gen, bar);
            __builtin_amdgcn_fence(__ATOMIC_ACQUIRE, "agent");
            asm volatile("s_waitcnt vmcnt(0)" ::: "memory");
        }
    }
    __syncthreads();
}

struct Args { const float* in[18]; float* out; unsigned char* ws; int ph_lo, ph_hi; };
enum { IN_X = 0, IN_MEM, IN_N1G, IN_WIN, IN_POOLW, IN_POOLS, IN_MEMNG, IN_WMKV, IN_GRPG, IN_WOUT, IN_N2G, IN_RW, IN_RB, IN_WGU, IN_BGU, IN_WDN, IN_BDN, IN_FING };

#define GAS __attribute__((address_space(1)))
#define CAS __attribute__((address_space(4)))
struct Frame {
    LAS unsigned char* lds; int tid, lane, wave, G, bid;
    const CAS unsigned char* kp;
    __device__ __forceinline__ const float* in(int i) const { return (const float*)*(GAS const float* const CAS*)(kp + 8 * i); }
    __device__ __forceinline__ float* out() const { return (float*)*(GAS float* const CAS*)(kp + 144); }
    __device__ __forceinline__ unsigned char* ws() const { return (unsigned char*)*(GAS unsigned char* const CAS*)(kp + 152); }
};

template <int MODE> __device__ __forceinline__ int perm_col(int c) {
    if (MODE == 1) { if (c >= 1024) return c; const int head = c >> 6, d = c & 63, g8 = (d & 31) >> 2, i = (d & 3) + ((d >> 5) << 2); return (head << 6) + (g8 << 3) + i; }
    if (MODE == 2) { const int up = c >> 10, cc = c & 1023; return ((cc >> 7) << 8) + (up << 7) + (cc & 127); }
    return c;
}
struct TItem { const float* W; bf16_t* WT; int N, mode, k0, n0; };
__device__ __forceinline__ int perm_col_rt(int mode, int c) { return mode == 1 ? perm_col<1>(c) : (mode == 2 ? perm_col<2>(c) : c); }
__device__ __forceinline__ void titem_load(const TItem& I, float (&tmp)[32], int lane) {
#pragma unroll
    for (int i = 0; i < 32; ++i) { const int kk = 2 * i + (lane >> 5); tmp[i] = I.W[(size_t)(I.k0 + kk) * I.N + I.n0 + (lane & 31)]; }
}
__device__ __forceinline__ void titem_store(const TItem& I, const float (&tmp)[32], LAS float* scr, int lane) {
#pragma unroll
    for (int i = 0; i < 32; ++i) { const int kk = 2 * i + (lane >> 5); scr[kk * 33 + (lane & 31)] = tmp[i]; }
    LDS_WAIT();
    if (I.mode >= 2) {
        const int c = lane & 3; unsigned char* W8 = (unsigned char*)I.WT;
#pragma unroll
        for (int j = 0; j < 2; ++j) { const int n = (lane >> 2) + 16 * j; const LAS float* s = scr + (16 * c) * 33 + n; u32x4 o;
#pragma unroll
            for (int q = 0; q < 4; ++q) { int w = 0; w = __builtin_amdgcn_cvt_pk_fp8_f32(s[(4 * q) * 33] * W8SCALE, s[(4 * q + 1) * 33] * W8SCALE, w, false);
                w = __builtin_amdgcn_cvt_pk_fp8_f32(s[(4 * q + 2) * 33] * W8SCALE, s[(4 * q + 3) * 33] * W8SCALE, w, true); o[q] = (unsigned)w; }
            const int row = (I.mode == 2) ? perm_col<2>(I.n0 + n) : (I.n0 + n);
            *(u32x4*)(W8 + (size_t)row * DM + I.k0 + 16 * c) = o; }
    } else {
        const int c = lane & 7;
#pragma unroll
        for (int j = 0; j < 4; ++j) { const int n = (lane >> 3) + 8 * j; const LAS float* s = scr + (8 * c) * 33 + n;
            u32x4 o; o.x = cvtpk(s[0 * 33], s[1 * 33]); o.y = cvtpk(s[2 * 33], s[3 * 33]); o.z = cvtpk(s[4 * 33], s[5 * 33]); o.w = cvtpk(s[6 * 33], s[7 * 33]);
            *(u32x4*)(I.WT + (size_t)perm_col_rt(I.mode, I.n0 + n) * DM + I.k0 + 8 * c) = o; }
    }
    LDS_WAIT();
}
struct W8Step { const float* W; unsigned char* W8; int N, gu, k0, n0; };
__device__ __forceinline__ void w8_load(const W8Step& I, f32x4 (&r)[16], int wave, int lane) {
#pragma unroll
    for (int h = 0; h < 2; ++h)
#pragma unroll
        for (int i = 0; i < 8; ++i) r[8 * h + i] = __builtin_nontemporal_load((const f32x4*)(I.W + (size_t)(I.k0 + 8 * (wave + 8 * h) + i) * I.N + I.n0 + 4 * lane));
}
__device__ __forceinline__ void w8_store(const W8Step& I, const f32x4 (&r)[16], LAS unsigned char* T, int tid, int wave, int lane) {
#pragma unroll
    for (int h = 0; h < 2; ++h) { const int a = wave + 8 * h;
#pragma unroll
        for (int j = 0; j < 4; ++j) { int w0 = 0, w1 = 0;
            w0 = __builtin_amdgcn_cvt_pk_fp8_f32(r[8 * h + 0][j] * W8SCALE, r[8 * h + 1][j] * W8SCALE, w0, false); w0 = __builtin_amdgcn_cvt_pk_fp8_f32(r[8 * h + 2][j] * W8SCALE, r[8 * h + 3][j] * W8SCALE, w0, true);
            w1 = __builtin_amdgcn_cvt_pk_fp8_f32(r[8 * h + 4][j] * W8SCALE, r[8 * h + 5][j] * W8SCALE, w1, false); w1 = __builtin_amdgcn_cvt_pk_fp8_f32(r[8 * h + 6][j] * W8SCALE, r[8 * h + 7][j] * W8SCALE, w1, true);
            u32x2 w; w.x = (unsigned)w0; w.y = (unsigned)w1;
            *(LAS u32x2*)(T + (4 * lane + j) * 128 + ((a ^ (lane & 15)) << 3)) = w; } }
    __syncthreads();
#pragma unroll
    for (int i = 0; i < 4; ++i) { const int p = tid + 512 * i, row = p >> 3, c16 = p & 7, f = (row >> 2) & 15;
        u32x4 v = *(const LAS u32x4*)(T + row * 128 + ((c16 ^ (f >> 1)) << 4));
        if (f & 1) v = (u32x4){v.z, v.w, v.x, v.y};
        const int orow = I.gu ? perm_col<2>(I.n0 + row) : (I.n0 + row);
        *(u32x4*)(I.W8 + (size_t)orow * DM + I.k0 + 16 * c16) = v; }
}
constexpr int W8_GU_STEPS = 32 * 64, W8_PER_LAYER = W8_GU_STEPS + 32 * 32;
__device__ __forceinline__ void w8_decode(Frame& F, W8Step& I, int layer, int j) {
    if (j < W8_GU_STEPS) { const int le = layer * NE + (j >> 6), r_ = j & 63; I.W = F.in(IN_WGU) + (size_t)le * DM * 2048; I.W8 = F.ws() + WS_WGU + (size_t)le * 2048 * DM; I.N = 2048; I.gu = 1; I.k0 = 128 * (r_ >> 3); I.n0 = 256 * (r_ & 7); }
    else { const int q_ = j - W8_GU_STEPS, le = layer * NE + (q_ >> 5), r_ = q_ & 31; I.W = F.in(IN_WDN) + (size_t)le * DM * DM; I.W8 = F.ws() + WS_WDN + (size_t)le * DM * DM; I.N = DM; I.gu = 0; I.k0 = 128 * (r_ >> 2); I.n0 = 256 * (r_ & 3); }
}
constexpr int W8_Q_DN0 = 32 * 32, W8_Q_TOTAL = W8_Q_DN0 + W8_PER_LAYER;
__device__ __forceinline__ void w8_decode_q(Frame& F, W8Step& I, int q) { if (q < W8_Q_DN0) w8_decode(F, I, 0, W8_GU_STEPS + q); else w8_decode(F, I, 1, q - W8_Q_DN0); }
__device__ __forceinline__ int w8_grab(Frame& F, unsigned* next, unsigned* done, int limit) {
    volatile LAS int* bc = (volatile LAS int*)(F.lds + MISC_OFF + 128);
    __syncthreads();
    if (F.tid == 0) { int go = 1; if (done != nullptr && __hip_atomic_load(done, __ATOMIC_RELAXED, __HIP_MEMORY_SCOPE_AGENT) >= (unsigned)F.G) go = 0;
        if (go && limit < W8_Q_TOTAL && __hip_atomic_load(next, __ATOMIC_RELAXED, __HIP_MEMORY_SCOPE_AGENT) >= (unsigned)limit) go = 0;
        int j = W8_Q_TOTAL; if (go) j = (int)__hip_atomic_fetch_add(next, 1u, __ATOMIC_RELAXED, __HIP_MEMORY_SCOPE_AGENT); bc[0] = j; }
    __syncthreads();
    return bc[0];
}
__device__ __forceinline__ void w8_help(Frame& F, unsigned* next, unsigned* done, int limit = W8_Q_TOTAL) {
    f32x4 ra[16], rb[16]; W8Step A, B; LAS unsigned char* T0 = F.lds; LAS unsigned char* T1 = F.lds + 32768;
    int j = w8_grab(F, next, done, limit);
    if (j < W8_Q_TOTAL) { w8_decode_q(F, A, j); w8_load(A, ra, F.wave, F.lane); }
    while (j < W8_Q_TOTAL) {
        int jn = w8_grab(F, next, done, limit); if (jn < W8_Q_TOTAL) { w8_decode_q(F, B, jn); w8_load(B, rb, F.wave, F.lane); }
        w8_store(A, ra, T0, F.tid, F.wave, F.lane); j = jn; if (j >= W8_Q_TOTAL) break;
        jn = w8_grab(F, next, done, limit); if (jn < W8_Q_TOTAL) { w8_decode_q(F, A, jn); w8_load(A, ra, F.wave, F.lane); }
        w8_store(B, rb, T1, F.tid, F.wave, F.lane); j = jn;
    }
    __syncthreads();
}
__device__ __forceinline__ void w8_static(Frame& F, int layer, int first, int end, int stride) {
    f32x4 ra[16], rb[16]; W8Step A, B; int st = first; LAS unsigned char* T0 = F.lds; LAS unsigned char* T1 = F.lds + 32768;
    __syncthreads();
    if (st < end) { w8_decode(F, A, layer, st); w8_load(A, ra, F.wave, F.lane); }
    while (st < end) {
        int nx = st + stride; if (nx < end) { w8_decode(F, B, layer, nx); w8_load(B, rb, F.wave, F.lane); }
        w8_store(A, ra, T0, F.tid, F.wave, F.lane); st = nx; if (st >= end) break;
        nx = st + stride; if (nx < end) { w8_decode(F, A, layer, nx); w8_load(A, ra, F.wave, F.lane); }
        w8_store(B, rb, T1, F.tid, F.wave, F.lane); st = nx;
    }
    __syncthreads();
}
__device__ __forceinline__ void rms_row_bf16(const float* xrow, const float* g, bf16_t* orow, int lane) {
    f32x4 v[4]; float ss = 0.f;
#pragma unroll
    for (int j = 0; j < 4; ++j) { v[j] = ((const f32x4*)xrow)[lane + 64 * j]; ss += (v[j].x * v[j].x + v[j].y * v[j].y) + (v[j].z * v[j].z + v[j].w * v[j].w); }
    const float rs = rsqrtf(wave_sum(ss) * (1.f / DM) + EPS);
#pragma unroll
    for (int j = 0; j < 4; ++j) { const f32x4 gv = ((const f32x4*)g)[lane + 64 * j]; const f32x4 o = v[j] * rs * gv;
        u32x2 w; w.x = cvtpk(o.x, o.y); w.y = cvtpk(o.z, o.w); ((u32x2*)orow)[lane + 64 * j] = w; }
}
__device__ __forceinline__ void prologue(Frame& F) {
    LAS float* scr = (LAS float*)(F.lds + F.wave * 16384);
    const int gw = F.bid * 8 + F.wave, NGW = F.G * 8;
    constexpr int I_IN = 16 * 64, I_OUT = 16 * 32, I_MKV = 16 * 16;
    constexpr int S0 = 2 * I_IN, S1 = S0 + 2 * I_OUT, S2 = S1 + 2 * I_MKV, S4 = S2;
#define TI_DECODE(I, it_) do { const int it__ = (it_); int r_, N_; \
        if (it__ < S0) { const int l = it__ / I_IN; r_ = it__ % I_IN; N_ = NIN; (I).W = F.in(IN_WIN) + (size_t)l * DM * NIN; (I).WT = (bf16_t*)(F.ws() + WS_WIN) + (size_t)l * NIN * DM; (I).mode = 1; } \
        else if (it__ < S1) { const int q = it__ - S0, l = q / I_OUT; r_ = q % I_OUT; N_ = DM; (I).W = F.in(IN_WOUT) + (size_t)l * DM * DM; (I).WT = (bf16_t*)(F.ws() + WS_WOUT) + (size_t)l * DM * DM; (I).mode = 0; } \
        else { const int q = it__ - S1, l = q / I_MKV; r_ = q % I_MKV; N_ = 512; (I).W = F.in(IN_WMKV) + (size_t)l * DM * 512; (I).WT = (bf16_t*)(F.ws() + WS_WMKV) + (size_t)l * 512 * DM; (I).mode = 0; } \
        const int nblk_ = N_ / 32; (I).N = N_; (I).k0 = 64 * (r_ / nblk_); (I).n0 = 32 * (r_ % nblk_); } while (0)
    { float ta[32], tb[32]; TItem A, B; int it = gw;
      if (it < S4) { TI_DECODE(A, it); titem_load(A, ta, F.lane); }
      while (it < S4) {
          int nx = it + NGW; if (nx < S4) { TI_DECODE(B, nx); titem_load(B, tb, F.lane); }
          titem_store(A, ta, scr, F.lane); it = nx; if (it >= S4) break;
          nx = it + NGW; if (nx < S4) { TI_DECODE(A, nx); titem_load(A, ta, F.lane); }
          titem_store(B, tb, scr, F.lane); it = nx;
      } }
#undef TI_DECODE
    { float* cs = (float*)(F.ws() + WS_COS); float* sn = (float*)(F.ws() + WS_SIN);
      for (int i = F.bid * 512 + F.tid; i < SEQ * 32; i += F.G * 512) { const int pos = i >> 5, f = i & 31;
          const float inv = exp2f(-(float)f * (13.287712379549449f / 32.0f));
          const float angf = (float)pos * inv; const double rev = (double)angf * 0.15915494309189535; const float fr = (float)(rev - rint(rev));
          cs[i] = __builtin_amdgcn_cosf(fr); sn[i] = __builtin_amdgcn_sinf(fr); } }
    for (int r = gw; r < 2 * 512; r += NGW) { const int l = r >> 9, m = r & 511; rms_row_bf16(F.in(IN_MEM) + (size_t)m * DM, F.in(IN_MEMNG) + l * DM, (bf16_t*)(F.ws() + WS_MEMN) + (size_t)r * DM, F.lane); }
    { const float* xin = F.in(IN_X); const float* g1 = F.in(IN_N1G); bf16_t* XN = (bf16_t*)(F.ws() + WS_XN);
      for (int r0 = gw; r0 < TOK; r0 += 2 * NGW) {
          f32x4 v[2][4]; float ss[2] = {0.f, 0.f};
#pragma unroll
          for (int a = 0; a < 2; ++a) { const int r = min(r0 + a * NGW, TOK - 1);
#pragma unroll
              for (int j = 0; j < 4; ++j) { v[a][j] = ((const f32x4*)(xin + (size_t)r * DM))[F.lane + 64 * j]; ss[a] += (v[a][j].x * v[a][j].x + v[a][j].y * v[a][j].y) + (v[a][j].z * v[a][j].z + v[a][j].w * v[a][j].w); } }
#pragma unroll
          for (int a = 0; a < 2; ++a) { const int r = r0 + a * NGW; if (r >= TOK) break; const float rs = rsqrtf(wave_sum(ss[a]) * (1.f / DM) + EPS);
#pragma unroll
              for (int j = 0; j < 4; ++j) { const f32x4 gv = ((const f32x4*)g1)[F.lane + 64 * j]; const f32x4 o = v[a][j] * rs * gv;
                  u32x2 w; w.x = cvtpk(o.x, o.y); w.y = cvtpk(o.z, o.w); ((u32x2*)(XN + (size_t)r * DM))[F.lane + 64 * j] = w; } } } }
}

__device__ __forceinline__ int crow(int r, int hi) { return (r & 3) + 8 * (r >> 2) + 4 * hi; }
__device__ __forceinline__ s16x4 vtr(LAS const unsigned char* p) { typedef short v4i16_t __attribute__((ext_vector_type(4))); return __builtin_bit_cast(s16x4, __builtin_amdgcn_ds_read_tr16_b64_v4i16((LAS v4i16_t*)p)); }

struct AttnJob {
    const bf16_t* Q; int qpitch, qrow0, qstep;
    const bf16_t* K; const bf16_t* V; int kvpitch, krow0, kstep;
    int t0, ntiles;
    bf16_t* O; int opitch; float* lse; int lsepitch;
};
template <bool MEM> struct AttnStage { static constexpr int NSLOT = MEM ? 8 : 12, NL = NSLOT * 256 / 512; u32x4 k[NL], v[NL]; };

template <bool MEM>
__device__ __forceinline__ void attn_issue_loads(const AttnJob& J, AttnStage<MEM>& S, int tid) {
#pragma unroll
    for (int i = 0; i < AttnStage<MEM>::NL; ++i) { const int q = tid + 512 * i, slot = q >> 8, row = (q >> 3) & 31, c = q & 7;
        const int t = min(max(J.t0 + slot, 0), J.ntiles - 1); const size_t off = (size_t)(J.krow0 + (t * 32 + row) * J.kstep) * J.kvpitch + c * 8;
        S.k[i] = *(const u32x4*)(J.K + off); S.v[i] = *(const u32x4*)(J.V + off); }
}
template <bool MEM>
__device__ __forceinline__ void attn_write_lds(const AttnStage<MEM>& S, LAS unsigned char* lds, int tid) {
#pragma unroll
    for (int i = 0; i < AttnStage<MEM>::NL; ++i) { const int q = tid + 512 * i, slot = q >> 8, row = (q >> 3) & 31, c = q & 7;
        *(LAS u32x4*)(lds + slot * 4096 + row * 128 + ((c ^ ((row >> 1) & 7)) << 4)) = S.k[i];
        *(LAS u32x4*)(lds + 49152 + slot * 4096 + row * 128 + ((c << 4) ^ (((row >> 1) & 1) << 6))) = S.v[i]; }
}
template <bool MEM, int NTC, int LI0>
__device__ __forceinline__ void attn_chunk(const AttnJob& J, const bf16x8 (&qf)[4], LAS unsigned char* lds, int wave, const int (&ka)[4], int tv0, int tv1, int mt,
                                           f32x16 (&o)[2], float& m_run, f32x2& l_run) {
    f32x16 s[NTC];
#pragma unroll
    for (int kt = 0; kt < NTC; ++kt) {
        constexpr int dummy = 0; (void)dummy;
        const int li = LI0 + kt, slot = MEM ? li : (wave + li);
        bf16x8 kf[4];
#pragma unroll
        for (int d0 = 0; d0 < 4; ++d0) kf[d0] = *(const LAS bf16x8*)(lds + ka[d0] + li * 4096);
        f32x16 a;
#pragma unroll
        for (int r = 0; r < 16; ++r) a[r] = 0.f;
#pragma unroll
        for (int d0 = 0; d0 < 4; ++d0) a = __builtin_amdgcn_mfma_f32_32x32x16_bf16(kf[d0], qf[d0], a, 0, 0, 0);
        if (!MEM) { const int traw = J.t0 + slot;
            if (li == 0 || li == 4) {
#pragma unroll
                for (int r = 0; r < 16; ++r) { const int cr = (r & 3) + 8 * (r >> 2); const bool keep = (li == 0) ? (cr >= mt) : (cr <= mt); a[r] = keep ? a[r] : -1e30f; } }
            if (traw < 0 || traw >= J.ntiles) {
                asm volatile("" ::: "memory");
#pragma unroll
                for (int r = 0; r < 16; ++r) a[r] = -1e30f; } }
        s[kt] = a;
    }
    float mx = -1e30f;
#pragma unroll
    for (int kt = 0; kt < NTC; ++kt)
#pragma unroll
        for (int r = 0; r < 16; ++r) mx = fmaxf(mx, s[kt][r]);
    mx = xor32_max(mx);
    const float m_new = fmaxf(m_run, mx);
    if (LI0 > 0) { const float alpha = __builtin_amdgcn_exp2f(m_run - m_new); const f32x2 al2 = {alpha, alpha}; l_run *= al2;
#pragma unroll
        for (int r = 0; r < 16; r += 2) { const f32x2 x0 = (f32x2){o[0][r], o[0][r + 1]} * al2, x1 = (f32x2){o[1][r], o[1][r + 1]} * al2; o[0][r] = x0.x; o[0][r + 1] = x0.y; o[1][r] = x1.x; o[1][r + 1] = x1.y; } }
    m_run = m_new; const f32x2 mn2 = {m_new, m_new};
#pragma unroll
    for (int kt = 0; kt < NTC; ++kt) {
        const int li = LI0 + kt;
#pragma unroll
        for (int r = 0; r < 16; r += 2) { f32x2 d = (f32x2){s[kt][r], s[kt][r + 1]} - mn2; d.x = __builtin_amdgcn_exp2f(d.x); d.y = __builtin_amdgcn_exp2f(d.y); s[kt][r] = d.x; s[kt][r + 1] = d.y; l_run += d; }
        bf16x8 pb[2];
#pragma unroll
        for (int s2 = 0; s2 < 2; ++s2) { u32x4 w; w.x = cvtpk(s[kt][8 * s2 + 0], s[kt][8 * s2 + 1]); w.y = cvtpk(s[kt][8 * s2 + 2], s[kt][8 * s2 + 3]);
            w.z = cvtpk(s[kt][8 * s2 + 4], s[kt][8 * s2 + 5]); w.w = cvtpk(s[kt][8 * s2 + 6], s[kt][8 * s2 + 7]); pb[s2] = __builtin_bit_cast(bf16x8, w); }
#pragma unroll
        for (int db = 0; db < 2; ++db)
#pragma unroll
            for (int s2 = 0; s2 < 2; ++s2) { const int tb = (db == 0) ? tv0 : tv1;
                const s16x4 lo = vtr(lds + tb + li * 4096 + s2 * 2048), h8 = vtr(lds + tb + li * 4096 + s2 * 2048 + 1024);
                const bf16x8 va = (bf16x8){lo[0], lo[1], lo[2], lo[3], h8[0], h8[1], h8[2], h8[3]};
                o[db] = __builtin_amdgcn_mfma_f32_32x32x16_bf16(va, pb[s2], o[db], 0, 0, 0); }
    }
}
template <bool MEM>
__device__ __forceinline__ void attn_compute(const AttnJob& J, const bf16x8 (&qf)[4], LAS unsigned char* lds, int wave, int lane) {
    const int r32 = lane & 31, hi = lane >> 5;
    f32x16 o[2];
#pragma unroll
    for (int r = 0; r < 16; ++r) { o[0][r] = 0.f; o[1][r] = 0.f; }
    float m_run = -1e30f; f32x2 l_run = {0.f, 0.f};
    const int ksw = (r32 >> 1) & 7, koff = r32 * 128 + (MEM ? 0 : wave * 4096);
    const int q4 = (lane & 15) >> 2, sw = (q4 >> 1) & 1, trow = (4 * hi + q4) * 128, tcol = ((lane >> 4) & 1) * 32 + (lane & 3) * 8;
    const int tv0 = 49152 + (MEM ? 0 : wave * 4096) + trow + ((sw << 6) | tcol), tv1 = 49152 + (MEM ? 0 : wave * 4096) + trow + (((1 ^ sw) << 6) | tcol);
    int ka[4];
#pragma unroll
    for (int d0 = 0; d0 < 4; ++d0) ka[d0] = koff + (((2 * d0 + hi) ^ ksw) << 4);
    int mt = r32 - 4 * hi; asm volatile("" : "+v"(mt));
    if (MEM) { attn_chunk<MEM, 3, 0>(J, qf, lds, wave, ka, tv0, tv1, mt, o, m_run, l_run); attn_chunk<MEM, 3, 3>(J, qf, lds, wave, ka, tv0, tv1, mt, o, m_run, l_run);
               attn_chunk<MEM, 2, 6>(J, qf, lds, wave, ka, tv0, tv1, mt, o, m_run, l_run); }
    else     { attn_chunk<MEM, 3, 0>(J, qf, lds, wave, ka, tv0, tv1, mt, o, m_run, l_run); attn_chunk<MEM, 2, 3>(J, qf, lds, wave, ka, tv0, tv1, mt, o, m_run, l_run); }
    const float l = xor32_sum(l_run.x + l_run.y);
    const float inv = 1.0f / l;
    const int qrow = J.qrow0 + (wave * 32 + r32) * J.qstep;
    LAS unsigned char* ot = lds + 98304 + wave * 4096;
#pragma unroll
    for (int db = 0; db < 2; ++db)
#pragma unroll
        for (int g = 0; g < 4; ++g) { u32x2 w; w.x = cvtpk(o[db][4 * g] * inv, o[db][4 * g + 1] * inv); w.y = cvtpk(o[db][4 * g + 2] * inv, o[db][4 * g + 3] * inv);
            *(LAS u32x2*)(ot + r32 * 128 + (32 * db + 8 * g + 4 * hi) * 2) = w; }
    if (J.lse != nullptr && hi == 0) J.lse[(size_t)qrow * J.lsepitch] = m_run + __builtin_amdgcn_logf(l);
    LDS_WAIT();
    { const int c = lane & 7, rr = lane >> 3; const size_t obase = (size_t)(J.qrow0 + wave * 32 * J.qstep) * J.opitch;
#pragma unroll
      for (int i = 0; i < 4; ++i) { const int row = rr + 8 * i; *(u32x4*)(J.O + obase + (size_t)(row * J.qstep) * J.opitch + c * 8) = *(const LAS u32x4*)(ot + row * 128 + c * 16); } }
}
template <bool MEM, class MakeJob>
__device__ __forceinline__ void attn_block_units(Frame& F, int first, int count, int stride, const MakeJob& mk) {
    if (first >= count) return;
    AttnStage<MEM> S; AttnJob J = mk(first); bf16x8 qn[4];
#define ATTN_LOAD_Q(JJ) do { const int qrow_ = (JJ).qrow0 + (F.wave * 32 + (F.lane & 31)) * (JJ).qstep; const bf16_t* qp_ = (JJ).Q + (size_t)qrow_ * (JJ).qpitch + (F.lane >> 5) * 8; \
        _Pragma("unroll") for (int d0 = 0; d0 < 4; ++d0) qn[d0] = *(const bf16x8*)(qp_ + d0 * 16); } while (0)
    attn_issue_loads<MEM>(J, S, F.tid); ATTN_LOAD_Q(J);
    for (int u = first; u < count; u += stride) {
        bf16x8 qf[4];
#pragma unroll
        for (int d0 = 0; d0 < 4; ++d0) qf[d0] = qn[d0];
        __syncthreads();
        attn_write_lds<MEM>(S, F.lds, F.tid);
        __syncthreads();
        const int un = u + stride; AttnJob Jn = J;
        if (un < count) { Jn = mk(un); attn_issue_loads<MEM>(Jn, S, F.tid); ATTN_LOAD_Q(Jn); }
        attn_compute<MEM>(J, qf, F.lds, F.wave, F.lane);
        J = Jn;
    }
    __syncthreads();
#undef ATTN_LOAD_Q
}

constexpr int POOL_DH = 40960, POOL_WT = POOL_DH + 64 * 528, POOL_DPITCH = 528, POOL_WPITCH = 144;
__device__ __forceinline__ void pool_unit(Frame& F, const bf16_t* PROJ, const float* pw, const float* pscale, bf16_t* YRAW, int tile) {
    const int tid = F.tid, row0 = tile * 64, pos0 = row0 & (SEQ - 1);
    LAS bf16_t* U = (LAS bf16_t*)F.lds;
    LAS unsigned char* Dh = F.lds + POOL_DH; LAS unsigned char* WT = F.lds + POOL_WT;
    { u32x4 uv[5];
#pragma unroll
      for (int q = 0; q < 5; ++q) { const int i = tid + 512 * q, r = i >> 5, ch = i & 31, pos = min(max(pos0 - 8 + r, 0), SEQ - 1);
          uv[q] = *(const u32x4*)(PROJ + (size_t)(row0 - pos0 + pos) * NIN + 1536 + ch * 8); }
#pragma unroll
      for (int q = 0; q < 5; ++q) { const int i = tid + 512 * q, r = i >> 5, ch = i & 31, pos = pos0 - 8 + r;
          *(LAS u32x4*)(U + r * 256 + ch * 8) = (pos >= 0 && pos < SEQ) ? uv[q] : (u32x4){0u, 0u, 0u, 0u}; } }
    { float pwv[32];
#pragma unroll
      for (int i = 0; i < 32; ++i) pwv[i] = pw[tid + 512 * i];
#pragma unroll
      for (int i = 0; i < 32; ++i) { const int idx = tid + 512 * i, dout = idx & 63, c = (idx >> 6) & 63, g = idx >> 12;
          *(LAS bf16_t*)(WT + (g * 64 + dout) * POOL_WPITCH + c * 2) = f2bf(pwv[i]); } }
    __syncthreads();
    { const int ch = tid & 255, g = ch >> 6, half = tid >> 8, w = 2 << g, left = w >> 1, right = w - 1 - left, i0 = half * 32;
      float s = 0.f;
#pragma unroll
      for (int k = 0; k < 16; ++k) if (k < w) s += bf1(U[(i0 - left + k + 8) * 256 + ch]);
#pragma unroll 2
      for (int ii = 0; ii < 32; ++ii) { const int i = i0 + ii, pos = pos0 + i; const int lo = max(pos - left, 0), hi = min(pos + right, SEQ - 1);
          *(LAS bf16_t*)(Dh + i * POOL_DPITCH + ch * 2) = f2bf(s / (float)(hi - lo + 1) - bf1(U[(i + 8) * 256 + ch]));
          s += bf1(U[(i + 1 + right + 8) * 256 + ch]) - bf1(U[(i - left + 8) * 256 + ch]); } }
    __syncthreads();
    { const int lane = F.lane, r32 = lane & 31, hi = lane >> 5, g = F.wave & 3, th = F.wave >> 2;
      bf16x8 af[4];
#pragma unroll
      for (int s = 0; s < 4; ++s) af[s] = *(const LAS bf16x8*)(Dh + (th * 32 + r32) * POOL_DPITCH + (g * 64 + 16 * s + 8 * hi) * 2);
#pragma unroll 1
      for (int nt = 0; nt < 2; ++nt) {
          f32x16 acc;
#pragma unroll
          for (int r = 0; r < 16; ++r) acc[r] = 0.f;
#pragma unroll
          for (int s = 0; s < 4; ++s) { const bf16x8 bfr = *(const LAS bf16x8*)(WT + (g * 64 + nt * 32 + r32) * POOL_WPITCH + (16 * s + 8 * hi) * 2);
              acc = __builtin_amdgcn_mfma_f32_32x32x16_bf16(bfr, af[s], acc, 0, 0, 0); }
          LAS unsigned char* yt = F.lds + (th * 32 + r32) * 528 + (g * 64 + nt * 32 + 4 * hi) * 2; const float* ps = pscale + g * 64 + nt * 32 + 4 * hi;
#pragma unroll
          for (int gq = 0; gq < 4; ++gq) { const f32x4 sc = *(const f32x4*)(ps + 8 * gq);
              u32x2 w; w.x = cvtpk(acc[4 * gq] * sc.x, acc[4 * gq + 1] * sc.y); w.y = cvtpk(acc[4 * gq + 2] * sc.z, acc[4 * gq + 3] * sc.w); *(LAS u32x2*)(yt + 16 * gq) = w; }
      } }
    __syncthreads();
#pragma unroll
    for (int i = 0; i < 4; ++i) { const int q = tid + 512 * i, tok = q >> 5, c = q & 31;
        *(u32x4*)(YRAW + (size_t)(row0 + tok) * 512 + c * 8) = *(const LAS u32x4*)(F.lds + tok * 528 + c * 16); }
    __syncthreads();
}

struct DilJob { const bf16_t* QH; bf16_t* AO; float* LSE;
    __device__ __forceinline__ AttnJob operator()(int bu) const {
        const int i8 = bu & 31, bhp = bu >> 5, p = bhp % 3, bh = bhp / 3, h = bh & 7, b = bh >> 3;
        const int dil = (p == 0) ? 1 : (p == 1 ? 4 : 16), tpr = 256 / dil, g8 = tpr >> 3, r = i8 / g8, jt0 = 8 * (i8 % g8);
        const size_t hs = (size_t)SEQ * 64;
        AttnJob J; J.Q = QH + (size_t)(b * 8 + h) * hs; J.qpitch = 64; J.qrow0 = r + jt0 * 32 * dil; J.qstep = dil;
        J.K = QH + (size_t)((2 + b) * 8 + h) * hs; J.V = QH + (size_t)((4 + b) * 8 + h) * hs; J.kvpitch = 64; J.krow0 = r; J.kstep = dil; J.t0 = jt0 - 2; J.ntiles = tpr;
        J.O = AO + (size_t)p * TOK * 512 + (size_t)b * SEQ * 512 + h * 64; J.opitch = 512; J.lse = LSE + (size_t)p * TOK * 8 + (size_t)b * SEQ * 8 + h; J.lsepitch = 8; return J; } };
struct MemJob { const bf16_t* PROJ; const bf16_t* MKV; bf16_t* YRAW;
    __device__ __forceinline__ AttnJob operator()(int mu) const {
        const int q8 = mu & 31, bh = mu >> 5, hm = bh & 3, b = bh >> 2;
        AttnJob J; J.Q = PROJ + 1792 + hm * 64; J.qpitch = NIN; J.qrow0 = b * SEQ + q8 * 256; J.qstep = 1;
        J.K = MKV + hm * 64; J.V = MKV + 256 + hm * 64; J.kvpitch = 512; J.krow0 = b * NMEM; J.kstep = 1; J.t0 = 0; J.ntiles = 8;
        J.O = YRAW + 256 + hm * 64; J.opitch = 512; J.lse = nullptr; J.lsepitch = 0; return J; } };

__device__ __forceinline__ void phase_mixers(Frame& F, int l, int parts = 7) {
    const bf16_t* PROJ = (const bf16_t*)(F.ws() + WS_PROJ); const bf16_t* QH = (const bf16_t*)(F.ws() + WS_QKVH);
    bf16_t* AO = (bf16_t*)(F.ws() + WS_AO); float* LSE = (float*)(F.ws() + WS_LSE); bf16_t* YRAW = (bf16_t*)(F.ws() + WS_YRAW);
    const bf16_t* MKV = (const bf16_t*)(F.ws() + WS_MEMKV) + (size_t)l * 512 * 512;
    const int pt = (parts == 7 && l == 0) ? (F.bid & 3) : -1;
    if (pt == 0) w8_static(F, 0, W8_GU_STEPS / 2 + F.bid, W8_GU_STEPS, F.G);
    if (parts & 1) { DilJob mk{QH, AO, LSE}; attn_block_units<false>(F, F.bid, 1536, F.G, mk); }
    if (pt == 1) w8_static(F, 0, W8_GU_STEPS / 2 + F.bid, W8_GU_STEPS, F.G);
    if (parts & 2) { MemJob mk{PROJ, MKV, YRAW}; attn_block_units<true>(F, F.bid, 256, F.G, mk); }
    if (pt == 2) w8_static(F, 0, W8_GU_STEPS / 2 + F.bid, W8_GU_STEPS, F.G);
    if (parts & 4) for (int tile = F.bid; tile < TOK / 64; tile += F.G) pool_unit(F, PROJ, F.in(IN_POOLW) + (size_t)l * 4 * 64 * 64, F.in(IN_POOLS) + l * 256, YRAW, tile);
    if (pt == 3) w8_static(F, 0, W8_GU_STEPS / 2 + F.bid, W8_GU_STEPS, F.G);
}

__device__ __forceinline__ void phase_combine_norm(Frame& F, int l) {
    const bf16_t* AO = (const bf16_t*)(F.ws() + WS_AO); const float* LSE = (const float*)(F.ws() + WS_LSE); const bf16_t* YRAW = (const bf16_t*)(F.ws() + WS_YRAW);
    bf16_t* Y = (bf16_t*)(F.ws() + WS_Y); const float* gg = F.in(IN_GRPG) + l * DM;
    const int gw = F.bid * 8 + F.wave, NGW = F.G * 8, lane = F.lane, head = lane >> 3;
    float lsn[2][3]; u32x4 avn[2][3]; u32x2 pvn[2], mvn[2];
#define CN_LOAD(r0_) do { _Pragma("unroll") for (int a = 0; a < 2; ++a) { const size_t row = (size_t)min((r0_) + a * NGW, TOK - 1); \
            _Pragma("unroll") for (int p = 0; p < 3; ++p) { lsn[a][p] = LSE[(size_t)p * TOK * 8 + row * 8 + head]; avn[a][p] = __builtin_nontemporal_load((const u32x4*)(AO + (size_t)p * TOK * 512 + row * 512 + lane * 8)); } \
            pvn[a] = *(const u32x2*)(YRAW + row * 512 + lane * 4); mvn[a] = *(const u32x2*)(YRAW + row * 512 + 256 + lane * 4); } } while (0)
    CN_LOAD(gw);
    for (int r0 = gw; r0 < TOK; r0 += 2 * NGW) {
        float ls[2][3]; u32x4 av[2][3]; u32x2 pv[2], mv[2];
#pragma unroll
        for (int a = 0; a < 2; ++a) { pv[a] = pvn[a]; mv[a] = mvn[a];
#pragma unroll
            for (int p = 0; p < 3; ++p) { ls[a][p] = lsn[a][p]; av[a][p] = avn[a][p]; } }
        if (r0 + 2 * NGW < TOK) CN_LOAD(r0 + 2 * NGW);
#pragma unroll
        for (int a = 0; a < 2; ++a) { const int rowi = r0 + a * NGW; if (rowi >= TOK) break; const size_t row = (size_t)rowi;
            const float l0 = ls[a][0], l1 = ls[a][1], l2 = ls[a][2]; const u32x4 a0 = av[a][0], a1 = av[a][1], a2 = av[a][2];
            const float mx = fmaxf(l0, fmaxf(l1, l2));
            float w0 = __builtin_amdgcn_exp2f(l0 - mx), w1 = __builtin_amdgcn_exp2f(l1 - mx), w2 = __builtin_amdgcn_exp2f(l2 - mx);
            const float wi = 1.0f / (w0 + w1 + w2); w0 *= wi; w1 *= wi; w2 *= wi;
            float y[8]; float ss = 0.f;
#pragma unroll
            for (int i = 0; i < 4; ++i) { y[2 * i] = w0 * bflo(a0[i]) + w1 * bflo(a1[i]) + w2 * bflo(a2[i]); y[2 * i + 1] = w0 * bfhi(a0[i]) + w1 * bfhi(a1[i]) + w2 * bfhi(a2[i]); ss += y[2 * i] * y[2 * i] + y[2 * i + 1] * y[2 * i + 1]; }
            const float p0 = bflo(pv[a].x), p1 = bfhi(pv[a].x), p2 = bflo(pv[a].y), p3 = bfhi(pv[a].y);
            const float q0 = bflo(mv[a].x), q1 = bfhi(mv[a].x), q2 = bflo(mv[a].y), q3 = bfhi(mv[a].y);
            float sp = p0 * p0 + p1 * p1 + p2 * p2 + p3 * p3, sq = q0 * q0 + q1 * q1 + q2 * q2 + q3 * q3;
            ss = wave_sum(ss); sp = wave_sum(sp); sq = wave_sum(sq);
            const float rs = rsqrtf(ss * (1.f / 512.f) + EPS), rp = rsqrtf(sp * (1.f / 256.f) + EPS), rq = rsqrtf(sq * (1.f / 256.f) + EPS);
            const f32x4 g0 = *(const f32x4*)(gg + lane * 8), g1 = *(const f32x4*)(gg + lane * 8 + 4), gp = *(const f32x4*)(gg + 512 + lane * 4), gq = *(const f32x4*)(gg + 768 + lane * 4);
            u32x4 wv; wv.x = cvtpk(y[0] * rs * g0.x, y[1] * rs * g0.y); wv.y = cvtpk(y[2] * rs * g0.z, y[3] * rs * g0.w); wv.z = cvtpk(y[4] * rs * g1.x, y[5] * rs * g1.y); wv.w = cvtpk(y[6] * rs * g1.z, y[7] * rs * g1.w);
            *(u32x4*)(Y + row * DM + lane * 8) = wv;
            u32x2 op; op.x = cvtpk(p0 * rp * gp.x, p1 * rp * gp.y); op.y = cvtpk(p2 * rp * gp.z, p3 * rp * gp.w); *(u32x2*)(Y + row * DM + 512 + lane * 4) = op;
            u32x2 oq; oq.x = cvtpk(q0 * rq * gq.x, q1 * rq * gq.y); oq.y = cvtpk(q2 * rq * gq.z, q3 * rq * gq.w); *(u32x2*)(Y + row * DM + 768 + lane * 4) = oq; }
    }
}

#undef CN_LOAD
__device__ __forceinline__ void phase_router(Frame& F, int l) {
    const bf16_t* X1 = (const bf16_t*)(F.ws() + WS_X1); unsigned char* H2 = F.ws() + WS_H2;
    const float* g2 = F.in(IN_N2G) + l * DM; const float* Wr = F.in(IN_RW) + (size_t)l * DM * NE; const float* rb = F.in(IN_RB) + l * NE;
    int* rt_e = (int*)(F.ws() + WS_RT); int* rt_rank = rt_e + TOK * TOPK; float* rt_gate = (float*)(rt_rank + TOK * TOPK); int* elist = (int*)(F.ws() + WS_ELIST);
    unsigned* gcnt = (unsigned*)(F.ws() + WS_CTL) + CW_CNT + 64 * l;
    LAS float* hb = (LAS float*)F.lds;
    LAS float* pl = (LAS float*)(F.lds + 65536);
    LAS int* lcnt = (LAS int*)(F.lds + MISC_OFF + 1024);
    LAS int* lbase = lcnt + 32;
    LAS int* le = lcnt + 64;
    LAS int* lrank = le + 256;
    const int lane = F.lane, e = lane & 31, half = lane >> 5, w = F.wave;
    f32x2 wreg[32];
#pragma unroll
    for (int i = 0; i < 32; ++i) { wreg[i].x = Wr[(size_t)(128 * w + 64 * half + 2 * i) * NE + e]; wreg[i].y = Wr[(size_t)(128 * w + 64 * half + 2 * i + 1) * NE + e]; }
    const float bias = rb[e];
    for (int tg = F.bid; tg < TOK / 64; tg += F.G) {
        if (F.tid < 32) lcnt[F.tid] = 0;
        __syncthreads();
        u32x2 xv[2][4];
#pragma unroll
        for (int i2 = 0; i2 < 2; ++i2)
#pragma unroll
            for (int j = 0; j < 4; ++j) xv[i2][j] = ((const u32x2*)(X1 + ((size_t)tg * 64 + 2 * w + i2) * DM))[lane + 64 * j];
#pragma unroll 1
        for (int b = 0; b < 4; ++b) {
#pragma unroll
            for (int i2 = 0; i2 < 2; ++i2) { const int ti = 2 * w + i2; const size_t row = (size_t)tg * 64 + 16 * b + ti;
                f32x4 v[4]; float ss = 0.f;
#pragma unroll
                for (int j = 0; j < 4; ++j) { v[j] = (f32x4){bflo(xv[i2][j].x), bfhi(xv[i2][j].x), bflo(xv[i2][j].y), bfhi(xv[i2][j].y)}; ss += (v[j].x * v[j].x + v[j].y * v[j].y) + (v[j].z * v[j].z + v[j].w * v[j].w); }
                const float rs = rsqrtf(wave_sum(ss) * (1.f / DM) + EPS);
#pragma unroll
                for (int j = 0; j < 4; ++j) { const f32x4 gv = ((const f32x4*)g2)[lane + 64 * j]; const f32x4 o = v[j] * rs * gv;
                    int w8 = 0; w8 = __builtin_amdgcn_cvt_pk_fp8_f32(o.x, o.y, w8, false); w8 = __builtin_amdgcn_cvt_pk_fp8_f32(o.z, o.w, w8, true); ((int*)(H2 + row * DM))[lane + 64 * j] = w8;
                    *(LAS f32x4*)(hb + ti * 1024 + (lane + 64 * j) * 4) = o; } }
            if (b < 3) {
#pragma unroll
                for (int i2 = 0; i2 < 2; ++i2)
#pragma unroll
                    for (int j = 0; j < 4; ++j) xv[i2][j] = ((const u32x2*)(X1 + ((size_t)tg * 64 + 16 * (b + 1) + 2 * w + i2) * DM))[lane + 64 * j]; }
            __syncthreads();
#pragma unroll 2
            for (int t = 0; t < 16; ++t) { const LAS float* hp = hb + t * 1024 + 128 * w + 64 * half; f32x2 a0 = {0.f, 0.f}, a1 = {0.f, 0.f};
#pragma unroll
                for (int i = 0; i < 64; i += 4) { const f32x4 hv = *(const LAS f32x4*)(hp + i); a0 += (f32x2){hv.x, hv.y} * wreg[i >> 1]; a1 += (f32x2){hv.z, hv.w} * wreg[(i >> 1) + 1]; }
                const float p = xor32_sum((a0.x + a0.y) + (a1.x + a1.y));
                if (lane < 32) pl[(w * 16 + t) * 32 + e] = p; }
            __syncthreads();
#pragma unroll
            for (int i2 = 0; i2 < 2; ++i2) { const int ti = 2 * w + i2, tl = 16 * b + ti;
                float v = bias;
#pragma unroll
                for (int ww = 0; ww < 8; ++ww) v += pl[(ww * 16 + ti) * 32 + e];
                float tv[4]; int tix[4];
#pragma unroll
                for (int k = 0; k < 4; ++k) { float bv = v; int bi = e;
#define TOPK_STEP(M) { const float ov = swz_f<M>(bv); const int oi = swz_i<M>(bi); if (ov > bv || (ov == bv && oi < bi)) { bv = ov; bi = oi; } }
                    TOPK_STEP(1) TOPK_STEP(2) TOPK_STEP(4) TOPK_STEP(8)
#undef TOPK_STEP
                    { const auto rv = __builtin_amdgcn_permlane16_swap(__float_as_uint(bv), __float_as_uint(bv), false, false); const auto ri = __builtin_amdgcn_permlane16_swap((unsigned)bi, (unsigned)bi, false, false);
                      const float v0 = __uint_as_float(rv[0]), v1 = __uint_as_float(rv[1]); const int i0 = (int)ri[0], i1 = (int)ri[1];
                      const bool t1 = (v1 > v0) || (v1 == v0 && i1 < i0); bv = t1 ? v1 : v0; bi = t1 ? i1 : i0; }
                    tv[k] = bv; tix[k] = bi; if (e == bi) v = -3.0e38f; }
                const float e1 = __expf(tv[1] - tv[0]), e2 = __expf(tv[2] - tv[0]), e3 = __expf(tv[3] - tv[0]); const float isum = 1.0f / (1.0f + e1 + e2 + e3);
                if (lane < 4) { const int me = (lane == 0) ? tix[0] : (lane == 1) ? tix[1] : (lane == 2) ? tix[2] : tix[3];
                    const float gt = ((lane == 0) ? 1.0f : (lane == 1) ? e1 : (lane == 2) ? e2 : e3) * isum;
                    const int lr = __hip_atomic_fetch_add(lcnt + me, 1, __ATOMIC_RELAXED, __HIP_MEMORY_SCOPE_WORKGROUP);
                    le[tl * 4 + lane] = me; lrank[tl * 4 + lane] = lr; rt_gate[((size_t)tg * 64 + tl) * 4 + lane] = gt; } }
        }
        __syncthreads();
        if (F.tid < 32) lbase[F.tid] = (int)__hip_atomic_fetch_add(gcnt + F.tid, (unsigned)lcnt[F.tid], __ATOMIC_RELAXED, __HIP_MEMORY_SCOPE_AGENT);
        __syncthreads();
        if (F.tid < 256) { const int me = le[F.tid], rk = lbase[me] + lrank[F.tid]; rt_e[(size_t)tg * 256 + F.tid] = me; rt_rank[(size_t)tg * 256 + F.tid] = rk; elist[(size_t)me * TOK + rk] = tg * 64 + (F.tid >> 2); }
        __syncthreads();
    }
}

__device__ __forceinline__ LAS int* moe_tile_table(Frame& F, int l) {
    LAS int* tstart = (LAS int*)(F.lds + MISC_OFF + 512);
    const unsigned* gcnt = (const unsigned*)(F.ws() + WS_CTL) + CW_CNT + 64 * l;
    if (F.tid < 64) {
        const int e = F.lane & 31; const int cnt = (int)__hip_atomic_load(gcnt + e, __ATOMIC_RELAXED, __HIP_MEMORY_SCOPE_AGENT); const int mt = (cnt + 255) >> 8;
        int inc = mt;
#pragma unroll
        for (int o = 1; o < 32; o <<= 1) { const int t = __builtin_amdgcn_ds_bpermute(((F.lane - o) & 63) << 2, inc); if (e >= o) inc += t; }
        if (F.lane < 32) { tstart[80 + e] = cnt; tstart[40 + e] = mt; tstart[e] = inc - mt; if (e == 31) tstart[32] = inc; } }
    __syncthreads();
    return tstart;
}

__device__ __forceinline__ void phase_moe_combine(Frame& F, int l) {
    const bf16_t* X1 = (const bf16_t*)(F.ws() + WS_X1); bf16_t* X2 = (bf16_t*)(F.ws() + WS_X2); const unsigned char* YS = F.ws() + WS_YS;
    LAS int* tstart = moe_tile_table(F, l);
    const int* rt_e = (const int*)(F.ws() + WS_RT); const int* rt_rank = rt_e + TOK * TOPK; const float* rt_gate = (const float*)(F.ws() + WS_RT) + 2 * TOK * TOPK;
    bf16_t* XN = (bf16_t*)(F.ws() + WS_XN);
    const bool lastl = (l == DEPTH - 1);
    const float* gn = lastl ? F.in(IN_FING) : (F.in(IN_N1G) + (l + 1) * DM);
    const int gw = F.bid * 8 + F.wave, NGW = F.G * 8, lane = F.lane;
    typedef int i32x4 __attribute__((ext_vector_type(4)));
    i32x4 een[2], sln[2]; f32x4 gtn[2];
#pragma unroll
    for (int a = 0; a < 2; ++a) { const int t = min(gw + a * NGW, TOK - 1); een[a] = *(const i32x4*)(rt_e + (size_t)t * 4); sln[a] = *(const i32x4*)(rt_rank + (size_t)t * 4); gtn[a] = *(const f32x4*)(rt_gate + (size_t)t * 4); }
    for (int t0 = gw; t0 < TOK; t0 += 2 * NGW) {
        i32x4 sl[2]; f32x4 gt[2]; f32x4 v[2][4]; u32x4 xb[2][2]; u32x2 y[2][4][2];
#pragma unroll
        for (int a = 0; a < 2; ++a) { const int t = min(t0 + a * NGW, TOK - 1); const i32x4 ee = een[a]; sl[a] = sln[a]; gt[a] = gtn[a];
            sl[a].x += tstart[ee.x] * 256; sl[a].y += tstart[ee.y] * 256; sl[a].z += tstart[ee.z] * 256; sl[a].w += tstart[ee.w] * 256;
            const bf16_t* xr = X1 + (size_t)t * DM + lane * 8; xb[a][0] = *(const u32x4*)xr; xb[a][1] = *(const u32x4*)(xr + 512); }
#pragma unroll
        for (int a = 0; a < 2; ++a)
#pragma unroll
            for (int k = 0; k < 4; ++k) { const unsigned char* yr = YS + (size_t)sl[a][k] * DM + lane * 8; y[a][k][0] = __builtin_nontemporal_load((const u32x2*)yr); y[a][k][1] = __builtin_nontemporal_load((const u32x2*)(yr + 512)); }
#pragma unroll
        for (int a = 0; a < 2; ++a) { const int t = min(t0 + 2 * NGW + a * NGW, TOK - 1); een[a] = *(const i32x4*)(rt_e + (size_t)t * 4); sln[a] = *(const i32x4*)(rt_rank + (size_t)t * 4); gtn[a] = *(const f32x4*)(rt_gate + (size_t)t * 4); }
#pragma unroll
        for (int a = 0; a < 2; ++a) { const int t = t0 + a * NGW; if (t >= TOK) break;
#pragma unroll
            for (int hf = 0; hf < 2; ++hf) { const u32x4 r = xb[a][hf]; v[a][2 * hf] = (f32x4){bflo(r.x), bfhi(r.x), bflo(r.y), bfhi(r.y)}; v[a][2 * hf + 1] = (f32x4){bflo(r.z), bfhi(r.z), bflo(r.w), bfhi(r.w)}; }
#pragma unroll
            for (int k = 0; k < 4; ++k) { const float g = gt[a][k];
#pragma unroll
                for (int hf = 0; hf < 2; ++hf) { const u32x2 yy = y[a][k][hf];
                    const f32x2 p0 = __builtin_amdgcn_cvt_pk_f32_fp8((int)yy.x, false), p1 = __builtin_amdgcn_cvt_pk_f32_fp8((int)yy.x, true), p2 = __builtin_amdgcn_cvt_pk_f32_fp8((int)yy.y, false), p3 = __builtin_amdgcn_cvt_pk_f32_fp8((int)yy.y, true);
                    v[a][2 * hf][0] += g * p0.x; v[a][2 * hf][1] += g * p0.y; v[a][2 * hf][2] += g * p1.x; v[a][2 * hf][3] += g * p1.y;
                    v[a][2 * hf + 1][0] += g * p2.x; v[a][2 * hf + 1][1] += g * p2.y; v[a][2 * hf + 1][2] += g * p3.x; v[a][2 * hf + 1][3] += g * p3.y; } }
            float ss = 0.f;
#pragma unroll
            for (int j = 0; j < 4; ++j) ss += (v[a][j].x * v[a][j].x + v[a][j].y * v[a][j].y) + (v[a][j].z * v[a][j].z + v[a][j].w * v[a][j].w);
            const float rs = rsqrtf(wave_sum(ss) * (1.f / DM) + EPS);
            const float* gr = gn + lane * 8; f32x4 o[4];
            o[0] = v[a][0] * rs * *(const f32x4*)gr; o[1] = v[a][1] * rs * *(const f32x4*)(gr + 4); o[2] = v[a][2] * rs * *(const f32x4*)(gr + 512); o[3] = v[a][3] * rs * *(const f32x4*)(gr + 516);
            if (lastl) { float* orow = F.out() + (size_t)t * DM + lane * 8; *(f32x4*)orow = o[0]; *(f32x4*)(orow + 4) = o[1]; *(f32x4*)(orow + 512) = o[2]; *(f32x4*)(orow + 516) = o[3]; }
            else { bf16_t* xr = X2 + (size_t)t * DM + lane * 8; u32x4 x0, x1;
                x0.x = cvtpk(v[a][0].x, v[a][0].y); x0.y = cvtpk(v[a][0].z, v[a][0].w); x0.z = cvtpk(v[a][1].x, v[a][1].y); x0.w = cvtpk(v[a][1].z, v[a][1].w);
                x1.x = cvtpk(v[a][2].x, v[a][2].y); x1.y = cvtpk(v[a][2].z, v[a][2].w); x1.z = cvtpk(v[a][3].x, v[a][3].y); x1.w = cvtpk(v[a][3].z, v[a][3].w);
                *(u32x4*)xr = x0; *(u32x4*)(xr + 512) = x1;
                bf16_t* nr = XN + (size_t)t * DM + lane * 8; u32x4 w0, w1;
                w0.x = cvtpk(o[0].x, o[0].y); w0.y = cvtpk(o[0].z, o[0].w); w0.z = cvtpk(o[1].x, o[1].y); w0.w = cvtpk(o[1].z, o[1].w);
                w1.x = cvtpk(o[2].x, o[2].y); w1.y = cvtpk(o[2].z, o[2].w); w1.z = cvtpk(o[3].x, o[3].y); w1.w = cvtpk(o[3].z, o[3].w);
                *(u32x4*)nr = w0; *(u32x4*)(nr + 512) = w1; }
        }
    }
}

constexpr int PH_PER_LAYER = 8, N_PHASES = 1 + DEPTH * PH_PER_LAYER;

__global__ void __launch_bounds__(512, 2) enc_fwd(Args args) {
    extern __shared__ __attribute__((aligned(16))) unsigned char lds_raw[];
    Frame F;
    const int wave0 = __builtin_amdgcn_readfirstlane((int)threadIdx.x >> 6);
    F.lds = (LAS unsigned char*)lds_raw; F.lane = (int)__builtin_amdgcn_mbcnt_hi(~0u, __builtin_amdgcn_mbcnt_lo(~0u, 0u)); F.wave = wave0; F.tid = wave0 * 64 + F.lane; F.G = gridDim.x; F.bid = blockIdx.x;
    static_assert(sizeof(Args) == 168, "kernarg layout: in[18] | out | ws | ph_lo, ph_hi");
    F.kp = (const CAS unsigned char*)__builtin_amdgcn_kernarg_segment_ptr();
    const int lo = args.ph_lo, hi = args.ph_hi;
    volatile LAS unsigned* bst = (volatile LAS unsigned*)(F.lds + MISC_OFF + 64);
    if (F.tid < 2) bst[F.tid] = 0u;
    __syncthreads();
    XcdBarrier xbar; xbar.bar = (unsigned*)(F.ws() + WS_CTL) + CW_BAR; xbar.x = 0; xbar.st = bst;
    if (hi - lo > 1) xbar = xcd_barrier_post((unsigned*)(F.ws() + WS_CTL) + CW_BAR, bst, F.tid);
    for (int ph = lo; ph < hi; ++ph) {
        int phv = ph; asm volatile("" : "+s"(phv));
        { int lv = (int)__builtin_amdgcn_mbcnt_hi(~0u, __builtin_amdgcn_mbcnt_lo(~0u, 0u)); asm volatile("" : "+v"(lv)); F.lane = lv; F.wave = wave0; F.tid = wave0 * 64 + lv;
          int bv = blockIdx.x; asm volatile("" : "+s"(bv)); F.bid = bv;
          const CAS unsigned char* kpv = (const CAS unsigned char*)__builtin_amdgcn_kernarg_segment_ptr(); asm volatile("" : "+s"(kpv)); F.kp = kpv; }
        if (phv == 0) prologue(F);
#ifdef PROBE_VARIANT
        else if (phv >= 100) phase_mixers(F, 0, phv - 100);
#endif
        else {
            const int l = (phv - 1) / PH_PER_LAYER, k = (phv - 1) % PH_PER_LAYER;
            const int vcu = (F.G % 8 == 0) ? (F.bid % 8) * (F.G / 8) + F.bid / 8 : F.bid;
            if (k == 0) {
                { pg8::Gemm g{(const bf16_t*)(F.ws() + WS_XN), (const bf16_t*)(F.ws() + WS_WIN) + (size_t)l * NIN * DM, DM, 0}; pg8::StaticOrder S; S.init(TOK, NIN, F.G, F.bid);
                  pg8::EpiProj E{(bf16_t*)(F.ws() + WS_PROJ), (const float*)(F.ws() + WS_COS), (const float*)(F.ws() + WS_SIN), (bf16_t*)(F.ws() + WS_QKVH)};
                  pg8::gemm_phase<pg8::EpiProj, pg8::StaticOrder, true, true>(F.lds, F.tid, g, S, E); }
                if (l == 0) {
                    for (int ll = 0; ll < DEPTH; ++ll) {
                        pg8::Gemm g{(const bf16_t*)(F.ws() + WS_MEMN) + (size_t)ll * 512 * DM, (const bf16_t*)(F.ws() + WS_WMKV) + (size_t)ll * 512 * DM, DM, 0}; pg8::StaticOrder S; S.init(512, 512, F.G, (F.bid + F.G - 8 - 8 * ll) % F.G);
                        pg8::EpiBf16 E{(bf16_t*)(F.ws() + WS_MEMKV) + (size_t)ll * 512 * 512, 512, nullptr, 0, 1.0f};
                        pg8::gemm_phase<pg8::EpiBf16, pg8::StaticOrder, false, true>(F.lds, F.tid, g, S, E); }
                    { const int hb = F.G >> 1; if (F.bid >= hb) w8_static(F, 0, F.bid - hb, W8_GU_STEPS / 2, F.G - hb); }
                    { unsigned* ctl = (unsigned*)(F.ws() + WS_CTL); __syncthreads(); if (F.tid == 0) __hip_atomic_fetch_add(ctl + CW_DONE, 1u, __ATOMIC_RELAXED, __HIP_MEMORY_SCOPE_AGENT); w8_help(F, ctl + CW_W8NEXT, ctl + CW_DONE); }
                }
            } else if (k == 1) phase_mixers(F, l);
            else if (k == 2) phase_combine_norm(F, l);
            else if (k == 3) {
                pg8::Gemm g{(const bf16_t*)(F.ws() + WS_Y), (const bf16_t*)(F.ws() + WS_WOUT) + (size_t)l * DM * DM, DM, 0}; pg8::StaticOrder S; S.init(TOK, DM, F.G, F.bid);
                if (l == 0) { pg8::EpiRes<false> E{F.in(IN_X), (bf16_t*)(F.ws() + WS_X1)}; pg8::gemm_phase<pg8::EpiRes<false>, pg8::StaticOrder, false, true>(F.lds, F.tid, g, S, E); }
                else        { pg8::EpiRes<true> E{F.ws() + WS_X2, (bf16_t*)(F.ws() + WS_X1)}; pg8::gemm_phase<pg8::EpiRes<true>, pg8::StaticOrder, false, true>(F.lds, F.tid, g, S, E); }
            } else if (k == 4) { w8_help(F, (unsigned*)(F.ws() + WS_CTL) + CW_W8NEXT, nullptr, (l == 0) ? W8_Q_DN0 : W8_Q_TOTAL); phase_router(F, l); }
            else if (k == 5) {
                LAS int* tstart = moe_tile_table(F, l);
                pg8::MoeOrder S{tstart, 8, 4, F.G, vcu};
                LAS int* gtok = (LAS int*)(F.lds + MISC_OFF + 4096);
                { const int* elist = (const int*)(F.ws() + WS_ELIST); int tkv[9];
#pragma unroll
                  for (int i = 0; i < 9; ++i) { pg8::Unit u; const bool ok = S.next(i, u); const int ee = ok ? u.e : 0, idx = ok ? (u.pm - tstart[ee]) * 256 + (F.tid & 255) : 0;
                      const int tk = elist[(size_t)ee * TOK + idx]; tkv[i] = (ok && idx < tstart[80 + ee]) ? tk : 0; }
                  if (F.tid < 256) {
#pragma unroll
                      for (int i = 0; i < 9; ++i) gtok[i * 256 + F.tid] = tkv[i]; }
                  __syncthreads(); }
                pg8::Gemm g{(const bf16_t*)(F.ws() + WS_H2), (const bf16_t*)(F.ws() + WS_WGU + (size_t)l * NE * 2048 * DM), DM, (size_t)2048 * DM, gtok};
                pg8::EpiSwiglu E{F.ws() + WS_ACT, F.in(IN_BGU) + (size_t)l * NE * 2048, 1.0f / W8SCALE};
                pg8::gemm_phase<pg8::EpiSwiglu, pg8::MoeOrder, true, true, true, true>(F.lds, F.tid, g, S, E);
                if (l == 0) { unsigned* ctl = (unsigned*)(F.ws() + WS_CTL); __syncthreads(); if (F.tid == 0) __hip_atomic_fetch_add(ctl + CW_DONE + 64 * 5, 1u, __ATOMIC_RELAXED, __HIP_MEMORY_SCOPE_AGENT); w8_help(F, ctl + CW_W8NEXT, ctl + CW_DONE + 64 * 5); }
            } else if (k == 6) {
                LAS int* tstart = moe_tile_table(F, l);
                pg8::Gemm g{(const bf16_t*)(F.ws() + WS_ACT), (const bf16_t*)(F.ws() + WS_WDN + (size_t)l * NE * DM * DM), DM, (size_t)DM * DM};
                pg8::MoeOrder S{tstart, 4, 8, F.G, vcu};
                pg8::EpiF8 E{F.ws() + WS_YS, DM, F.in(IN_BDN) + (size_t)l * NE * DM, DM, 1.0f / W8SCALE};
                pg8::gemm_phase<pg8::EpiF8, pg8::MoeOrder, true, true, true>(F.lds, F.tid, g, S, E);
                if (l == 0) { unsigned* ctl = (unsigned*)(F.ws() + WS_CTL); __syncthreads(); if (F.tid == 0) __hip_atomic_fetch_add(ctl + CW_DONE + 64 * 6, 1u, __ATOMIC_RELAXED, __HIP_MEMORY_SCOPE_AGENT); w8_help(F, ctl + CW_W8NEXT, ctl + CW_DONE + 64 * 6); }
            } else phase_moe_combine(F, l);
        }
        if (ph + 1 < hi) { if (lo < 0) cg::this_grid().sync(); else { xbar.bar = (unsigned*)(F.ws() + WS_CTL) + CW_BAR; xcd_barrier(xbar, F.tid); } }
    }
}

extern "C" void kernel_launch(void* const* d_in, const int* in_sizes, int n_in, void* d_out, int out_size, void* d_ws, size_t ws_size, hipStream_t stream) {
    static int grid = 0;
    if (grid == 0) {
        if (n_in != 18 || in_sizes[0] != TOK * DM || out_size != TOK * DM || ws_size < WS_END) { fprintf(stderr, "kernel_launch: unexpected shapes / workspace (n_in %d, ws %zu)\n", n_in, ws_size); grid = -1; return; }
        int dev = 0, cus = 0, per_cu = 0;
        if (hipGetDevice(&dev) != hipSuccess || hipDeviceGetAttribute(&cus, hipDeviceAttributeMultiprocessorCount, dev) != hipSuccess) { grid = -1; return; }
        if (hipFuncSetAttribute((const void*)enc_fwd, hipFuncAttributeMaxDynamicSharedMemorySize, LDS_BYTES) != hipSuccess) { fprintf(stderr, "kernel_launch: hipFuncSetAttribute failed\n"); grid = -1; return; }
        if (hipOccupancyMaxActiveBlocksPerMultiprocessor(&per_cu, (const void*)enc_fwd, 512, LDS_BYTES) != hipSuccess || per_cu < 1) { fprintf(stderr, "kernel_launch: note: occupancy query says %d blocks/CU\n", per_cu); (void)hipGetLastError(); }
        grid = cus;
    }
    if (grid < 0) return;
    (void)hipMemsetAsync((char*)d_ws + WS_CTL, 0, CTL_BYTES, stream);
    Args a{};
    for (int i = 0; i < 18; ++i) a.in[i] = (const float*)d_in[i];
    a.out = (float*)d_out; a.ws = (unsigned char*)d_ws;
#if MK_ONE_LAUNCH
    a.ph_lo = 0; a.ph_hi = N_PHASES;
    void* kargs[] = {&a};
    hipError_t e = hipLaunchCooperativeKernel((const void*)enc_fwd, dim3(grid), dim3(512), kargs, LDS_BYTES, stream);
    if (e != hipSuccess) fprintf(stderr, "cooperative launch failed: %s (grid %d)\n", hipGetErrorString(e), grid);
#else
    for (int p = 0; p < N_PHASES; ++p) { a.ph_lo = p; a.ph_hi = p + 1; hipLaunchKernelGGL(enc_fwd, dim3(grid), dim3(512), LDS_BYTES, stream, a);
#ifdef PROBE_PH
        if (p == PROBE_PH) for (int r = 0; r < PROBE_REP; ++r) {
#ifdef PROBE_VARIANT
            a.ph_lo = PROBE_VARIANT; a.ph_hi = PROBE_VARIANT + 1;
#endif
            hipLaunchKernelGGL(enc_fwd, dim3(grid), dim3(512), LDS_BYTES, stream, a); }
#endif
    }
#endif
}
```

```cpp
#include <hip/hip_runtime.h>
#include <hip/hip_cooperative_groups.h>
#include <cstdio>
#include <cstdint>
namespace cg = cooperative_groups;

#ifndef MK_ONE_LAUNCH
#define MK_ONE_LAUNCH 1
#endif

#define LAS __attribute__((address_space(3)))
typedef unsigned short bf16_t;
typedef short bf16x8 __attribute__((ext_vector_type(8)));
typedef short s16x4 __attribute__((ext_vector_type(4)));
typedef float f32x4 __attribute__((ext_vector_type(4)));
typedef float f32x2 __attribute__((ext_vector_type(2)));
typedef float f32x16 __attribute__((ext_vector_type(16)));
typedef unsigned u32x4 __attribute__((ext_vector_type(4)));
typedef unsigned u32x2 __attribute__((ext_vector_type(2)));

constexpr int BATCH = 2, SEQ = 8192, TOK = BATCH * SEQ, DM = 1024, NIN = 2048, NE = 32, TOPK = 4, NMEM = 256, DEPTH = 2;
constexpr float EPS = 1e-5f;
constexpr float QSCALE = 0.125f * 1.4426950408889634f;
constexpr int MAXT = 288;
constexpr float W8SCALE = 32.0f;

constexpr size_t MiB = 1u << 20;
constexpr size_t WS_CTL = 0, CTL_BYTES = 64 * 1024;
constexpr size_t WS_COS = 1 * MiB, WS_SIN = 2 * MiB;
constexpr size_t WS_WIN = 4 * MiB;
constexpr size_t WS_WOUT = 12 * MiB;
constexpr size_t WS_WMKV = 16 * MiB;
constexpr size_t WS_MEMKV = 18 * MiB;
constexpr size_t WS_MEMN = 20 * MiB;
constexpr size_t WS_RT = 22 * MiB;
constexpr size_t WS_LSE = 24 * MiB;
constexpr size_t WS_WGU = 32 * MiB;
constexpr size_t WS_WDN = 288 * MiB;
constexpr size_t WS_XN = 416 * MiB;
constexpr size_t WS_PROJ = 448 * MiB;
constexpr size_t WS_AO = 512 * MiB;
constexpr size_t WS_YRAW = 560 * MiB;
constexpr size_t WS_Y = 576 * MiB;
constexpr size_t WS_X1 = 608 * MiB;
constexpr size_t WS_X2 = 672 * MiB;
constexpr size_t WS_H2 = 736 * MiB;
constexpr size_t WS_ASLOT = 768 * MiB;
constexpr size_t WS_ACT = 912 * MiB;
constexpr size_t WS_YS = 1056 * MiB;
constexpr size_t WS_QKVH = 1200 * MiB;
constexpr size_t WS_ELIST = 1248 * MiB;
constexpr size_t WS_END = 1252 * MiB;
constexpr int CW_CNT = 1024;
constexpr int CW_BAR = 4096;
constexpr int CW_W8NEXT = 2048;
constexpr int CW_DONE = 2112;

constexpr int RING_BYTES = 131072, MISC_OFF = RING_BYTES, LDS_BYTES = 147456;

__device__ __forceinline__ unsigned cvtpk(float lo, float hi) { typedef __bf16 bf2 __attribute__((ext_vector_type(2))); f32x2 v = {lo, hi}; bf2 b = __builtin_convertvector(v, bf2); return __builtin_bit_cast(unsigned, b); }
__device__ __forceinline__ float bflo(unsigned u) { return __uint_as_float(u << 16); }
__device__ __forceinline__ float bfhi(unsigned u) { return __uint_as_float(u & 0xffff0000u); }
__device__ __forceinline__ float bf1(bf16_t u) { return __uint_as_float(((unsigned)u) << 16); }
__device__ __forceinline__ bf16_t f2bf(float f) { return (bf16_t)(cvtpk(f, 0.f) & 0xffffu); }
template <int M> __device__ __forceinline__ int swz_i(int v) { constexpr int ctrl = (M == 1) ? 0xB1 : (M == 2) ? 0x4E : (M == 4) ? 0x141 : 0x140; static_assert(M == 1 || M == 2 || M == 4 || M == 8, "dpp step");
    return __builtin_amdgcn_update_dpp(v, v, ctrl, 0xf, 0xf, true); }
template <int M> __device__ __forceinline__ float swz_f(float v) { return __int_as_float(swz_i<M>(__float_as_int(v))); }
__device__ __forceinline__ float xor16_sum(float v) { auto r = __builtin_amdgcn_permlane16_swap(__float_as_uint(v), __float_as_uint(v), false, false); return __uint_as_float(r[0]) + __uint_as_float(r[1]); }
__device__ __forceinline__ float xor32_sum(float v) { auto r = __builtin_amdgcn_permlane32_swap(__float_as_uint(v), __float_as_uint(v), false, false); return __uint_as_float(r[0]) + __uint_as_float(r[1]); }
__device__ __forceinline__ float xor32_max(float v) { auto r = __builtin_amdgcn_permlane32_swap(__float_as_uint(v), __float_as_uint(v), false, false); return fmaxf(__uint_as_float(r[0]), __uint_as_float(r[1])); }
__device__ __forceinline__ float wave_sum(float v) {
    v += swz_f<1>(v); v += swz_f<2>(v); v += swz_f<4>(v); v += swz_f<8>(v);
    return xor32_sum(xor16_sum(v));
}
#define LDS_WAIT() asm volatile("s_waitcnt lgkmcnt(0)" ::: "memory")

namespace pg8 {
typedef int i32x4_t __attribute__((ext_vector_type(4)));
typedef int i32x8_t __attribute__((ext_vector_type(8)));
constexpr int BM = 256, BK = 64, HALF = 128, HTB = HALF * BK * 2, STAGE_BYTES = 8 * HTB, NXCD = 8, WGM = 8;
__host__ __device__ __forceinline__ int lds_byte(int r, int c) { const int st = (r >> 4) * 2 + (c >> 5), rr = r & 15, cc = c & 31, ob = rr * 64 + cc * 2; return st * 1024 + (ob ^ (((ob >> 9) & 1) << 5)); }
__host__ __device__ __forceinline__ void stage_rc(int b, int& R, int& C) { const int st = b / 1024, sb = b % 1024, swz = sb ^ (((sb >> 9) & 1) << 5); R = (st >> 1) * 16 + swz / 64; C = (st & 1) * 32 + (swz % 64) / 2; }
__host__ __device__ __forceinline__ int perm32(int rho) { const int n = rho >> 4, i = rho & 15; return 8 * (i >> 2) + 4 * n + (i & 3); }

struct Unit { int pm, pn, e; };
struct Gemm { const bf16_t* A; const bf16_t* Bt; int K; size_t ebytes; const LAS int* gtok; };

struct StaticOrder {
    int nM, nN, nwg, G, c;
    __device__ void init(int M, int N, int G_, int c_) { nM = M / BM; nN = N / BM; nwg = nM * nN; G = G_; c = c_; }
    __device__ bool next(int i, Unit& u) const {
        const long L = (long)i * G + c; if (L >= nwg) return false;
        int wgid = (int)L; { const int q = nwg / NXCD, r = nwg % NXCD, xcd = wgid % NXCD, off = wgid / NXCD; wgid = (xcd < r ? xcd * (q + 1) : r * (q + 1) + (xcd - r) * q) + off; }
        const int nig = WGM * nN, gid = wgid / nig, fm = gid * WGM, gsz = (nM - fm) < WGM ? (nM - fm) : WGM;
        u.pm = fm + ((wgid % nig) % gsz); u.pn = (wgid % nig) / gsz; u.e = 0; return true;
    }
};
struct MoeOrder {
    const LAS int* tstart; int nN, GM, G, c;
    __device__ bool next(int i, Unit& u) const {
        const int total = tstart[32] * nN; const long L = (long)i * G + c; if (L >= total) return false;
        const int pmL = (int)L / nN; int e = 0;
#pragma unroll
        for (int k = 1; k < 32; ++k) e += (tstart[k] <= pmL) ? 1 : 0;
        const int t0 = tstart[e], mt = tstart[e + 1] - t0, w = (int)L - t0 * nN;
        const int grp = w / (GM * nN), wg = w - grp * GM * nN, rem = mt - grp * GM, gsz = rem < GM ? rem : GM;
        u.pm = __builtin_amdgcn_readfirstlane(t0 + grp * GM + wg % gsz); u.pn = __builtin_amdgcn_readfirstlane(wg / gsz); u.e = __builtin_amdgcn_readfirstlane(e); return true;
    }
};


__device__ __forceinline__ u32x4 pair16(u32x2 a, u32x2 b) {
    const auto rx = __builtin_amdgcn_permlane16_swap(a.x, b.x, false, false); const auto ry = __builtin_amdgcn_permlane16_swap(a.y, b.y, false, false);
    return (u32x4){rx[0], ry[0], rx[1], ry[1]};
}
struct EpiProj {
    static constexpr bool PERM = true, AFTER_DRAIN = false;
    bf16_t* O; const float* cs; const float* sn; bf16_t* QH;
    __device__ __forceinline__ void operator()(const f32x4 (&acc)[2][2][4][2], const Unit& u, int wr, int wc, int fr, int fq) const {
        const int row0 = u.pm * BM + wr * 64 + fr, colb = u.pn * BM + wc * 32 + 8 * fq;
        if (u.pn < 4) {
            const float sc = (u.pn < 2) ? QSCALE : 1.f;
#pragma unroll
            for (int ai = 0; ai < 2; ++ai) {
                f32x4 cv[4][2], sv[4][2];
#pragma unroll
                for (int m = 0; m < 4; ++m) { const int pos = (row0 + ai * HALF + m * 16) & (SEQ - 1);
#pragma unroll
                    for (int bj = 0; bj < 2; ++bj) { const int g8 = ((colb + bj * HALF) & 63) >> 3; cv[m][bj] = *(const f32x4*)(cs + pos * 32 + g8 * 4); sv[m][bj] = *(const f32x4*)(sn + pos * 32 + g8 * 4); } }
#pragma unroll
                for (int mp = 0; mp < 2; ++mp)
#pragma unroll
                    for (int bj = 0; bj < 2; ++bj) { const int col = colb + bj * HALF, head = col >> 6, g8 = (col & 63) >> 3;
                        u32x2 w1[2], w2[2];
#pragma unroll
                        for (int q = 0; q < 2; ++q) { const int m = 2 * mp + q; const f32x4 c = cv[m][bj], s = sv[m][bj];
                            const f32x4 t1 = acc[ai][bj][m][0], t2 = acc[ai][bj][m][1];
                            const f32x4 o1 = (t1 * c - t2 * s) * sc, o2 = (t1 * s + t2 * c) * sc;
                            w1[q].x = cvtpk(o1[0], o1[1]); w1[q].y = cvtpk(o1[2], o1[3]); w2[q].x = cvtpk(o2[0], o2[1]); w2[q].y = cvtpk(o2[2], o2[3]); }
                        const int msel = 2 * mp + (fq & 1), row = row0 + ai * HALF + msel * 16, pos = row & (SEQ - 1);
                        bf16_t* p = QH + ((size_t)((((head >> 3) * 2 + (row >> 13)) * 8 + (head & 7))) * SEQ + pos) * 64 + (g8 & ~1) * 4;
                        *(u32x4*)p = pair16(w1[0], w1[1]); *(u32x4*)(p + 32) = pair16(w2[0], w2[1]); }
                asm volatile("" ::: "memory");
            }
        } else if (u.pn < 6) {
#pragma unroll
            for (int ai = 0; ai < 2; ++ai)
#pragma unroll
                for (int m = 0; m < 4; ++m) { const int row = row0 + ai * HALF + m * 16;
#pragma unroll
                    for (int bj = 0; bj < 2; ++bj) { const int col = colb + bj * HALF - 1024, hh = col >> 6; const f32x4 v0 = acc[ai][bj][m][0], v1 = acc[ai][bj][m][1];
                        u32x4 w; w.x = cvtpk(v0[0], v0[1]); w.y = cvtpk(v0[2], v0[3]); w.z = cvtpk(v1[0], v1[1]); w.w = cvtpk(v1[2], v1[3]);
                        *(u32x4*)(QH + ((size_t)(((4 + (row >> 13)) * 8 + hh)) * SEQ + (row & (SEQ - 1))) * 64 + (col & 63)) = w; } }
        } else {
            const float sc = (u.pn == 7) ? QSCALE : 1.f;
#pragma unroll
            for (int ai = 0; ai < 2; ++ai)
#pragma unroll
                for (int m = 0; m < 4; ++m) { bf16_t* rowp = O + (size_t)(row0 + ai * HALF + m * 16) * NIN + colb;
#pragma unroll
                    for (int bj = 0; bj < 2; ++bj) { const f32x4 v0 = acc[ai][bj][m][0] * sc, v1 = acc[ai][bj][m][1] * sc;
                        u32x4 w; w.x = cvtpk(v0[0], v0[1]); w.y = cvtpk(v0[2], v0[3]); w.z = cvtpk(v1[0], v1[1]); w.w = cvtpk(v1[2], v1[3]);
                        *(u32x4*)(rowp + bj * HALF) = w; } }
        }
    }
};
struct EpiBf16 {
    static constexpr bool PERM = true, AFTER_DRAIN = false;
    bf16_t* O; int ldc; const float* bias; int bias_estride; float scale;
    __device__ __forceinline__ void operator()(const f32x4 (&acc)[2][2][4][2], const Unit& u, int wr, int wc, int fr, int fq) const {
        const int row0 = u.pm * BM + wr * 64 + fr, col0 = u.pn * BM + wc * 32 + 8 * fq;
        f32x4 bv[2][2];
#pragma unroll
        for (int bj = 0; bj < 2; ++bj)
#pragma unroll
            for (int n = 0; n < 2; ++n) bv[bj][n] = bias ? *(const f32x4*)(bias + (size_t)u.e * bias_estride + col0 + bj * HALF + 4 * n) : (f32x4){0.f, 0.f, 0.f, 0.f};
#pragma unroll
        for (int ai = 0; ai < 2; ++ai)
#pragma unroll
            for (int m = 0; m < 4; ++m) { bf16_t* rowp = O + (size_t)(row0 + ai * HALF + m * 16) * ldc + col0;
#pragma unroll
                for (int bj = 0; bj < 2; ++bj) { const f32x4 v0 = acc[ai][bj][m][0] * scale + bv[bj][0], v1 = acc[ai][bj][m][1] * scale + bv[bj][1];
                    u32x4 w; w.x = cvtpk(v0[0], v0[1]); w.y = cvtpk(v0[2], v0[3]); w.z = cvtpk(v1[0], v1[1]); w.w = cvtpk(v1[2], v1[3]);
                    *(u32x4*)(rowp + bj * HALF) = w; } }
    }
};
struct EpiF8 {
    static constexpr bool PERM = true, AFTER_DRAIN = false;
    unsigned char* O; int ldc; const float* bias; int bias_estride; float scale;
    __device__ __forceinline__ void operator()(const f32x4 (&acc)[2][2][4][2], const Unit& u, int wr, int wc, int fr, int fq) const {
        const int row0 = u.pm * BM + wr * 64 + fr, col0 = u.pn * BM + wc * 32 + 8 * fq;
        f32x4 bv[2][2];
#pragma unroll
        for (int bj = 0; bj < 2; ++bj)
#pragma unroll
            for (int n = 0; n < 2; ++n) bv[bj][n] = *(const f32x4*)(bias + (size_t)u.e * bias_estride + col0 + bj * HALF + 4 * n);
#pragma unroll
        for (int ai = 0; ai < 2; ++ai)
#pragma unroll
            for (int mp = 0; mp < 2; ++mp)
#pragma unroll
                for (int bj = 0; bj < 2; ++bj) { u32x2 w[2];
#pragma unroll
                    for (int q = 0; q < 2; ++q) { const int m = 2 * mp + q; const f32x4 v0 = acc[ai][bj][m][0] * scale + bv[bj][0], v1 = acc[ai][bj][m][1] * scale + bv[bj][1];
                        int w0 = 0, w1 = 0; w0 = __builtin_amdgcn_cvt_pk_fp8_f32(v0[0], v0[1], w0, false); w0 = __builtin_amdgcn_cvt_pk_fp8_f32(v0[2], v0[3], w0, true);
                        w1 = __builtin_amdgcn_cvt_pk_fp8_f32(v1[0], v1[1], w1, false); w1 = __builtin_amdgcn_cvt_pk_fp8_f32(v1[2], v1[3], w1, true);
                        w[q].x = (unsigned)w0; w[q].y = (unsigned)w1; }
                    const int msel = 2 * mp + (fq & 1);
                    *(u32x4*)(O + (size_t)(row0 + ai * HALF + msel * 16) * ldc + u.pn * BM + wc * 32 + 8 * (fq & ~1) + bj * HALF) = pair16(w[0], w[1]); }
    }
};
struct EpiSwiglu {
    static constexpr bool PERM = true, AFTER_DRAIN = false;
    unsigned char* O; const float* bias; float scale;
    __device__ __forceinline__ static float act1(float g, float up) {
        g = fminf(g, 7.0f); up = fminf(fmaxf(up, -7.0f), 7.0f);
        const float sg = __builtin_amdgcn_rcpf(1.0f + __builtin_amdgcn_exp2f(g * (-1.702f * 1.4426950408889634f)));
        return (up + 1.0f) * g * sg;
    }
    __device__ __forceinline__ static f32x2 act2(f32x2 g, f32x2 up) {
        g.x = fminf(g.x, 7.0f); g.y = fminf(g.y, 7.0f); up.x = fminf(fmaxf(up.x, -7.0f), 7.0f); up.y = fminf(fmaxf(up.y, -7.0f), 7.0f);
        const f32x2 z = g * (-1.702f * 1.4426950408889634f); f32x2 e; e.x = __builtin_amdgcn_exp2f(z.x); e.y = __builtin_amdgcn_exp2f(z.y);
        const f32x2 d = e + 1.0f; f32x2 r; r.x = __builtin_amdgcn_rcpf(d.x); r.y = __builtin_amdgcn_rcpf(d.y);
        return (up + 1.0f) * g * r;
    }
    __device__ __forceinline__ void operator()(const f32x4 (&acc)[2][2][4][2], const Unit& u, int wr, int wc, int fr, int fq) const {
        const int row0 = u.pm * BM + wr * 64 + fr, j0 = u.pn * HALF + wc * 32 + 8 * fq;
        const float* bg = bias + (size_t)u.e * 2048 + j0; const float* bu = bg + 1024;
        const f32x4 bg0 = *(const f32x4*)bg, bg1 = *(const f32x4*)(bg + 4), bu0 = *(const f32x4*)bu, bu1 = *(const f32x4*)(bu + 4);
#pragma unroll
        for (int ai = 0; ai < 2; ++ai)
#pragma unroll
            for (int mp = 0; mp < 2; ++mp) { u32x2 w[2];
#pragma unroll
                for (int q = 0; q < 2; ++q) { const int m = 2 * mp + q;
                    const f32x4 g0 = acc[ai][0][m][0] * scale + bg0, g1 = acc[ai][0][m][1] * scale + bg1, u0 = acc[ai][1][m][0] * scale + bu0, u1 = acc[ai][1][m][1] * scale + bu1;
                    int w0 = 0, w1 = 0;
                    const f32x2 a0 = act2((f32x2){g0[0], g0[1]}, (f32x2){u0[0], u0[1]}), a1 = act2((f32x2){g0[2], g0[3]}, (f32x2){u0[2], u0[3]}), a2 = act2((f32x2){g1[0], g1[1]}, (f32x2){u1[0], u1[1]}), a3 = act2((f32x2){g1[2], g1[3]}, (f32x2){u1[2], u1[3]});
                    w0 = __builtin_amdgcn_cvt_pk_fp8_f32(a0.x, a0.y, w0, false); w0 = __builtin_amdgcn_cvt_pk_fp8_f32(a1.x, a1.y, w0, true);
                    w1 = __builtin_amdgcn_cvt_pk_fp8_f32(a2.x, a2.y, w1, false); w1 = __builtin_amdgcn_cvt_pk_fp8_f32(a3.x, a3.y, w1, true);
                    w[q].x = (unsigned)w0; w[q].y = (unsigned)w1; }
                const int msel = 2 * mp + (fq & 1);
                *(u32x4*)(O + (size_t)(row0 + ai * HALF + msel * 16) * DM + u.pn * HALF + wc * 32 + 8 * (fq & ~1)) = pair16(w[0], w[1]); }
    }
};
template <bool BASE_BF16>
struct EpiRes {
    static constexpr bool PERM = true, AFTER_DRAIN = false;
    const void* base; bf16_t* out;
    __device__ __forceinline__ void operator()(const f32x4 (&acc)[2][2][4][2], const Unit& u, int wr, int wc, int fr, int fq) const {
        const int row0 = u.pm * BM + wr * 64 + fr, col0 = u.pn * BM + wc * 32 + 8 * fq;
#pragma unroll
        for (int ai = 0; ai < 2; ++ai) {
            f32x4 bs[4][2][2];
#pragma unroll
            for (int m = 0; m < 4; ++m) { const size_t off = (size_t)(row0 + ai * HALF + m * 16) * DM + col0;
#pragma unroll
                for (int bj = 0; bj < 2; ++bj) {
                    if constexpr (BASE_BF16) { const u32x4 r = __builtin_nontemporal_load((const u32x4*)((const bf16_t*)base + off + bj * HALF));
                        bs[m][bj][0] = (f32x4){bflo(r.x), bfhi(r.x), bflo(r.y), bfhi(r.y)}; bs[m][bj][1] = (f32x4){bflo(r.z), bfhi(r.z), bflo(r.w), bfhi(r.w)}; }
                    else { bs[m][bj][0] = __builtin_nontemporal_load((const f32x4*)((const float*)base + off + bj * HALF)); bs[m][bj][1] = __builtin_nontemporal_load((const f32x4*)((const float*)base + off + bj * HALF + 4)); } } }
#pragma unroll
            for (int m = 0; m < 4; ++m) { const size_t off = (size_t)(row0 + ai * HALF + m * 16) * DM + col0;
#pragma unroll
                for (int bj = 0; bj < 2; ++bj) { const f32x4 v0 = bs[m][bj][0] + acc[ai][bj][m][0], v1 = bs[m][bj][1] + acc[ai][bj][m][1];
                    u32x4 w; w.x = cvtpk(v0[0], v0[1]); w.y = cvtpk(v0[2], v0[3]); w.z = cvtpk(v1[0], v1[1]); w.w = cvtpk(v1[2], v1[3]);
                    *(u32x4*)(out + off + bj * HALF) = w; } }
            asm volatile("" ::: "memory");
        }
    }
};

template <class Epi, class Sched, bool ALIGN_EPI = false, bool SP2 = true, bool FP8 = false, bool GATHER = false>
__device__ __forceinline__ void gemm_phase(LAS unsigned char* lds, const int tid, const Gemm g, const Sched& S, const Epi& E) {
    const int wid = __builtin_amdgcn_readfirstlane(tid >> 6), lane = tid & 63, wr = wid >> 2, wc = wid & 3, fr = lane & 15, fq = lane >> 4;
    const int K = g.K, rowb = FP8 ? K : 2 * K, nt = rowb / 128;
    unsigned voffA[2], voffB[2];
#pragma unroll
    for (int i = 0; i < 2; ++i) { int R, C; stage_rc(tid * 16 + i * 8192, R, C); const int Rb = Epi::PERM ? ((R & ~31) + perm32(R & 31)) : R;
        voffA[i] = (unsigned)(R * rowb + C * 2); voffB[i] = (unsigned)(Rb * rowb + C * 2); }
    const size_t kstep = (size_t)(BK * 2);
    const size_t hstep = (size_t)HALF * rowb;
    const size_t tstep = 2 * hstep;
    const unsigned ldsw = (unsigned)wid * 1024u;
    const int aoff = lds_byte(wr * 64 + fr, fq * 8), boff = lds_byte(wc * 32 + fr, fq * 8);
#define PG8_SA(b, h) (((b) * 2 + (h)) * HTB)
#define PG8_SB(b, h) ((4 + (b) * 2 + (h)) * HTB)
#define PG8_STAGE(bufoff, gbase, voff) do { _Pragma("unroll") for (int _i = 0; _i < 2; ++_i) \
        __builtin_amdgcn_global_load_lds((const unsigned*)((const char*)(gbase) + (voff)[_i]), (LAS unsigned*)(lds + (bufoff) + ldsw + _i * 8192), 16, 0, 0); } while (0)
#define PG8_STAGE_A(bufoff, gbase, h, nx) do { if constexpr (GATHER) { unsigned vo_[2]; vo_[0] = (nx) ? gAn[h][0] : gAc[h][0]; vo_[1] = (nx) ? gAn[h][1] : gAc[h][1]; PG8_STAGE(bufoff, gbase, vo_); } \
        else PG8_STAGE(bufoff, (gbase) + (h) * hstep, voffA); } while (0)
#define PG8_LDA(dst, b, h) do { if constexpr (FP8) { _Pragma("unroll") for (int m = 0; m < 4; ++m) { const i32x4_t lo_ = *(const LAS i32x4_t*)(lds + PG8_SA(b, h) + aoff + m * 2048), hi_ = *(const LAS i32x4_t*)(lds + PG8_SA(b, h) + aoff + m * 2048 + 1024); \
            dst##8[m] = __builtin_shufflevector(lo_, hi_, 0, 1, 2, 3, 4, 5, 6, 7); } } \
        else { _Pragma("unroll") for (int m = 0; m < 4; ++m) _Pragma("unroll") for (int k = 0; k < 2; ++k) dst[m][k] = *(const LAS bf16x8*)(lds + PG8_SA(b, h) + aoff + m * 2048 + k * 1024); } } while (0)
#define PG8_LDB(dst, b, h) do { if constexpr (FP8) { _Pragma("unroll") for (int n = 0; n < 2; ++n) { const i32x4_t lo_ = *(const LAS i32x4_t*)(lds + PG8_SB(b, h) + boff + n * 2048), hi_ = *(const LAS i32x4_t*)(lds + PG8_SB(b, h) + boff + n * 2048 + 1024); \
            dst##8[n] = __builtin_shufflevector(lo_, hi_, 0, 1, 2, 3, 4, 5, 6, 7); } } \
        else { _Pragma("unroll") for (int n = 0; n < 2; ++n) _Pragma("unroll") for (int k = 0; k < 2; ++k) dst[n][k] = *(const LAS bf16x8*)(lds + PG8_SB(b, h) + boff + n * 2048 + k * 1024); } } while (0)
#define PG8_MMA(ai, bj, At, Bt) do { __builtin_amdgcn_s_setprio(1); \
        if constexpr (FP8) { _Pragma("unroll") for (int m = 0; m < 4; ++m) _Pragma("unroll") for (int n = 0; n < 2; ++n) \
            asm volatile("v_mfma_scale_f32_16x16x128_f8f6f4 %0, %1, %2, %0, %3, %3 op_sel_hi:[0,0,0]" : "+v"(acc[ai][bj][m][n]) : "v"(Bt##8[n]), "v"(At##8[m]), "v"(0x7f7f7f7f)); } \
        else { _Pragma("unroll") for (int m = 0; m < 4; ++m) _Pragma("unroll") for (int n = 0; n < 2; ++n) _Pragma("unroll") for (int k = 0; k < 2; ++k) \
            acc[ai][bj][m][n] = __builtin_amdgcn_mfma_f32_16x16x32_bf16(Bt[n][k], At[m][k], acc[ai][bj][m][n], 0, 0, 0); } \
        __builtin_amdgcn_s_setprio(0); } while (0)
#define PG8_WAIT_V(n) asm volatile("s_waitcnt vmcnt(" #n ")" ::: "memory")
#define PG8_WAIT_L(n) asm volatile("s_waitcnt lgkmcnt(" #n ")" ::: "memory")
#define PG8_BAR __builtin_amdgcn_s_barrier()
#define PG8_SCHED __builtin_amdgcn_sched_barrier(0)
#define PG8_UA(u) (GATHER ? (const char*)g.A : (const char*)g.A + (size_t)(u).pm * tstep)
    unsigned gAc[2][2], gAn[2][2];
#define PG8_GLOAD(dst, ui_) do { if constexpr (GATHER) { _Pragma("unroll") for (int h = 0; h < 2; ++h) _Pragma("unroll") for (int i = 0; i < 2; ++i) { int R, C; stage_rc(tid * 16 + i * 8192, R, C); \
            dst[h][i] = (unsigned)(g.gtok[(ui_) * 256 + h * HALF + R] * rowb + C * 2); } } } while (0)
#define PG8_UB(u) ((const char*)g.Bt + (size_t)(u).e * g.ebytes + (size_t)(u).pn * tstep)
    Unit cur, nxt; int ui = 0;
    if (!S.next(0, cur)) return;
    f32x4 acc[2][2][4][2];
#pragma unroll
    for (int a = 0; a < 2; ++a)
#pragma unroll
        for (int b = 0; b < 2; ++b)
#pragma unroll
            for (int m = 0; m < 4; ++m)
#pragma unroll
                for (int n = 0; n < 2; ++n) acc[a][b][m][n] = (f32x4){0.f, 0.f, 0.f, 0.f};
    bf16x8 At[4][2], B0[2][2], B1[2][2]; i32x8_t At8[4], B08[2], B18[2];
    const char* cA = PG8_UA(cur); const char* cB = PG8_UB(cur);
    PG8_GLOAD(gAc, 0);
    if constexpr (SP2) {
        PG8_STAGE(PG8_SB(0, 0), cB, voffB); PG8_STAGE(PG8_SB(0, 1), cB + hstep, voffB); PG8_STAGE_A(PG8_SA(0, 0), cA, 0, false); PG8_STAGE_A(PG8_SA(0, 1), cA, 1, false);
        if (wr == 1) PG8_BAR;
        PG8_WAIT_V(2); PG8_BAR;
        PG8_STAGE(PG8_SB(1, 0), cB + kstep, voffB); PG8_STAGE_A(PG8_SA(1, 0), cA + kstep, 0, false); PG8_STAGE(PG8_SB(1, 1), cB + hstep + kstep, voffB);
        PG8_WAIT_V(6); PG8_BAR;
    } else {
        PG8_STAGE(PG8_SB(0, 0), cB, voffB); PG8_STAGE_A(PG8_SA(0, 0), cA, 0, false); PG8_STAGE(PG8_SB(0, 1), cB + hstep, voffB); PG8_STAGE_A(PG8_SA(0, 1), cA, 1, false);
        if (wr == 1) PG8_BAR;
        PG8_WAIT_V(4); PG8_BAR;
        PG8_STAGE(PG8_SB(1, 0), cB + kstep, voffB); PG8_STAGE_A(PG8_SA(1, 0), cA + kstep, 0, false); PG8_STAGE(PG8_SB(1, 1), cB + hstep + kstep, voffB);
        PG8_WAIT_V(6); PG8_BAR;
    }
    for (;;) {
        const bool has_next = S.next(ui + 1, nxt);
        if constexpr (GATHER) { if (has_next) PG8_GLOAD(gAn, ui + 1); else { gAn[0][0] = gAc[0][0]; gAn[0][1] = gAc[0][1]; gAn[1][0] = gAc[1][0]; gAn[1][1] = gAc[1][1]; } }
        const char* nA = has_next ? PG8_UA(nxt) : cA; const char* nB = has_next ? PG8_UB(nxt) : cB;
#pragma unroll 1
        for (int t = 0; t < nt; t += 2) {
            const bool last = (t == nt - 2);
            const char* a1 = cA + (size_t)(t + 1) * kstep;
            const char* a2 = last ? nA : cA + (size_t)(t + 2) * kstep; const char* b2 = last ? nB : cB + (size_t)(t + 2) * kstep;
            const char* a3 = a2 + kstep; const char* b3 = b2 + kstep;
            if constexpr (SP2) {
            PG8_LDB(B0, 0, 0); PG8_LDB(B1, 0, 1); PG8_SCHED; PG8_LDA(At, 0, 0); PG8_STAGE_A(PG8_SA(1, 1), a1, 1, false);
            PG8_WAIT_V(8); PG8_WAIT_L(0); PG8_BAR; PG8_MMA(0, 0, At, B0); PG8_MMA(0, 1, At, B1); PG8_BAR; PG8_SCHED;
            PG8_LDA(At, 0, 1); PG8_STAGE(PG8_SB(0, 0), b2, voffB); PG8_STAGE(PG8_SB(0, 1), b2 + hstep, voffB); PG8_STAGE_A(PG8_SA(0, 0), a2, 0, last);
            PG8_WAIT_V(8); PG8_WAIT_L(0); PG8_BAR; PG8_MMA(1, 0, At, B0); PG8_MMA(1, 1, At, B1); PG8_BAR; PG8_SCHED;
            PG8_LDB(B0, 1, 0); PG8_LDB(B1, 1, 1); PG8_SCHED; PG8_LDA(At, 1, 0); PG8_STAGE_A(PG8_SA(0, 1), a2, 1, last);
            PG8_WAIT_V(8); PG8_WAIT_L(0); PG8_BAR; PG8_MMA(0, 0, At, B0); PG8_MMA(0, 1, At, B1); PG8_BAR; PG8_SCHED;
            PG8_LDA(At, 1, 1); PG8_STAGE(PG8_SB(1, 0), b3, voffB); PG8_STAGE(PG8_SB(1, 1), b3 + hstep, voffB); PG8_STAGE_A(PG8_SA(1, 0), a3, 0, last);
            PG8_WAIT_V(8); PG8_WAIT_L(0); PG8_BAR; PG8_MMA(1, 0, At, B0); PG8_MMA(1, 1, At, B1); PG8_BAR; PG8_SCHED;
            } else {
            PG8_LDB(B0, 0, 0); PG8_SCHED; PG8_LDA(At, 0, 0); PG8_STAGE_A(PG8_SA(1, 1), a1, 1, false);
            PG8_WAIT_L(8); PG8_BAR; PG8_WAIT_L(0); PG8_MMA(0, 0, At, B0); PG8_BAR; PG8_SCHED;
            PG8_LDB(B1, 0, 1); PG8_STAGE(PG8_SB(0, 0), b2, voffB);
            PG8_BAR; PG8_WAIT_L(0); PG8_MMA(0, 1, At, B1); PG8_BAR;
            PG8_LDA(At, 0, 1); PG8_STAGE_A(PG8_SA(0, 0), a2, 0, last);
            PG8_BAR; PG8_WAIT_L(0); PG8_MMA(1, 0, At, B0); PG8_BAR; PG8_SCHED;
            PG8_STAGE(PG8_SB(0, 1), b2 + hstep, voffB);
            PG8_WAIT_V(6); PG8_BAR; PG8_MMA(1, 1, At, B1); PG8_BAR;
            PG8_LDB(B0, 1, 0); PG8_SCHED; PG8_LDA(At, 1, 0); PG8_STAGE_A(PG8_SA(0, 1), a2, 1, last);
            PG8_WAIT_L(8); PG8_BAR; PG8_WAIT_L(0); PG8_MMA(0, 0, At, B0); PG8_BAR; PG8_SCHED;
            PG8_LDB(B1, 1, 1); PG8_STAGE(PG8_SB(1, 0), b3, voffB);
            PG8_BAR; PG8_WAIT_L(0); PG8_MMA(0, 1, At, B1); PG8_BAR;
            PG8_LDA(At, 1, 1); PG8_STAGE_A(PG8_SA(1, 0), a3, 0, last);
            PG8_BAR; PG8_WAIT_L(0); PG8_MMA(1, 0, At, B0); PG8_BAR; PG8_SCHED;
            PG8_STAGE(PG8_SB(1, 1), b3 + hstep, voffB);
            PG8_WAIT_V(6); PG8_BAR; PG8_MMA(1, 1, At, B1); PG8_BAR;
            }
        }
        if constexpr (ALIGN_EPI) { if (wr == 0) PG8_BAR; }
        if constexpr (FP8) asm volatile("s_nop 15\n\ts_nop 15" ::: "memory");
        E(acc, cur, wr, wc, fr, fq);
        if (!has_next) break;
#pragma unroll
        for (int a = 0; a < 2; ++a)
#pragma unroll
            for (int b = 0; b < 2; ++b)
#pragma unroll
                for (int m = 0; m < 4; ++m)
#pragma unroll
                    for (int n = 0; n < 2; ++n) acc[a][b][m][n] = (f32x4){0.f, 0.f, 0.f, 0.f};
        cur = nxt; cA = nA; cB = nB; ++ui;
        if constexpr (GATHER) { gAc[0][0] = gAn[0][0]; gAc[0][1] = gAn[0][1]; gAc[1][0] = gAn[1][0]; gAc[1][1] = gAn[1][1]; }
        if constexpr (ALIGN_EPI) { if (wr == 1) PG8_BAR; }
    }
    PG8_WAIT_V(0);
    if constexpr (!ALIGN_EPI) { if (wr == 0) PG8_BAR; }
    PG8_BAR;
#undef PG8_SA
#undef PG8_SB
#undef PG8_STAGE
#undef PG8_STAGE_A
#undef PG8_GLOAD
#undef PG8_LDA
#undef PG8_LDB
#undef PG8_MMA
#undef PG8_WAIT_V
#undef PG8_WAIT_L
#undef PG8_BAR
#undef PG8_SCHED
#undef PG8_UA
#undef PG8_UB
}
}


#define XB_TMO      128
#define XB_XCNT(j)  (256  + 64 * (j))
#define XB_XSUB(j)  (1280 + 64 * (j))
#define XB_XGEN(j)  (2304 + 64 * (j))
#define XB_TOP      3328
#define XB_TOPGEN   3392
#define XCD_BAR_WORDS 3456
#define XB_SPIN_CAP (1u << 18)
__device__ __forceinline__ unsigned xb_ld(unsigned* p)              { return __hip_atomic_load(p, __ATOMIC_RELAXED, __HIP_MEMORY_SCOPE_AGENT); }
__device__ __forceinline__ unsigned xb_add(unsigned* p, unsigned v) { return __hip_atomic_fetch_add(p, v, __ATOMIC_RELAXED, __HIP_MEMORY_SCOPE_AGENT); }
__device__ __forceinline__ unsigned xb_xcc_id() { return (unsigned)__builtin_amdgcn_s_getreg((3 << 11) | 20) & 0xFu; }
#define XB_SPIN(cond, bar) do { unsigned _sp = 0; while (cond) { __builtin_amdgcn_s_sleep(1); \
    if ((++_sp & 255u) == 0u) { if (xb_ld(&(bar)[XB_TMO])) break; if (_sp > XB_SPIN_CAP) { atomicAdd(&(bar)[XB_TMO], 1u); break; } } } } while (0)
struct XcdBarrier { unsigned* bar; unsigned x; volatile LAS unsigned* st; };
__device__ __forceinline__ XcdBarrier xcd_barrier_post(unsigned* bar, volatile LAS unsigned* st, int tid) {
    XcdBarrier b; b.bar = bar; b.x = xb_xcc_id(); b.st = st;
    if (tid == 0) (void)xb_add(&bar[XB_XCNT(b.x)], 1u);
    return b;
}
__device__ __forceinline__ void xcd_barrier_complete(unsigned* bar, unsigned x, unsigned& nloc, unsigned& nx) {
    const unsigned G = gridDim.x * gridDim.y * gridDim.z;
    unsigned sum, cnt, mine, sp = 0u;
    for (;;) {
        sum = 0u; cnt = 0u; mine = 0u;
#pragma unroll
        for (unsigned j = 0; j < 16; ++j) { const unsigned c = xb_ld(&bar[XB_XCNT(j)]); sum += c; cnt += (c > 0u) ? 1u : 0u; mine = (j == x) ? c : mine; }
        if (sum == G) break;
        __builtin_amdgcn_s_sleep(1);
        if ((++sp & 255u) == 0u) { if (xb_ld(&bar[XB_TMO])) break; if (sp > XB_SPIN_CAP) { atomicAdd(&bar[XB_TMO], 1u); break; } }
    }
    nloc = mine > 0u ? mine : 1u; nx = cnt > 0u ? cnt : 1u;
}
__device__ __forceinline__ void xcd_barrier(const XcdBarrier& b, int tid) {
    asm volatile("s_waitcnt vmcnt(0)" ::: "memory");
    __syncthreads();
    if (tid == 0) {
        unsigned* bar = b.bar;
        __builtin_amdgcn_s_waitcnt(0);
        unsigned nloc = b.st[0], nx = b.st[1];
        if (nloc == 0u) { xcd_barrier_complete(bar, b.x, nloc, nx); b.st[0] = nloc; b.st[1] = nx; }
        const unsigned old = xb_add(&bar[XB_XSUB(b.x)], 1u);
        const unsigned gen = old / nloc;
        if (old + 1u == (gen + 1u) * nloc) {
            __builtin_amdgcn_fence(__ATOMIC_RELEASE, "agent");
            asm volatile("s_waitcnt vmcnt(0)" ::: "memory");
            const unsigned og = xb_add(&bar[XB_TOP], 1u);
            const unsigned tg = og / nx;
            if (og + 1u == (tg + 1u) * nx) xb_add(&bar[XB_TOPGEN], 1u);
            else XB_SPIN(xb_ld(&bar[XB_TOPGEN]) == tg, bar);
            __builtin_amdgcn_fence(__ATOMIC_ACQUIRE, "agent");
            xb_add(&bar[XB_XGEN(b.x)], 1u);
            asm volatile("s_waitcnt vmcnt(0)" ::: "memory");
        } else {
            XB_SPIN(xb_ld(&bar[XB_XGEN(b.x)]) == gen, bar);
            __builtin_amdgcn_fence(__ATOMIC_ACQUIRE, "agent");
            asm volatile("s_waitcnt vmcnt(0)" ::: "memory");
        }
    }
    __syncthreads();
}

struct Args { const float* in[18]; float* out; unsigned char* ws; int ph_lo, ph_hi; };
enum { IN_X = 0, IN_MEM, IN_N1G, IN_WIN, IN_POOLW, IN_POOLS, IN_MEMNG, IN_WMKV, IN_GRPG, IN_WOUT, IN_N2G, IN_RW, IN_RB, IN_WGU, IN_BGU, IN_WDN, IN_BDN, IN_FING };

#define GAS __attribute__((address_space(1)))
#define CAS __attribute__((address_space(4)))
struct Frame {
    LAS unsigned char* lds; int tid, lane, wave, G, bid;
    const CAS unsigned char* kp;
    __device__ __forceinline__ const float* in(int i) const { return (const float*)*(GAS const float* const CAS*)(kp + 8 * i); }
    __device__ __forceinline__ float* out() const { return (float*)*(GAS float* const CAS*)(kp + 144); }
    __device__ __forceinline__ unsigned char* ws() const { return (unsigned char*)*(GAS unsigned char* const CAS*)(kp + 152); }
};

template <int MODE> __device__ __forceinline__ int perm_col(int c) {
    if (MODE == 1) { if (c >= 1024) return c; const int head = c >> 6, d = c & 63, g8 = (d & 31) >> 2, i = (d & 3) + ((d >> 5) << 2); return (head << 6) + (g8 << 3) + i; }
    if (MODE == 2) { const int up = c >> 10, cc = c & 1023; return ((cc >> 7) << 8) + (up << 7) + (cc & 127); }
    return c;
}
struct TItem { const float* W; bf16_t* WT; int N, mode, k0, n0; };
__device__ __forceinline__ int perm_col_rt(int mode, int c) { return mode == 1 ? perm_col<1>(c) : (mode == 2 ? perm_col<2>(c) : c); }
__device__ __forceinline__ void titem_load(const TItem& I, float (&tmp)[32], int lane) {
#pragma unroll
    for (int i = 0; i < 32; ++i) { const int kk = 2 * i + (lane >> 5); tmp[i] = I.W[(size_t)(I.k0 + kk) * I.N + I.n0 + (lane & 31)]; }
}
__device__ __forceinline__ void titem_store(const TItem& I, const float (&tmp)[32], LAS float* scr, int lane) {
#pragma unroll
    for (int i = 0; i < 32; ++i) { const int kk = 2 * i + (lane >> 5); scr[kk * 33 + (lane & 31)] = tmp[i]; }
    LDS_WAIT();
    if (I.mode >= 2) {
        const int c = lane & 3; unsigned char* W8 = (unsigned char*)I.WT;
#pragma unroll
        for (int j = 0; j < 2; ++j) { const int n = (lane >> 2) + 16 * j; const LAS float* s = scr + (16 * c) * 33 + n; u32x4 o;
#pragma unroll
            for (int q = 0; q < 4; ++q) { int w = 0; w = __builtin_amdgcn_cvt_pk_fp8_f32(s[(4 * q) * 33] * W8SCALE, s[(4 * q + 1) * 33] * W8SCALE, w, false);
                w = __builtin_amdgcn_cvt_pk_fp8_f32(s[(4 * q + 2) * 33] * W8SCALE, s[(4 * q + 3) * 33] * W8SCALE, w, true); o[q] = (unsigned)w; }
            const int row = (I.mode == 2) ? perm_col<2>(I.n0 + n) : (I.n0 + n);
            *(u32x4*)(W8 + (size_t)row * DM + I.k0 + 16 * c) = o; }
    } else {
        const int c = lane & 7;
#pragma unroll
        for (int j = 0; j < 4; ++j) { const int n = (lane >> 3) + 8 * j; const LAS float* s = scr + (8 * c) * 33 + n;
            u32x4 o; o.x = cvtpk(s[0 * 33], s[1 * 33]); o.y = cvtpk(s[2 * 33], s[3 * 33]); o.z = cvtpk(s[4 * 33], s[5 * 33]); o.w = cvtpk(s[6 * 33], s[7 * 33]);
            *(u32x4*)(I.WT + (size_t)perm_col_rt(I.mode, I.n0 + n) * DM + I.k0 + 8 * c) = o; }
    }
    LDS_WAIT();
}
struct W8Step { const float* W; unsigned char* W8; int N, gu, k0, n0; };
__device__ __forceinline__ void w8_load(const W8Step& I, f32x4 (&r)[16], int wave, int lane) {
#pragma unroll
    for (int h = 0; h < 2; ++h)
#pragma unroll
        for (int i = 0; i < 8; ++i) r[8 * h + i] = __builtin_nontemporal_load((const f32x4*)(I.W + (size_t)(I.k0 + 8 * (wave + 8 * h) + i) * I.N + I.n0 + 4 * lane));
}
__device__ __forceinline__ void w8_store(const W8Step& I, const f32x4 (&r)[16], LAS unsigned char* T, int tid, int wave, int lane) {
#pragma unroll
    for (int h = 0; h < 2; ++h) { const int a = wave + 8 * h;
#pragma unroll
        for (int j = 0; j < 4; ++j) { int w0 = 0, w1 = 0;
            w0 = __builtin_amdgcn_cvt_pk_fp8_f32(r[8 * h + 0][j] * W8SCALE, r[8 * h + 1][j] * W8SCALE, w0, false); w0 = __builtin_amdgcn_cvt_pk_fp8_f32(r[8 * h + 2][j] * W8SCALE, r[8 * h + 3][j] * W8SCALE, w0, true);
            w1 = __builtin_amdgcn_cvt_pk_fp8_f32(r[8 * h + 4][j] * W8SCALE, r[8 * h + 5][j] * W8SCALE, w1, false); w1 = __builtin_amdgcn_cvt_pk_fp8_f32(r[8 * h + 6][j] * W8SCALE, r[8 * h + 7][j] * W8SCALE, w1, true);
            u32x2 w; w.x = (unsigned)w0; w.y = (unsigned)w1;
            *(LAS u32x2*)(T + (4 * lane + j) * 128 + ((a ^ (lane & 15)) << 3)) = w; } }
    __syncthreads();
#pragma unroll
    for (int i = 0; i < 4; ++i) { const int p = tid + 512 * i, row = p >> 3, c16 = p & 7, f = (row >> 2) & 15;
        u32x4 v = *(const LAS u32x4*)(T + row * 128 + ((c16 ^ (f >> 1)) << 4));
        if (f & 1) v = (u32x4){v.z, v.w, v.x, v.y};
        const int orow = I.gu ? perm_col<2>(I.n0 + row) : (I.n0 + row);
        *(u32x4*)(I.W8 + (size_t)orow * DM + I.k0 + 16 * c16) = v; }
}
constexpr int W8_GU_STEPS = 32 * 64, W8_PER_LAYER = W8_GU_STEPS + 32 * 32;
__device__ __forceinline__ void w8_decode(Frame& F, W8Step& I, int layer, int j) {
    if (j < W8_GU_STEPS) { const int le = layer * NE + (j >> 6), r_ = j & 63; I.W = F.in(IN_WGU) + (size_t)le * DM * 2048; I.W8 = F.ws() + WS_WGU + (size_t)le * 2048 * DM; I.N = 2048; I.gu = 1; I.k0 = 128 * (r_ >> 3); I.n0 = 256 * (r_ & 7); }
    else { const int q_ = j - W8_GU_STEPS, le = layer * NE + (q_ >> 5), r_ = q_ & 31; I.W = F.in(IN_WDN) + (size_t)le * DM * DM; I.W8 = F.ws() + WS_WDN + (size_t)le * DM * DM; I.N = DM; I.gu = 0; I.k0 = 128 * (r_ >> 2); I.n0 = 256 * (r_ & 3); }
}
constexpr int W8_Q_DN0 = 32 * 32, W8_Q_TOTAL = W8_Q_DN0 + W8_PER_LAYER;
__device__ __forceinline__ void w8_decode_q(Frame& F, W8Step& I, int q) { if (q < W8_Q_DN0) w8_decode(F, I, 0, W8_GU_STEPS + q); else w8_decode(F, I, 1, q - W8_Q_DN0); }
__device__ __forceinline__ int w8_grab(Frame& F, unsigned* next, unsigned* done, int limit) {
    volatile LAS int* bc = (volatile LAS int*)(F.lds + MISC_OFF + 128);
    __syncthreads();
    if (F.tid == 0) { int go = 1; if (done != nullptr && __hip_atomic_load(done, __ATOMIC_RELAXED, __HIP_MEMORY_SCOPE_AGENT) >= (unsigned)F.G) go = 0;
        if (go && limit < W8_Q_TOTAL && __hip_atomic_load(next, __ATOMIC_RELAXED, __HIP_MEMORY_SCOPE_AGENT) >= (unsigned)limit) go = 0;
        int j = W8_Q_TOTAL; if (go) j = (int)__hip_atomic_fetch_add(next, 1u, __ATOMIC_RELAXED, __HIP_MEMORY_SCOPE_AGENT); bc[0] = j; }
    __syncthreads();
    return bc[0];
}
__device__ __forceinline__ void w8_help(Frame& F, unsigned* next, unsigned* done, int limit = W8_Q_TOTAL) {
    f32x4 ra[16], rb[16]; W8Step A, B; LAS unsigned char* T0 = F.lds; LAS unsigned char* T1 = F.lds + 32768;
    int j = w8_grab(F, next, done, limit);
    if (j < W8_Q_TOTAL) { w8_decode_q(F, A, j); w8_load(A, ra, F.wave, F.lane); }
    while (j < W8_Q_TOTAL) {
        int jn = w8_grab(F, next, done, limit); if (jn < W8_Q_TOTAL) { w8_decode_q(F, B, jn); w8_load(B, rb, F.wave, F.lane); }
        w8_store(A, ra, T0, F.tid, F.wave, F.lane); j = jn; if (j >= W8_Q_TOTAL) break;
        jn = w8_grab(F, next, done, limit); if (jn < W8_Q_TOTAL) { w8_decode_q(F, A, jn); w8_load(A, ra, F.wave, F.lane); }
        w8_store(B, rb, T1, F.tid, F.wave, F.lane); j = jn;
    }
    __syncthreads();
}
__device__ __forceinline__ void w8_static(Frame& F, int layer, int first, int end, int stride) {
    f32x4 ra[16], rb[16]; W8Step A, B; int st = first; LAS unsigned char* T0 = F.lds; LAS unsigned char* T1 = F.lds + 32768;
    __syncthreads();
    if (st < end) { w8_decode(F, A, layer, st); w8_load(A, ra, F.wave, F.lane); }
    while (st < end) {
        int nx = st + stride; if (nx < end) { w8_decode(F, B, layer, nx); w8_load(B, rb, F.wave, F.lane); }
        w8_store(A, ra, T0, F.tid, F.wave, F.lane); st = nx; if (st >= end) break;
        nx = st + stride; if (nx < end) { w8_decode(F, A, layer, nx); w8_load(A, ra, F.wave, F.lane); }
        w8_store(B, rb, T1, F.tid, F.wave, F.lane); st = nx;
    }
    __syncthreads();
}
__device__ __forceinline__ void rms_row_bf16(const float* xrow, const float* g, bf16_t* orow, int lane) {
    f32x4 v[4]; float ss = 0.f;
#pragma unroll
    for (int j = 0; j < 4; ++j) { v[j] = ((const f32x4*)xrow)[lane + 64 * j]; ss += (v[j].x * v[j].x + v[j].y * v[j].y) + (v[j].z * v[j].z + v[j].w * v[j].w); }
    const float rs = rsqrtf(wave_sum(ss) * (1.f / DM) + EPS);
#pragma unroll
    for (int j = 0; j < 4; ++j) { const f32x4 gv = ((const f32x4*)g)[lane + 64 * j]; const f32x4 o = v[j] * rs * gv;
        u32x2 w; w.x = cvtpk(o.x, o.y); w.y = cvtpk(o.z, o.w); ((u32x2*)orow)[lane + 64 * j] = w; }
}
__device__ __forceinline__ void prologue(Frame& F) {
    LAS float* scr = (LAS float*)(F.lds + F.wave * 16384);
    const int gw = F.bid * 8 + F.wave, NGW = F.G * 8;
    constexpr int I_IN = 16 * 64, I_OUT = 16 * 32, I_MKV = 16 * 16;
    constexpr int S0 = 2 * I_IN, S1 = S0 + 2 * I_OUT, S2 = S1 + 2 * I_MKV, S4 = S2;
#define TI_DECODE(I, it_) do { const int it__ = (it_); int r_, N_; \
        if (it__ < S0) { const int l = it__ / I_IN; r_ = it__ % I_IN; N_ = NIN; (I).W = F.in(IN_WIN) + (size_t)l * DM * NIN; (I).WT = (bf16_t*)(F.ws() + WS_WIN) + (size_t)l * NIN * DM; (I).mode = 1; } \
        else if (it__ < S1) { const int q = it__ - S0, l = q / I_OUT; r_ = q % I_OUT; N_ = DM; (I).W = F.in(IN_WOUT) + (size_t)l * DM * DM; (I).WT = (bf16_t*)(F.ws() + WS_WOUT) + (size_t)l * DM * DM; (I).mode = 0; } \
        else { const int q = it__ - S1, l = q / I_MKV; r_ = q % I_MKV; N_ = 512; (I).W = F.in(IN_WMKV) + (size_t)l * DM * 512; (I).WT = (bf16_t*)(F.ws() + WS_WMKV) + (size_t)l * 512 * DM; (I).mode = 0; } \
        const int nblk_ = N_ / 32; (I).N = N_; (I).k0 = 64 * (r_ / nblk_); (I).n0 = 32 * (r_ % nblk_); } while (0)
    { float ta[32], tb[32]; TItem A, B; int it = gw;
      if (it < S4) { TI_DECODE(A, it); titem_load(A, ta, F.lane); }
      while (it < S4) {
          int nx = it + NGW; if (nx < S4) { TI_DECODE(B, nx); titem_load(B, tb, F.lane); }
          titem_store(A, ta, scr, F.lane); it = nx; if (it >= S4) break;
          nx = it + NGW; if (nx < S4) { TI_DECODE(A, nx); titem_load(A, ta, F.lane); }
          titem_store(B, tb, scr, F.lane); it = nx;
      } }
#undef TI_DECODE
    { float* cs = (float*)(F.ws() + WS_COS); float* sn = (float*)(F.ws() + WS_SIN);
      for (int i = F.bid * 512 + F.tid; i < SEQ * 32; i += F.G * 512) { const int pos = i >> 5, f = i & 31;
          const float inv = exp2f(-(float)f * (13.287712379549449f / 32.0f));
          const float angf = (float)pos * inv; const double rev = (double)angf * 0.15915494309189535; const float fr = (float)(rev - rint(rev));
          cs[i] = __builtin_amdgcn_cosf(fr); sn[i] = __builtin_amdgcn_sinf(fr); } }
    for (int r = gw; r < 2 * 512; r += NGW) { const int l = r >> 9, m = r & 511; rms_row_bf16(F.in(IN_MEM) + (size_t)m * DM, F.in(IN_MEMNG) + l * DM, (bf16_t*)(F.ws() + WS_MEMN) + (size_t)r * DM, F.lane); }
    { const float* xin = F.in(IN_X); const float* g1 = F.in(IN_N1G); bf16_t* XN = (bf16_t*)(F.ws() + WS_XN);
      for (int r0 = gw; r0 < TOK; r0 += 2 * NGW) {
          f32x4 v[2][4]; float ss[2] = {0.f, 0.f};
#pragma unroll
          for (int a = 0; a < 2; ++a) { const int r = min(r0 + a * NGW, TOK - 1);
#pragma unroll
              for (int j = 0; j < 4; ++j) { v[a][j] = ((const f32x4*)(xin + (size_t)r * DM))[F.lane + 64 * j]; ss[a] += (v[a][j].x * v[a][j].x + v[a][j].y * v[a][j].y) + (v[a][j].z * v[a][j].z + v[a][j].w * v[a][j].w); } }
#pragma unroll
          for (int a = 0; a < 2; ++a) { const int r = r0 + a * NGW; if (r >= TOK) break; const float rs = rsqrtf(wave_sum(ss[a]) * (1.f / DM) + EPS);
#pragma unroll
              for (int j = 0; j < 4; ++j) { const f32x4 gv = ((const f32x4*)g1)[F.lane + 64 * j]; const f32x4 o = v[a][j] * rs * gv;
                  u32x2 w; w.x = cvtpk(o.x, o.y); w.y = cvtpk(o.z, o.w); ((u32x2*)(XN + (size_t)r * DM))[F.lane + 64 * j] = w; } } } }
}

__device__ __forceinline__ int crow(int r, int hi) { return (r & 3) + 8 * (r >> 2) + 4 * hi; }
__device__ __forceinline__ s16x4 vtr(LAS const unsigned char* p) { typedef short v4i16_t __attribute__((ext_vector_type(4))); return __builtin_bit_cast(s16x4, __builtin_amdgcn_ds_read_tr16_b64_v4i16((LAS v4i16_t*)p)); }

struct AttnJob {
    const bf16_t* Q; int qpitch, qrow0, qstep;
    const bf16_t* K; const bf16_t* V; int kvpitch, krow0, kstep;
    int t0, ntiles;
    bf16_t* O; int opitch; float* lse; int lsepitch;
};
template <bool MEM> struct AttnStage { static constexpr int NSLOT = MEM ? 8 : 12, NL = NSLOT * 256 / 512; u32x4 k[NL], v[NL]; };

template <bool MEM>
__device__ __forceinline__ void attn_issue_loads(const AttnJob& J, AttnStage<MEM>& S, int tid) {
#pragma unroll
    for (int i = 0; i < AttnStage<MEM>::NL; ++i) { const int q = tid + 512 * i, slot = q >> 8, row = (q >> 3) & 31, c = q & 7;
        const int t = min(max(J.t0 + slot, 0), J.ntiles - 1); const size_t off = (size_t)(J.krow0 + (t * 32 + row) * J.kstep) * J.kvpitch + c * 8;
        S.k[i] = *(const u32x4*)(J.K + off); S.v[i] = *(const u32x4*)(J.V + off); }
}
template <bool MEM>
__device__ __forceinline__ void attn_write_lds(const AttnStage<MEM>& S, LAS unsigned char* lds, int tid) {
#pragma unroll
    for (int i = 0; i < AttnStage<MEM>::NL; ++i) { const int q = tid + 512 * i, slot = q >> 8, row = (q >> 3) & 31, c = q & 7;
        *(LAS u32x4*)(lds + slot * 4096 + row * 128 + ((c ^ ((row >> 1) & 7)) << 4)) = S.k[i];
        *(LAS u32x4*)(lds + 49152 + slot * 4096 + row * 128 + ((c << 4) ^ (((row >> 1) & 1) << 6))) = S.v[i]; }
}
template <bool MEM, int NTC, int LI0>
__device__ __forceinline__ void attn_chunk(const AttnJob& J, const bf16x8 (&qf)[4], LAS unsigned char* lds, int wave, const int (&ka)[4], int tv0, int tv1, int mt,
                                           f32x16 (&o)[2], float& m_run, f32x2& l_run) {
    f32x16 s[NTC];
#pragma unroll
    for (int kt = 0; kt < NTC; ++kt) {
        constexpr int dummy = 0; (void)dummy;
        const int li = LI0 + kt, slot = MEM ? li : (wave + li);
        bf16x8 kf[4];
#pragma unroll
        for (int d0 = 0; d0 < 4; ++d0) kf[d0] = *(const LAS bf16x8*)(lds + ka[d0] + li * 4096);
        f32x16 a;
#pragma unroll
        for (int r = 0; r < 16; ++r) a[r] = 0.f;
#pragma unroll
        for (int d0 = 0; d0 < 4; ++d0) a = __builtin_amdgcn_mfma_f32_32x32x16_bf16(kf[d0], qf[d0], a, 0, 0, 0);
        if (!MEM) { const int traw = J.t0 + slot;
            if (li == 0 || li == 4) {
#pragma unroll
                for (int r = 0; r < 16; ++r) { const int cr = (r & 3) + 8 * (r >> 2); const bool keep = (li == 0) ? (cr >= mt) : (cr <= mt); a[r] = keep ? a[r] : -1e30f; } }
            if (traw < 0 || traw >= J.ntiles) {
                asm volatile("" ::: "memory");
#pragma unroll
                for (int r = 0; r < 16; ++r) a[r] = -1e30f; } }
        s[kt] = a;
    }
    float mx = -1e30f;
#pragma unroll
    for (int kt = 0; kt < NTC; ++kt)
#pragma unroll
        for (int r = 0; r < 16; ++r) mx = fmaxf(mx, s[kt][r]);
    mx = xor32_max(mx);
    const float m_new = fmaxf(m_run, mx);
    if (LI0 > 0) { const float alpha = __builtin_amdgcn_exp2f(m_run - m_new); const f32x2 al2 = {alpha, alpha}; l_run *= al2;
#pragma unroll
        for (int r = 0; r < 16; r += 2) { const f32x2 x0 = (f32x2){o[0][r], o[0][r + 1]} * al2, x1 = (f32x2){o[1][r], o[1][r + 1]} * al2; o[0][r] = x0.x; o[0][r + 1] = x0.y; o[1][r] = x1.x; o[1][r + 1] = x1.y; } }
    m_run = m_new; const f32x2 mn2 = {m_new, m_new};
#pragma unroll
    for (int kt = 0; kt < NTC; ++kt) {
        const int li = LI0 + kt;
#pragma unroll
        for (int r = 0; r < 16; r += 2) { f32x2 d = (f32x2){s[kt][r], s[kt][r + 1]} - mn2; d.x = __builtin_amdgcn_exp2f(d.x); d.y = __builtin_amdgcn_exp2f(d.y); s[kt][r] = d.x; s[kt][r + 1] = d.y; l_run += d; }
        bf16x8 pb[2];
#pragma unroll
        for (int s2 = 0; s2 < 2; ++s2) { u32x4 w; w.x = cvtpk(s[kt][8 * s2 + 0], s[kt][8 * s2 + 1]); w.y = cvtpk(s[kt][8 * s2 + 2], s[kt][8 * s2 + 3]);
            w.z = cvtpk(s[kt][8 * s2 + 4], s[kt][8 * s2 + 5]); w.w = cvtpk(s[kt][8 * s2 + 6], s[kt][8 * s2 + 7]); pb[s2] = __builtin_bit_cast(bf16x8, w); }
#pragma unroll
        for (int db = 0; db < 2; ++db)
#pragma unroll
            for (int s2 = 0; s2 < 2; ++s2) { const int tb = (db == 0) ? tv0 : tv1;
                const s16x4 lo = vtr(lds + tb + li * 4096 + s2 * 2048), h8 = vtr(lds + tb + li * 4096 + s2 * 2048 + 1024);
                const bf16x8 va = (bf16x8){lo[0], lo[1], lo[2], lo[3], h8[0], h8[1], h8[2], h8[3]};
                o[db] = __builtin_amdgcn_mfma_f32_32x32x16_bf16(va, pb[s2], o[db], 0, 0, 0); }
    }
}
template <bool MEM>
__device__ __forceinline__ void attn_compute(const AttnJob& J, const bf16x8 (&qf)[4], LAS unsigned char* lds, int wave, int lane) {
    const int r32 = lane & 31, hi = lane >> 5;
    f32x16 o[2];
#pragma unroll
    for (int r = 0; r < 16; ++r) { o[0][r] = 0.f; o[1][r] = 0.f; }
    float m_run = -1e30f; f32x2 l_run = {0.f, 0.f};
    const int ksw = (r32 >> 1) & 7, koff = r32 * 128 + (MEM ? 0 : wave * 4096);
    const int q4 = (lane & 15) >> 2, sw = (q4 >> 1) & 1, trow = (4 * hi + q4) * 128, tcol = ((lane >> 4) & 1) * 32 + (lane & 3) * 8;
    const int tv0 = 49152 + (MEM ? 0 : wave * 4096) + trow + ((sw << 6) | tcol), tv1 = 49152 + (MEM ? 0 : wave * 4096) + trow + (((1 ^ sw) << 6) | tcol);
    int ka[4];
#pragma unroll
    for (int d0 = 0; d0 < 4; ++d0) ka[d0] = koff + (((2 * d0 + hi) ^ ksw) << 4);
    int mt = r32 - 4 * hi; asm volatile("" : "+v"(mt));
    if (MEM) { attn_chunk<MEM, 3, 0>(J, qf, lds, wave, ka, tv0, tv1, mt, o, m_run, l_run); attn_chunk<MEM, 3, 3>(J, qf, lds, wave, ka, tv0, tv1, mt, o, m_run, l_run);
               attn_chunk<MEM, 2, 6>(J, qf, lds, wave, ka, tv0, tv1, mt, o, m_run, l_run); }
    else     { attn_chunk<MEM, 3, 0>(J, qf, lds, wave, ka, tv0, tv1, mt, o, m_run, l_run); attn_chunk<MEM, 2, 3>(J, qf, lds, wave, ka, tv0, tv1, mt, o, m_run, l_run); }
    const float l = xor32_sum(l_run.x + l_run.y);
    const float inv = 1.0f / l;
    const int qrow = J.qrow0 + (wave * 32 + r32) * J.qstep;
    LAS unsigned char* ot = lds + 98304 + wave * 4096;
#pragma unroll
    for (int db = 0; db < 2; ++db)
#pragma unroll
        for (int g = 0; g < 4; ++g) { u32x2 w; w.x = cvtpk(o[db][4 * g] * inv, o[db][4 * g + 1] * inv); w.y = cvtpk(o[db][4 * g + 2] * inv, o[db][4 * g + 3] * inv);
            *(LAS u32x2*)(ot + r32 * 128 + (32 * db + 8 * g + 4 * hi) * 2) = w; }
    if (J.lse != nullptr && hi == 0) J.lse[(size_t)qrow * J.lsepitch] = m_run + __builtin_amdgcn_logf(l);
    LDS_WAIT();
    { const int c = lane & 7, rr = lane >> 3; const size_t obase = (size_t)(J.qrow0 + wave * 32 * J.qstep) * J.opitch;
#pragma unroll
      for (int i = 0; i < 4; ++i) { const int row = rr + 8 * i; *(u32x4*)(J.O + obase + (size_t)(row * J.qstep) * J.opitch + c * 8) = *(const LAS u32x4*)(ot + row * 128 + c * 16); } }
}
template <bool MEM, class MakeJob>
__device__ __forceinline__ void attn_block_units(Frame& F, int first, int count, int stride, const MakeJob& mk) {
    if (first >= count) return;
    AttnStage<MEM> S; AttnJob J = mk(first); bf16x8 qn[4];
#define ATTN_LOAD_Q(JJ) do { const int qrow_ = (JJ).qrow0 + (F.wave * 32 + (F.lane & 31)) * (JJ).qstep; const bf16_t* qp_ = (JJ).Q + (size_t)qrow_ * (JJ).qpitch + (F.lane >> 5) * 8; \
        _Pragma("unroll") for (int d0 = 0; d0 < 4; ++d0) qn[d0] = *(const bf16x8*)(qp_ + d0 * 16); } while (0)
    attn_issue_loads<MEM>(J, S, F.tid); ATTN_LOAD_Q(J);
    for (int u = first; u < count; u += stride) {
        bf16x8 qf[4];
#pragma unroll
        for (int d0 = 0; d0 < 4; ++d0) qf[d0] = qn[d0];
        __syncthreads();
        attn_write_lds<MEM>(S, F.lds, F.tid);
        __syncthreads();
        const int un = u + stride; AttnJob Jn = J;
        if (un < count) { Jn = mk(un); attn_issue_loads<MEM>(Jn, S, F.tid); ATTN_LOAD_Q(Jn); }
        attn_compute<MEM>(J, qf, F.lds, F.wave, F.lane);
        J = Jn;
    }
    __syncthreads();
#undef ATTN_LOAD_Q
}

constexpr int POOL_DH = 40960, POOL_WT = POOL_DH + 64 * 528, POOL_DPITCH = 528, POOL_WPITCH = 144;
__device__ __forceinline__ void pool_unit(Frame& F, const bf16_t* PROJ, const float* pw, const float* pscale, bf16_t* YRAW, int tile) {
    const int tid = F.tid, row0 = tile * 64, pos0 = row0 & (SEQ - 1);
    LAS bf16_t* U = (LAS bf16_t*)F.lds;
    LAS unsigned char* Dh = F.lds + POOL_DH; LAS unsigned char* WT = F.lds + POOL_WT;
    { u32x4 uv[5];
#pragma unroll
      for (int q = 0; q < 5; ++q) { const int i = tid + 512 * q, r = i >> 5, ch = i & 31, pos = min(max(pos0 - 8 + r, 0), SEQ - 1);
          uv[q] = *(const u32x4*)(PROJ + (size_t)(row0 - pos0 + pos) * NIN + 1536 + ch * 8); }
#pragma unroll
      for (int q = 0; q < 5; ++q) { const int i = tid + 512 * q, r = i >> 5, ch = i & 31, pos = pos0 - 8 + r;
          *(LAS u32x4*)(U + r * 256 + ch * 8) = (pos >= 0 && pos < SEQ) ? uv[q] : (u32x4){0u, 0u, 0u, 0u}; } }
    { float pwv[32];
#pragma unroll
      for (int i = 0; i < 32; ++i) pwv[i] = pw[tid + 512 * i];
#pragma unroll
      for (int i = 0; i < 32; ++i) { const int idx = tid + 512 * i, dout = idx & 63, c = (idx >> 6) & 63, g = idx >> 12;
          *(LAS bf16_t*)(WT + (g * 64 + dout) * POOL_WPITCH + c * 2) = f2bf(pwv[i]); } }
    __syncthreads();
    { const int ch = tid & 255, g = ch >> 6, half = tid >> 8, w = 2 << g, left = w >> 1, right = w - 1 - left, i0 = half * 32;
      float s = 0.f;
#pragma unroll
      for (int k = 0; k < 16; ++k) if (k < w) s += bf1(U[(i0 - left + k + 8) * 256 + ch]);
#pragma unroll 2
      for (int ii = 0; ii < 32; ++ii) { const int i = i0 + ii, pos = pos0 + i; const int lo = max(pos - left, 0), hi = min(pos + right, SEQ - 1);
          *(LAS bf16_t*)(Dh + i * POOL_DPITCH + ch * 2) = f2bf(s / (float)(hi - lo + 1) - bf1(U[(i + 8) * 256 + ch]));
          s += bf1(U[(i + 1 + right + 8) * 256 + ch]) - bf1(U[(i - left + 8) * 256 + ch]); } }
    __syncthreads();
    { const int lane = F.lane, r32 = lane & 31, hi = lane >> 5, g = F.wave & 3, th = F.wave >> 2;
      bf16x8 af[4];
#pragma unroll
      for (int s = 0; s < 4; ++s) af[s] = *(const LAS bf16x8*)(Dh + (th * 32 + r32) * POOL_DPITCH + (g * 64 + 16 * s + 8 * hi) * 2);
#pragma unroll 1
      for (int nt = 0; nt < 2; ++nt) {
          f32x16 acc;
#pragma unroll
          for (int r = 0; r < 16; ++r) acc[r] = 0.f;
#pragma unroll
          for (int s = 0; s < 4; ++s) { const bf16x8 bfr = *(const LAS bf16x8*)(WT + (g * 64 + nt * 32 + r32) * POOL_WPITCH + (16 * s + 8 * hi) * 2);
              acc = __builtin_amdgcn_mfma_f32_32x32x16_bf16(bfr, af[s], acc, 0, 0, 0); }
          LAS unsigned char* yt = F.lds + (th * 32 + r32) * 528 + (g * 64 + nt * 32 + 4 * hi) * 2; const float* ps = pscale + g * 64 + nt * 32 + 4 * hi;
#pragma unroll
          for (int gq = 0; gq < 4; ++gq) { const f32x4 sc = *(const f32x4*)(ps + 8 * gq);
              u32x2 w; w.x = cvtpk(acc[4 * gq] * sc.x, acc[4 * gq + 1] * sc.y); w.y = cvtpk(acc[4 * gq + 2] * sc.z, acc[4 * gq + 3] * sc.w); *(LAS u32x2*)(yt + 16 * gq) = w; }
      } }
    __syncthreads();
#pragma unroll
    for (int i = 0; i < 4; ++i) { const int q = tid + 512 * i, tok = q >> 5, c = q & 31;
        *(u32x4*)(YRAW + (size_t)(row0 + tok) * 512 + c * 8) = *(const LAS u32x4*)(F.lds + tok * 528 + c * 16); }
    __syncthreads();
}

struct DilJob { const bf16_t* QH; bf16_t* AO; float* LSE;
    __device__ __forceinline__ AttnJob operator()(int bu) const {
        const int i8 = bu & 31, bhp = bu >> 5, p = bhp % 3, bh = bhp / 3, h = bh & 7, b = bh >> 3;
        const int dil = (p == 0) ? 1 : (p == 1 ? 4 : 16), tpr = 256 / dil, g8 = tpr >> 3, r = i8 / g8, jt0 = 8 * (i8 % g8);
        const size_t hs = (size_t)SEQ * 64;
        AttnJob J; J.Q = QH + (size_t)(b * 8 + h) * hs; J.qpitch = 64; J.qrow0 = r + jt0 * 32 * dil; J.qstep = dil;
        J.K = QH + (size_t)((2 + b) * 8 + h) * hs; J.V = QH + (size_t)((4 + b) * 8 + h) * hs; J.kvpitch = 64; J.krow0 = r; J.kstep = dil; J.t0 = jt0 - 2; J.ntiles = tpr;
        J.O = AO + (size_t)p * TOK * 512 + (size_t)b * SEQ * 512 + h * 64; J.opitch = 512; J.lse = LSE + (size_t)p * TOK * 8 + (size_t)b * SEQ * 8 + h; J.lsepitch = 8; return J; } };
struct MemJob { const bf16_t* PROJ; const bf16_t* MKV; bf16_t* YRAW;
    __device__ __forceinline__ AttnJob operator()(int mu) const {
        const int q8 = mu & 31, bh = mu >> 5, hm = bh & 3, b = bh >> 2;
        AttnJob J; J.Q = PROJ + 1792 + hm * 64; J.qpitch = NIN; J.qrow0 = b * SEQ + q8 * 256; J.qstep = 1;
        J.K = MKV + hm * 64; J.V = MKV + 256 + hm * 64; J.kvpitch = 512; J.krow0 = b * NMEM; J.kstep = 1; J.t0 = 0; J.ntiles = 8;
        J.O = YRAW + 256 + hm * 64; J.opitch = 512; J.lse = nullptr; J.lsepitch = 0; return J; } };

__device__ __forceinline__ void phase_mixers(Frame& F, int l, int parts = 7) {
    const bf16_t* PROJ = (const bf16_t*)(F.ws() + WS_PROJ); const bf16_t* QH = (const bf16_t*)(F.ws() + WS_QKVH);
    bf16_t* AO = (bf16_t*)(F.ws() + WS_AO); float* LSE = (float*)(F.ws() + WS_LSE); bf16_t* YRAW = (bf16_t*)(F.ws() + WS_YRAW);
    const bf16_t* MKV = (const bf16_t*)(F.ws() + WS_MEMKV) + (size_t)l * 512 * 512;
    const int pt = (parts == 7 && l == 0) ? (F.bid & 3) : -1;
    if (pt == 0) w8_static(F, 0, W8_GU_STEPS / 2 + F.bid, W8_GU_STEPS, F.G);
    if (parts & 1) { DilJob mk{QH, AO, LSE}; attn_block_units<false>(F, F.bid, 1536, F.G, mk); }
    if (pt == 1) w8_static(F, 0, W8_GU_STEPS / 2 + F.bid, W8_GU_STEPS, F.G);
    if (parts & 2) { MemJob mk{PROJ, MKV, YRAW}; attn_block_units<true>(F, F.bid, 256, F.G, mk); }
    if (pt == 2) w8_static(F, 0, W8_GU_STEPS / 2 + F.bid, W8_GU_STEPS, F.G);
    if (parts & 4) for (int tile = F.bid; tile < TOK / 64; tile += F.G) pool_unit(F, PROJ, F.in(IN_POOLW) + (size_t)l * 4 * 64 * 64, F.in(IN_POOLS) + l * 256, YRAW, tile);
    if (pt == 3) w8_static(F, 0, W8_GU_STEPS / 2 + F.bid, W8_GU_STEPS, F.G);
}

__device__ __forceinline__ void phase_combine_norm(Frame& F, int l) {
    const bf16_t* AO = (const bf16_t*)(F.ws() + WS_AO); const float* LSE = (const float*)(F.ws() + WS_LSE); const bf16_t* YRAW = (const bf16_t*)(F.ws() + WS_YRAW);
    bf16_t* Y = (bf16_t*)(F.ws() + WS_Y); const float* gg = F.in(IN_GRPG) + l * DM;
    const int gw = F.bid * 8 + F.wave, NGW = F.G * 8, lane = F.lane, head = lane >> 3;
    float lsn[2][3]; u32x4 avn[2][3]; u32x2 pvn[2], mvn[2];
#define CN_LOAD(r0_) do { _Pragma("unroll") for (int a = 0; a < 2; ++a) { const size_t row = (size_t)min((r0_) + a * NGW, TOK - 1); \
            _Pragma("unroll") for (int p = 0; p < 3; ++p) { lsn[a][p] = LSE[(size_t)p * TOK * 8 + row * 8 + head]; avn[a][p] = __builtin_nontemporal_load((const u32x4*)(AO + (size_t)p * TOK * 512 + row * 512 + lane * 8)); } \
            pvn[a] = *(const u32x2*)(YRAW + row * 512 + lane * 4); mvn[a] = *(const u32x2*)(YRAW + row * 512 + 256 + lane * 4); } } while (0)
    CN_LOAD(gw);
    for (int r0 = gw; r0 < TOK; r0 += 2 * NGW) {
        float ls[2][3]; u32x4 av[2][3]; u32x2 pv[2], mv[2];
#pragma unroll
        for (int a = 0; a < 2; ++a) { pv[a] = pvn[a]; mv[a] = mvn[a];
#pragma unroll
            for (int p = 0; p < 3; ++p) { ls[a][p] = lsn[a][p]; av[a][p] = avn[a][p]; } }
        if (r0 + 2 * NGW < TOK) CN_LOAD(r0 + 2 * NGW);
#pragma unroll
        for (int a = 0; a < 2; ++a) { const int rowi = r0 + a * NGW; if (rowi >= TOK) break; const size_t row = (size_t)rowi;
            const float l0 = ls[a][0], l1 = ls[a][1], l2 = ls[a][2]; const u32x4 a0 = av[a][0], a1 = av[a][1], a2 = av[a][2];
            const float mx = fmaxf(l0, fmaxf(l1, l2));
            float w0 = __builtin_amdgcn_exp2f(l0 - mx), w1 = __builtin_amdgcn_exp2f(l1 - mx), w2 = __builtin_amdgcn_exp2f(l2 - mx);
            const float wi = 1.0f / (w0 + w1 + w2); w0 *= wi; w1 *= wi; w2 *= wi;
            float y[8]; float ss = 0.f;
#pragma unroll
            for (int i = 0; i < 4; ++i) { y[2 * i] = w0 * bflo(a0[i]) + w1 * bflo(a1[i]) + w2 * bflo(a2[i]); y[2 * i + 1] = w0 * bfhi(a0[i]) + w1 * bfhi(a1[i]) + w2 * bfhi(a2[i]); ss += y[2 * i] * y[2 * i] + y[2 * i + 1] * y[2 * i + 1]; }
            const float p0 = bflo(pv[a].x), p1 = bfhi(pv[a].x), p2 = bflo(pv[a].y), p3 = bfhi(pv[a].y);
            const float q0 = bflo(mv[a].x), q1 = bfhi(mv[a].x), q2 = bflo(mv[a].y), q3 = bfhi(mv[a].y);
            float sp = p0 * p0 + p1 * p1 + p2 * p2 + p3 * p3, sq = q0 * q0 + q1 * q1 + q2 * q2 + q3 * q3;
            ss = wave_sum(ss); sp = wave_sum(sp); sq = wave_sum(sq);
            const float rs = rsqrtf(ss * (1.f / 512.f) + EPS), rp = rsqrtf(sp * (1.f / 256.f) + EPS), rq = rsqrtf(sq * (1.f / 256.f) + EPS);
            const f32x4 g0 = *(const f32x4*)(gg + lane * 8), g1 = *(const f32x4*)(gg + lane * 8 + 4), gp = *(const f32x4*)(gg + 512 + lane * 4), gq = *(const f32x4*)(gg + 768 + lane * 4);
            u32x4 wv; wv.x = cvtpk(y[0] * rs * g0.x, y[1] * rs * g0.y); wv.y = cvtpk(y[2] * rs * g0.z, y[3] * rs * g0.w); wv.z = cvtpk(y[4] * rs * g1.x, y[5] * rs * g1.y); wv.w = cvtpk(y[6] * rs * g1.z, y[7] * rs * g1.w);
            *(u32x4*)(Y + row * DM + lane * 8) = wv;
            u32x2 op; op.x = cvtpk(p0 * rp * gp.x, p1 * rp * gp.y); op.y = cvtpk(p2 * rp * gp.z, p3 * rp * gp.w); *(u32x2*)(Y + row * DM + 512 + lane * 4) = op;
            u32x2 oq; oq.x = cvtpk(q0 * rq * gq.x, q1 * rq * gq.y); oq.y = cvtpk(q2 * rq * gq.z, q3 * rq * gq.w); *(u32x2*)(Y + row * DM + 768 + lane * 4) = oq; }
    }
}

#undef CN_LOAD
__device__ __forceinline__ void phase_router(Frame& F, int l) {
    const bf16_t* X1 = (const bf16_t*)(F.ws() + WS_X1); unsigned char* H2 = F.ws() + WS_H2;
    const float* g2 = F.in(IN_N2G) + l * DM; const float* Wr = F.in(IN_RW) + (size_t)l * DM * NE; const float* rb = F.in(IN_RB) + l * NE;
    int* rt_e = (int*)(F.ws() + WS_RT); int* rt_rank = rt_e + TOK * TOPK; float* rt_gate = (float*)(rt_rank + TOK * TOPK); int* elist = (int*)(F.ws() + WS_ELIST);
    unsigned* gcnt = (unsigned*)(F.ws() + WS_CTL) + CW_CNT + 64 * l;
    LAS float* hb = (LAS float*)F.lds;
    LAS float* pl = (LAS float*)(F.lds + 65536);
    LAS int* lcnt = (LAS int*)(F.lds + MISC_OFF + 1024);
    LAS int* lbase = lcnt + 32;
    LAS int* le = lcnt + 64;
    LAS int* lrank = le + 256;
    const int lane = F.lane, e = lane & 31, half = lane >> 5, w = F.wave;
    f32x2 wreg[32];
#pragma unroll
    for (int i = 0; i < 32; ++i) { wreg[i].x = Wr[(size_t)(128 * w + 64 * half + 2 * i) * NE + e]; wreg[i].y = Wr[(size_t)(128 * w + 64 * half + 2 * i + 1) * NE + e]; }
    const float bias = rb[e];
    for (int tg = F.bid; tg < TOK / 64; tg += F.G) {
        if (F.tid < 32) lcnt[F.tid] = 0;
        __syncthreads();
        u32x2 xv[2][4];
#pragma unroll
        for (int i2 = 0; i2 < 2; ++i2)
#pragma unroll
            for (int j = 0; j < 4; ++j) xv[i2][j] = ((const u32x2*)(X1 + ((size_t)tg * 64 + 2 * w + i2) * DM))[lane + 64 * j];
#pragma unroll 1
        for (int b = 0; b < 4; ++b) {
#pragma unroll
            for (int i2 = 0; i2 < 2; ++i2) { const int ti = 2 * w + i2; const size_t row = (size_t)tg * 64 + 16 * b + ti;
                f32x4 v[4]; float ss = 0.f;
#pragma unroll
                for (int j = 0; j < 4; ++j) { v[j] = (f32x4){bflo(xv[i2][j].x), bfhi(xv[i2][j].x), bflo(xv[i2][j].y), bfhi(xv[i2][j].y)}; ss += (v[j].x * v[j].x + v[j].y * v[j].y) + (v[j].z * v[j].z + v[j].w * v[j].w); }
                const float rs = rsqrtf(wave_sum(ss) * (1.f / DM) + EPS);
#pragma unroll
                for (int j = 0; j < 4; ++j) { const f32x4 gv = ((const f32x4*)g2)[lane + 64 * j]; const f32x4 o = v[j] * rs * gv;
                    int w8 = 0; w8 = __builtin_amdgcn_cvt_pk_fp8_f32(o.x, o.y, w8, false); w8 = __builtin_amdgcn_cvt_pk_fp8_f32(o.z, o.w, w8, true); ((int*)(H2 + row * DM))[lane + 64 * j] = w8;
                    *(LAS f32x4*)(hb + ti * 1024 + (lane + 64 * j) * 4) = o; } }
            if (b < 3) {
#pragma unroll
                for (int i2 = 0; i2 < 2; ++i2)
#pragma unroll
                    for (int j = 0; j < 4; ++j) xv[i2][j] = ((const u32x2*)(X1 + ((size_t)tg * 64 + 16 * (b + 1) + 2 * w + i2) * DM))[lane + 64 * j]; }
            __syncthreads();
#pragma unroll 2
            for (int t = 0; t < 16; ++t) { const LAS float* hp = hb + t * 1024 + 128 * w + 64 * half; f32x2 a0 = {0.f, 0.f}, a1 = {0.f, 0.f};
#pragma unroll
                for (int i = 0; i < 64; i += 4) { const f32x4 hv = *(const LAS f32x4*)(hp + i); a0 += (f32x2){hv.x, hv.y} * wreg[i >> 1]; a1 += (f32x2){hv.z, hv.w} * wreg[(i >> 1) + 1]; }
                const float p = xor32_sum((a0.x + a0.y) + (a1.x + a1.y));
                if (lane < 32) pl[(w * 16 + t) * 32 + e] = p; }
            __syncthreads();
#pragma unroll
            for (int i2 = 0; i2 < 2; ++i2) { const int ti = 2 * w + i2, tl = 16 * b + ti;
                float v = bias;
#pragma unroll
                for (int ww = 0; ww < 8; ++ww) v += pl[(ww * 16 + ti) * 32 + e];
                float tv[4]; int tix[4];
#pragma unroll
                for (int k = 0; k < 4; ++k) { float bv = v; int bi = e;
#define TOPK_STEP(M) { const float ov = swz_f<M>(bv); const int oi = swz_i<M>(bi); if (ov > bv || (ov == bv && oi < bi)) { bv = ov; bi = oi; } }
                    TOPK_STEP(1) TOPK_STEP(2) TOPK_STEP(4) TOPK_STEP(8)
#undef TOPK_STEP
                    { const auto rv = __builtin_amdgcn_permlane16_swap(__float_as_uint(bv), __float_as_uint(bv), false, false); const auto ri = __builtin_amdgcn_permlane16_swap((unsigned)bi, (unsigned)bi, false, false);
                      const float v0 = __uint_as_float(rv[0]), v1 = __uint_as_float(rv[1]); const int i0 = (int)ri[0], i1 = (int)ri[1];
                      const bool t1 = (v1 > v0) || (v1 == v0 && i1 < i0); bv = t1 ? v1 : v0; bi = t1 ? i1 : i0; }
                    tv[k] = bv; tix[k] = bi; if (e == bi) v = -3.0e38f; }
                const float e1 = __expf(tv[1] - tv[0]), e2 = __expf(tv[2] - tv[0]), e3 = __expf(tv[3] - tv[0]); const float isum = 1.0f / (1.0f + e1 + e2 + e3);
                if (lane < 4) { const int me = (lane == 0) ? tix[0] : (lane == 1) ? tix[1] : (lane == 2) ? tix[2] : tix[3];
                    const float gt = ((lane == 0) ? 1.0f : (lane == 1) ? e1 : (lane == 2) ? e2 : e3) * isum;
                    const int lr = __hip_atomic_fetch_add(lcnt + me, 1, __ATOMIC_RELAXED, __HIP_MEMORY_SCOPE_WORKGROUP);
                    le[tl * 4 + lane] = me; lrank[tl * 4 + lane] = lr; rt_gate[((size_t)tg * 64 + tl) * 4 + lane] = gt; } }
        }
        __syncthreads();
        if (F.tid < 32) lbase[F.tid] = (int)__hip_atomic_fetch_add(gcnt + F.tid, (unsigned)lcnt[F.tid], __ATOMIC_RELAXED, __HIP_MEMORY_SCOPE_AGENT);
        __syncthreads();
        if (F.tid < 256) { const int me = le[F.tid], rk = lbase[me] + lrank[F.tid]; rt_e[(size_t)tg * 256 + F.tid] = me; rt_rank[(size_t)tg * 256 + F.tid] = rk; elist[(size_t)me * TOK + rk] = tg * 64 + (F.tid >> 2); }
        __syncthreads();
    }
}

__device__ __forceinline__ LAS int* moe_tile_table(Frame& F, int l) {
    LAS int* tstart = (LAS int*)(F.lds + MISC_OFF + 512);
    const unsigned* gcnt = (const unsigned*)(F.ws() + WS_CTL) + CW_CNT + 64 * l;
    if (F.tid < 64) {
        const int e = F.lane & 31; const int cnt = (int)__hip_atomic_load(gcnt + e, __ATOMIC_RELAXED, __HIP_MEMORY_SCOPE_AGENT); const int mt = (cnt + 255) >> 8;
        int inc = mt;
#pragma unroll
        for (int o = 1; o < 32; o <<= 1) { const int t = __builtin_amdgcn_ds_bpermute(((F.lane - o) & 63) << 2, inc); if (e >= o) inc += t; }
        if (F.lane < 32) { tstart[80 + e] = cnt; tstart[40 + e] = mt; tstart[e] = inc - mt; if (e == 31) tstart[32] = inc; } }
    __syncthreads();
    return tstart;
}

__device__ __forceinline__ void phase_moe_combine(Frame& F, int l) {
    const bf16_t* X1 = (const bf16_t*)(F.ws() + WS_X1); bf16_t* X2 = (bf16_t*)(F.ws() + WS_X2); const unsigned char* YS = F.ws() + WS_YS;
    LAS int* tstart = moe_tile_table(F, l);
    const int* rt_e = (const int*)(F.ws() + WS_RT); const int* rt_rank = rt_e + TOK * TOPK; const float* rt_gate = (const float*)(F.ws() + WS_RT) + 2 * TOK * TOPK;
    bf16_t* XN = (bf16_t*)(F.ws() + WS_XN);
    const bool lastl = (l == DEPTH - 1);
    const float* gn = lastl ? F.in(IN_FING) : (F.in(IN_N1G) + (l + 1) * DM);
    const int gw = F.bid * 8 + F.wave, NGW = F.G * 8, lane = F.lane;
    typedef int i32x4 __attribute__((ext_vector_type(4)));
    i32x4 een[2], sln[2]; f32x4 gtn[2];
#pragma unroll
    for (int a = 0; a < 2; ++a) { const int t = min(gw + a * NGW, TOK - 1); een[a] = *(const i32x4*)(rt_e + (size_t)t * 4); sln[a] = *(const i32x4*)(rt_rank + (size_t)t * 4); gtn[a] = *(const f32x4*)(rt_gate + (size_t)t * 4); }
    for (int t0 = gw; t0 < TOK; t0 += 2 * NGW) {
        i32x4 sl[2]; f32x4 gt[2]; f32x4 v[2][4]; u32x4 xb[2][2]; u32x2 y[2][4][2];
#pragma unroll
        for (int a = 0; a < 2; ++a) { const int t = min(t0 + a * NGW, TOK - 1); const i32x4 ee = een[a]; sl[a] = sln[a]; gt[a] = gtn[a];
            sl[a].x += tstart[ee.x] * 256; sl[a].y += tstart[ee.y] * 256; sl[a].z += tstart[ee.z] * 256; sl[a].w += tstart[ee.w] * 256;
            const bf16_t* xr = X1 + (size_t)t * DM + lane * 8; xb[a][0] = *(const u32x4*)xr; xb[a][1] = *(const u32x4*)(xr + 512); }
#pragma unroll
        for (int a = 0; a < 2; ++a)
#pragma unroll
            for (int k = 0; k < 4; ++k) { const unsigned char* yr = YS + (size_t)sl[a][k] * DM + lane * 8; y[a][k][0] = __builtin_nontemporal_load((const u32x2*)yr); y[a][k][1] = __builtin_nontemporal_load((const u32x2*)(yr + 512)); }
#pragma unroll
        for (int a = 0; a < 2; ++a) { const int t = min(t0 + 2 * NGW + a * NGW, TOK - 1); een[a] = *(const i32x4*)(rt_e + (size_t)t * 4); sln[a] = *(const i32x4*)(rt_rank + (size_t)t * 4); gtn[a] = *(const f32x4*)(rt_gate + (size_t)t * 4); }
#pragma unroll
        for (int a = 0; a < 2; ++a) { const int t = t0 + a * NGW; if (t >= TOK) break;
#pragma unroll
            for (int hf = 0; hf < 2; ++hf) { const u32x4 r = xb[a][hf]; v[a][2 * hf] = (f32x4){bflo(r.x), bfhi(r.x), bflo(r.y), bfhi(r.y)}; v[a][2 * hf + 1] = (f32x4){bflo(r.z), bfhi(r.z), bflo(r.w), bfhi(r.w)}; }
#pragma unroll
            for (int k = 0; k < 4; ++k) { const float g = gt[a][k];
#pragma unroll
                for (int hf = 0; hf < 2; ++hf) { const u32x2 yy = y[a][k][hf];
                    const f32x2 p0 = __builtin_amdgcn_cvt_pk_f32_fp8((int)yy.x, false), p1 = __builtin_amdgcn_cvt_pk_f32_fp8((int)yy.x, true), p2 = __builtin_amdgcn_cvt_pk_f32_fp8((int)yy.y, false), p3 = __builtin_amdgcn_cvt_pk_f32_fp8((int)yy.y, true);
                    v[a][2 * hf][0] += g * p0.x; v[a][2 * hf][1] += g * p0.y; v[a][2 * hf][2] += g * p1.x; v[a][2 * hf][3] += g * p1.y;
                    v[a][2 * hf + 1][0] += g * p2.x; v[a][2 * hf + 1][1] += g * p2.y; v[a][2 * hf + 1][2] += g * p3.x; v[a][2 * hf + 1][3] += g * p3.y; } }
            float ss = 0.f;
#pragma unroll
            for (int j = 0; j < 4; ++j) ss += (v[a][j].x * v[a][j].x + v[a][j].y * v[a][j].y) + (v[a][j].z * v[a][j].z + v[a][j].w * v[a][j].w);
            const float rs = rsqrtf(wave_sum(ss) * (1.f / DM) + EPS);
            const float* gr = gn + lane * 8; f32x4 o[4];
            o[0] = v[a][0] * rs * *(const f32x4*)gr; o[1] = v[a][1] * rs * *(const f32x4*)(gr + 4); o[2] = v[a][2] * rs * *(const f32x4*)(gr + 512); o[3] = v[a][3] * rs * *(const f32x4*)(gr + 516);
            if (lastl) { float* orow = F.out() + (size_t)t * DM + lane * 8; *(f32x4*)orow = o[0]; *(f32x4*)(orow + 4) = o[1]; *(f32x4*)(orow + 512) = o[2]; *(f32x4*)(orow + 516) = o[3]; }
            else { bf16_t* xr = X2 + (size_t)t * DM + lane * 8; u32x4 x0, x1;
                x0.x = cvtpk(v[a][0].x, v[a][0].y); x0.y = cvtpk(v[a][0].z, v[a][0].w); x0.z = cvtpk(v[a][1].x, v[a][1].y); x0.w = cvtpk(v[a][1].z, v[a][1].w);
                x1.x = cvtpk(v[a][2].x, v[a][2].y); x1.y = cvtpk(v[a][2].z, v[a][2].w); x1.z = cvtpk(v[a][3].x, v[a][3].y); x1.w = cvtpk(v[a][3].z, v[a][3].w);
                *(u32x4*)xr = x0; *(u32x4*)(xr + 512) = x1;
                bf16_t* nr = XN + (size_t)t * DM + lane * 8; u32x4 w0, w1;
                w0.x = cvtpk(o[0].x, o[0].y); w0.y = cvtpk(o[0].z, o[0].w); w0.z = cvtpk(o[1].x, o[1].y); w0.w = cvtpk(o[1].z, o[1].w);
                w1.x = cvtpk(o[2].x, o[2].y); w1.y = cvtpk(o[2].z, o[2].w); w1.z = cvtpk(o[3].x, o[3].y); w1.w = cvtpk(o[3].z, o[3].w);
                *(u32x4*)nr = w0; *(u32x4*)(nr + 512) = w1; }
        }
    }
}

constexpr int PH_PER_LAYER = 8, N_PHASES = 1 + DEPTH * PH_PER_LAYER;

__global__ void __launch_bounds__(512, 2) enc_fwd(Args args) {
    extern __shared__ __attribute__((aligned(16))) unsigned char lds_raw[];
    Frame F;
    const int wave0 = __builtin_amdgcn_readfirstlane((int)threadIdx.x >> 6);
    F.lds = (LAS unsigned char*)lds_raw; F.lane = (int)__builtin_amdgcn_mbcnt_hi(~0u, __builtin_amdgcn_mbcnt_lo(~0u, 0u)); F.wave = wave0; F.tid = wave0 * 64 + F.lane; F.G = gridDim.x; F.bid = blockIdx.x;
    static_assert(sizeof(Args) == 168, "kernarg layout: in[18] | out | ws | ph_lo, ph_hi");
    F.kp = (const CAS unsigned char*)__builtin_amdgcn_kernarg_segment_ptr();
    const int lo = args.ph_lo, hi = args.ph_hi;
    volatile LAS unsigned* bst = (volatile LAS unsigned*)(F.lds + MISC_OFF + 64);
    if (F.tid < 2) bst[F.tid] = 0u;
    __syncthreads();
    XcdBarrier xbar; xbar.bar = (unsigned*)(F.ws() + WS_CTL) + CW_BAR; xbar.x = 0; xbar.st = bst;
    if (hi - lo > 1) xbar = xcd_barrier_post((unsigned*)(F.ws() + WS_CTL) + CW_BAR, bst, F.tid);
    for (int ph = lo; ph < hi; ++ph) {
        int phv = ph; asm volatile("" : "+s"(phv));
        { int lv = (int)__builtin_amdgcn_mbcnt_hi(~0u, __builtin_amdgcn_mbcnt_lo(~0u, 0u)); asm volatile("" : "+v"(lv)); F.lane = lv; F.wave = wave0; F.tid = wave0 * 64 + lv;
          int bv = blockIdx.x; asm volatile("" : "+s"(bv)); F.bid = bv;
          const CAS unsigned char* kpv = (const CAS unsigned char*)__builtin_amdgcn_kernarg_segment_ptr(); asm volatile("" : "+s"(kpv)); F.kp = kpv; }
        if (phv == 0) prologue(F);
#ifdef PROBE_VARIANT
        else if (phv >= 100) phase_mixers(F, 0, phv - 100);
#endif
        else {
            const int l = (phv - 1) / PH_PER_LAYER, k = (phv - 1) % PH_PER_LAYER;
            const int vcu = (F.G % 8 == 0) ? (F.bid % 8) * (F.G / 8) + F.bid / 8 : F.bid;
            if (k == 0) {
                { pg8::Gemm g{(const bf16_t*)(F.ws() + WS_XN), (const bf16_t*)(F.ws() + WS_WIN) + (size_t)l * NIN * DM, DM, 0}; pg8::StaticOrder S; S.init(TOK, NIN, F.G, F.bid);
                  pg8::EpiProj E{(bf16_t*)(F.ws() + WS_PROJ), (const float*)(F.ws() + WS_COS), (const float*)(F.ws() + WS_SIN), (bf16_t*)(F.ws() + WS_QKVH)};
                  pg8::gemm_phase<pg8::EpiProj, pg8::StaticOrder, true, true>(F.lds, F.tid, g, S, E); }
                if (l == 0) {
                    for (int ll = 0; ll < DEPTH; ++ll) {
                        pg8::Gemm g{(const bf16_t*)(F.ws() + WS_MEMN) + (size_t)ll * 512 * DM, (const bf16_t*)(F.ws() + WS_WMKV) + (size_t)ll * 512 * DM, DM, 0}; pg8::StaticOrder S; S.init(512, 512, F.G, (F.bid + F.G - 8 - 8 * ll) % F.G);
                        pg8::EpiBf16 E{(bf16_t*)(F.ws() + WS_MEMKV) + (size_t)ll * 512 * 512, 512, nullptr, 0, 1.0f};
                        pg8::gemm_phase<pg8::EpiBf16, pg8::StaticOrder, false, true>(F.lds, F.tid, g, S, E); }
                    { const int hb = F.G >> 1; if (F.bid >= hb) w8_static(F, 0, F.bid - hb, W8_GU_STEPS / 2, F.G - hb); }
                    { unsigned* ctl = (unsigned*)(F.ws() + WS_CTL); __syncthreads(); if (F.tid == 0) __hip_atomic_fetch_add(ctl + CW_DONE, 1u, __ATOMIC_RELAXED, __HIP_MEMORY_SCOPE_AGENT); w8_help(F, ctl + CW_W8NEXT, ctl + CW_DONE); }
                }
            } else if (k == 1) phase_mixers(F, l);
            else if (k == 2) phase_combine_norm(F, l);
            else if (k == 3) {
                pg8::Gemm g{(const bf16_t*)(F.ws() + WS_Y), (const bf16_t*)(F.ws() + WS_WOUT) + (size_t)l * DM * DM, DM, 0}; pg8::StaticOrder S; S.init(TOK, DM, F.G, F.bid);
                if (l == 0) { pg8::EpiRes<false> E{F.in(IN_X), (bf16_t*)(F.ws() + WS_X1)}; pg8::gemm_phase<pg8::EpiRes<false>, pg8::StaticOrder, false, true>(F.lds, F.tid, g, S, E); }
                else        { pg8::EpiRes<true> E{F.ws() + WS_X2, (bf16_t*)(F.ws() + WS_X1)}; pg8::gemm_phase<pg8::EpiRes<true>, pg8::StaticOrder, false, true>(F.lds, F.tid, g, S, E); }
            } else if (k == 4) { if (l == 1) w8_help(F, (unsigned*)(F.ws() + WS_CTL) + CW_W8NEXT, nullptr, W8_Q_DN0 + W8_GU_STEPS); phase_router(F, l); }
            else if (k == 5) {
                LAS int* tstart = moe_tile_table(F, l);
                pg8::MoeOrder S{tstart, 8, 4, F.G, vcu};
                LAS int* gtok = (LAS int*)(F.lds + MISC_OFF + 4096);
                { const int* elist = (const int*)(F.ws() + WS_ELIST); int tkv[9];
#pragma unroll
                  for (int i = 0; i < 9; ++i) { pg8::Unit u; const bool ok = S.next(i, u); const int ee = ok ? u.e : 0, idx = ok ? (u.pm - tstart[ee]) * 256 + (F.tid & 255) : 0;
                      const int tk = elist[(size_t)ee * TOK + idx]; tkv[i] = (ok && idx < tstart[80 + ee]) ? tk : 0; }
                  if (F.tid < 256) {
#pragma unroll
                      for (int i = 0; i < 9; ++i) gtok[i * 256 + F.tid] = tkv[i]; }
                  __syncthreads(); }
                pg8::Gemm g{(const bf16_t*)(F.ws() + WS_H2), (const bf16_t*)(F.ws() + WS_WGU + (size_t)l * NE * 2048 * DM), DM, (size_t)2048 * DM, gtok};
                pg8::EpiSwiglu E{F.ws() + WS_ACT, F.in(IN_BGU) + (size_t)l * NE * 2048, 1.0f / W8SCALE};
                pg8::gemm_phase<pg8::EpiSwiglu, pg8::MoeOrder, true, true, true, true>(F.lds, F.tid, g, S, E);
                w8_help(F, (unsigned*)(F.ws() + WS_CTL) + CW_W8NEXT, nullptr, (l == 0) ? W8_Q_DN0 : W8_Q_TOTAL);
                if (l == 0) { unsigned* ctl = (unsigned*)(F.ws() + WS_CTL); __syncthreads(); if (F.tid == 0) __hip_atomic_fetch_add(ctl + CW_DONE + 64 * 5, 1u, __ATOMIC_RELAXED, __HIP_MEMORY_SCOPE_AGENT); w8_help(F, ctl + CW_W8NEXT, ctl + CW_DONE + 64 * 5); }
            } else if (k == 6) {
                LAS int* tstart = moe_tile_table(F, l);
                pg8::Gemm g{(const bf16_t*)(F.ws() + WS_ACT), (const bf16_t*)(F.ws() + WS_WDN + (size_t)l * NE * DM * DM), DM, (size_t)DM * DM};
                pg8::MoeOrder S{tstart, 4, 8, F.G, vcu};
                pg8::EpiF8 E{F.ws() + WS_YS, DM, F.in(IN_BDN) + (size_t)l * NE * DM, DM, 1.0f / W8SCALE};
                pg8::gemm_phase<pg8::EpiF8, pg8::MoeOrder, true, true, true>(F.lds, F.tid, g, S, E);
                if (l == 0) { unsigned* ctl = (unsigned*)(F.ws() + WS_CTL); __syncthreads(); if (F.tid == 0) __hip_atomic_fetch_add(ctl + CW_DONE + 64 * 6, 1u, __ATOMIC_RELAXED, __HIP_MEMORY_SCOPE_AGENT); w8_help(F, ctl + CW_W8NEXT, ctl + CW_DONE + 64 * 6); }
            } else phase_moe_combine(F, l);
        }
        if (ph + 1 < hi) { if (lo < 0) cg::this_grid().sync(); else { xbar.bar = (unsigned*)(F.ws() + WS_CTL) + CW_BAR; xcd_barrier(xbar, F.tid); } }
    }
}

extern "C" void kernel_launch(void* const* d_in, const int* in_sizes, int n_in, void* d_out, int out_size, void* d_ws, size_t ws_size, hipStream_t stream) {
    static int grid = 0;
    if (grid == 0) {
        if (n_in != 18 || in_sizes[0] != TOK * DM || out_size != TOK * DM || ws_size < WS_END) { fprintf(stderr, "kernel_launch: unexpected shapes / workspace (n_in %d, ws %zu)\n", n_in, ws_size); grid = -1; return; }
        int dev = 0, cus = 0, per_cu = 0;
        if (hipGetDevice(&dev) != hipSuccess || hipDeviceGetAttribute(&cus, hipDeviceAttributeMultiprocessorCount, dev) != hipSuccess) { grid = -1; return; }
        if (hipFuncSetAttribute((const void*)enc_fwd, hipFuncAttributeMaxDynamicSharedMemorySize, LDS_BYTES) != hipSuccess) { fprintf(stderr, "kernel_launch: hipFuncSetAttribute failed\n"); grid = -1; return; }
        if (hipOccupancyMaxActiveBlocksPerMultiprocessor(&per_cu, (const void*)enc_fwd, 512, LDS_BYTES) != hipSuccess || per_cu < 1) { fprintf(stderr, "kernel_launch: note: occupancy query says %d blocks/CU\n", per_cu); (void)hipGetLastError(); }
        grid = cus;
    }
    if (grid < 0) return;
    (void)hipMemsetAsync((char*)d_ws + WS_CTL, 0, CTL_BYTES, stream);
    Args a{};
    for (int i = 0; i < 18; ++i) a.in[i] = (const float*)d_in[i];
    a.out = (float*)d_out; a.ws = (unsigned char*)d_ws;
#if MK_ONE_LAUNCH
    a.ph_lo = 0; a.ph_hi = N_PHASES;
    void* kargs[] = {&a};
    hipError_t e = hipLaunchCooperativeKernel((const void*)enc_fwd, dim3(grid), dim3(512), kargs, LDS_BYTES, stream);
    if (e != hipSuccess) fprintf(stderr, "cooperative launch failed: %s (grid %d)\n", hipGetErrorString(e), grid);
#else
    for (int p = 0; p < N_PHASES; ++p) { a.ph_lo = p; a.ph_hi = p + 1; hipLaunchKernelGGL(enc_fwd, dim3(grid), dim3(512), LDS_BYTES, stream, a);
#ifdef PROBE_PH
        if (p == PROBE_PH) for (int r = 0; r < PROBE_REP; ++r) {
#ifdef PROBE_VARIANT
            a.ph_lo = PROBE_VARIANT; a.ph_hi = PROBE_VARIANT + 1;
#endif
            hipLaunchKernelGGL(enc_fwd, dim3(grid), dim3(512), LDS_BYTES, stream, a); }
#endif
    }
#endif
}
```

```cpp
#include <hip/hip_runtime.h>
#include <hip/hip_cooperative_groups.h>
#include <cstdio>
#include <cstdint>
namespace cg = cooperative_groups;

#ifndef MK_ONE_LAUNCH
#define MK_ONE_LAUNCH 1
#endif

#define LAS __attribute__((address_space(3)))
typedef unsigned short bf16_t;
typedef short bf16x8 __attribute__((ext_vector_type(8)));
typedef short s16x4 __attribute__((ext_vector_type(4)));
typedef float f32x4 __attribute__((ext_vector_type(4)));
typedef float f32x2 __attribute__((ext_vector_type(2)));
typedef float f32x16 __attribute__((ext_vector_type(16)));
typedef unsigned u32x4 __attribute__((ext_vector_type(4)));
typedef unsigned u32x2 __attribute__((ext_vector_type(2)));

constexpr int BATCH = 2, SEQ = 8192, TOK = BATCH * SEQ, DM = 1024, NIN = 2048, NE = 32, TOPK = 4, NMEM = 256, DEPTH = 2;
constexpr float EPS = 1e-5f;
constexpr float QSCALE = 0.125f * 1.4426950408889634f;
constexpr int MAXT = 288;
constexpr float W8SCALE = 32.0f;

constexpr size_t MiB = 1u << 20;
constexpr size_t WS_CTL = 0, CTL_BYTES = 64 * 1024;
constexpr size_t WS_COS = 1 * MiB, WS_SIN = 2 * MiB;
constexpr size_t WS_WIN = 4 * MiB;
constexpr size_t WS_WOUT = 12 * MiB;
constexpr size_t WS_WMKV = 16 * MiB;
constexpr size_t WS_MEMKV = 18 * MiB;
constexpr size_t WS_MEMN = 20 * MiB;
constexpr size_t WS_RT = 22 * MiB;
constexpr size_t WS_LSE = 24 * MiB;
constexpr size_t WS_WGU = 32 * MiB;
constexpr size_t WS_WDN = 288 * MiB;
constexpr size_t WS_XN = 416 * MiB;
constexpr size_t WS_PROJ = 448 * MiB;
constexpr size_t WS_AO = 512 * MiB;
constexpr size_t WS_YRAW = 560 * MiB;
constexpr size_t WS_Y = 576 * MiB;
constexpr size_t WS_X1 = 608 * MiB;
constexpr size_t WS_X2 = 672 * MiB;
constexpr size_t WS_H2 = 736 * MiB;
constexpr size_t WS_ASLOT = 768 * MiB;
constexpr size_t WS_ACT = 912 * MiB;
constexpr size_t WS_YS = 1056 * MiB;
constexpr size_t WS_QKVH = 1200 * MiB;
constexpr size_t WS_ELIST = 1248 * MiB;
constexpr size_t WS_END = 1252 * MiB;
constexpr int CW_CNT = 1024;
constexpr int CW_BAR = 4096;
constexpr int CW_W8NEXT = 2048;
constexpr int CW_DONE = 2112;

constexpr int RING_BYTES = 131072, MISC_OFF = RING_BYTES, LDS_BYTES = 147456;

__device__ __forceinline__ unsigned cvtpk(float lo, float hi) { typedef __bf16 bf2 __attribute__((ext_vector_type(2))); f32x2 v = {lo, hi}; bf2 b = __builtin_convertvector(v, bf2); return __builtin_bit_cast(unsigned, b); }
__device__ __forceinline__ float bflo(unsigned u) { return __uint_as_float(u << 16); }
__device__ __forceinline__ float bfhi(unsigned u) { return __uint_as_float(u & 0xffff0000u); }
__device__ __forceinline__ float bf1(bf16_t u) { return __uint_as_float(((unsigned)u) << 16); }
__device__ __forceinline__ bf16_t f2bf(float f) { return (bf16_t)(cvtpk(f, 0.f) & 0xffffu); }
template <int M> __device__ __forceinline__ int swz_i(int v) { constexpr int ctrl = (M == 1) ? 0xB1 : (M == 2) ? 0x4E : (M == 4) ? 0x141 : 0x140; static_assert(M == 1 || M == 2 || M == 4 || M == 8, "dpp step");
    return __builtin_amdgcn_update_dpp(v, v, ctrl, 0xf, 0xf, true); }
template <int M> __device__ __forceinline__ float swz_f(float v) { return __int_as_float(swz_i<M>(__float_as_int(v))); }
__device__ __forceinline__ float xor16_sum(float v) { auto r = __builtin_amdgcn_permlane16_swap(__float_as_uint(v), __float_as_uint(v), false, false); return __uint_as_float(r[0]) + __uint_as_float(r[1]); }
__device__ __forceinline__ float xor32_sum(float v) { auto r = __builtin_amdgcn_permlane32_swap(__float_as_uint(v), __float_as_uint(v), false, false); return __uint_as_float(r[0]) + __uint_as_float(r[1]); }
__device__ __forceinline__ float xor32_max(float v) { auto r = __builtin_amdgcn_permlane32_swap(__float_as_uint(v), __float_as_uint(v), false, false); return fmaxf(__uint_as_float(r[0]), __uint_as_float(r[1])); }
__device__ __forceinline__ float wave_sum(float v) {
    v += swz_f<1>(v); v += swz_f<2>(v); v += swz_f<4>(v); v += swz_f<8>(v);
    return xor32_sum(xor16_sum(v));
}
#define LDS_WAIT() asm volatile("s_waitcnt lgkmcnt(0)" ::: "memory")

namespace pg8 {
typedef int i32x4_t __attribute__((ext_vector_type(4)));
typedef int i32x8_t __attribute__((ext_vector_type(8)));
constexpr int BM = 256, BK = 64, HALF = 128, HTB = HALF * BK * 2, STAGE_BYTES = 8 * HTB, NXCD = 8, WGM = 8;
__host__ __device__ __forceinline__ int lds_byte(int r, int c) { const int st = (r >> 4) * 2 + (c >> 5), rr = r & 15, cc = c & 31, ob = rr * 64 + cc * 2; return st * 1024 + (ob ^ (((ob >> 9) & 1) << 5)); }
__host__ __device__ __forceinline__ void stage_rc(int b, int& R, int& C) { const int st = b / 1024, sb = b % 1024, swz = sb ^ (((sb >> 9) & 1) << 5); R = (st >> 1) * 16 + swz / 64; C = (st & 1) * 32 + (swz % 64) / 2; }
__host__ __device__ __forceinline__ int perm32(int rho) { const int n = rho >> 4, i = rho & 15; return 8 * (i >> 2) + 4 * n + (i & 3); }

struct Unit { int pm, pn, e; };
struct Gemm { const bf16_t* A; const bf16_t* Bt; int K; size_t ebytes; const LAS int* gtok; };

struct StaticOrder {
    int nM, nN, nwg, G, c;
    __device__ void init(int M, int N, int G_, int c_) { nM = M / BM; nN = N / BM; nwg = nM * nN; G = G_; c = c_; }
    __device__ bool next(int i, Unit& u) const {
        const long L = (long)i * G + c; if (L >= nwg) return false;
        int wgid = (int)L; { const int q = nwg / NXCD, r = nwg % NXCD, xcd = wgid % NXCD, off = wgid / NXCD; wgid = (xcd < r ? xcd * (q + 1) : r * (q + 1) + (xcd - r) * q) + off; }
        const int nig = WGM * nN, gid = wgid / nig, fm = gid * WGM, gsz = (nM - fm) < WGM ? (nM - fm) : WGM;
        u.pm = fm + ((wgid % nig) % gsz); u.pn = (wgid % nig) / gsz; u.e = 0; return true;
    }
};
struct MoeOrder {
    const LAS int* tstart; int nN, GM, G, c;
    __device__ bool next(int i, Unit& u) const {
        const int total = tstart[32] * nN; const long L = (long)i * G + c; if (L >= total) return false;
        const int pmL = (int)L / nN; int e = 0;
#pragma unroll
        for (int k = 1; k < 32; ++k) e += (tstart[k] <= pmL) ? 1 : 0;
        const int t0 = tstart[e], mt = tstart[e + 1] - t0, w = (int)L - t0 * nN;
        const int grp = w / (GM * nN), wg = w - grp * GM * nN, rem = mt - grp * GM, gsz = rem < GM ? rem : GM;
        u.pm = __builtin_amdgcn_readfirstlane(t0 + grp * GM + wg % gsz); u.pn = __builtin_amdgcn_readfirstlane(wg / gsz); u.e = __builtin_amdgcn_readfirstlane(e); return true;
    }
};


__device__ __forceinline__ u32x4 pair16(u32x2 a, u32x2 b) {
    const auto rx = __builtin_amdgcn_permlane16_swap(a.x, b.x, false, false); const auto ry = __builtin_amdgcn_permlane16_swap(a.y, b.y, false, false);
    return (u32x4){rx[0], ry[0], rx[1], ry[1]};
}
struct EpiProj {
    static constexpr bool PERM = true, AFTER_DRAIN = false;
    bf16_t* O; const float* cs; const float* sn; bf16_t* QH;
    __device__ __forceinline__ void operator()(const f32x4 (&acc)[2][2][4][2], const Unit& u, int wr, int wc, int fr, int fq) const {
        const int row0 = u.pm * BM + wr * 64 + fr, colb = u.pn * BM + wc * 32 + 8 * fq;
        if (u.pn < 4) {
            const float sc = (u.pn < 2) ? QSCALE : 1.f;
#pragma unroll
            for (int ai = 0; ai < 2; ++ai) {
                f32x4 cv[4][2], sv[4][2];
#pragma unroll
                for (int m = 0; m < 4; ++m) { const int pos = (row0 + ai * HALF + m * 16) & (SEQ - 1);
#pragma unroll
                    for (int bj = 0; bj < 2; ++bj) { const int g8 = ((colb + bj * HALF) & 63) >> 3; cv[m][bj] = *(const f32x4*)(cs + pos * 32 + g8 * 4); sv[m][bj] = *(const f32x4*)(sn + pos * 32 + g8 * 4); } }
#pragma unroll
                for (int mp = 0; mp < 2; ++mp)
#pragma unroll
                    for (int bj = 0; bj < 2; ++bj) { const int col = colb + bj * HALF, head = col >> 6, g8 = (col & 63) >> 3;
                        u32x2 w1[2], w2[2];
#pragma unroll
                        for (int q = 0; q < 2; ++q) { const int m = 2 * mp + q; const f32x4 c = cv[m][bj], s = sv[m][bj];
                            const f32x4 t1 = acc[ai][bj][m][0], t2 = acc[ai][bj][m][1];
                            const f32x4 o1 = (t1 * c - t2 * s) * sc, o2 = (t1 * s + t2 * c) * sc;
                            w1[q].x = cvtpk(o1[0], o1[1]); w1[q].y = cvtpk(o1[2], o1[3]); w2[q].x = cvtpk(o2[0], o2[1]); w2[q].y = cvtpk(o2[2], o2[3]); }
                        const int msel = 2 * mp + (fq & 1), row = row0 + ai * HALF + msel * 16, pos = row & (SEQ - 1);
                        bf16_t* p = QH + ((size_t)((((head >> 3) * 2 + (row >> 13)) * 8 + (head & 7))) * SEQ + pos) * 64 + (g8 & ~1) * 4;
                        *(u32x4*)p = pair16(w1[0], w1[1]); *(u32x4*)(p + 32) = pair16(w2[0], w2[1]); }
                asm volatile("" ::: "memory");
            }
        } else if (u.pn < 6) {
#pragma unroll
            for (int ai = 0; ai < 2; ++ai)
#pragma unroll
                for (int m = 0; m < 4; ++m) { const int row = row0 + ai * HALF + m * 16;
#pragma unroll
                    for (int bj = 0; bj < 2; ++bj) { const int col = colb + bj * HALF - 1024, hh = col >> 6; const f32x4 v0 = acc[ai][bj][m][0], v1 = acc[ai][bj][m][1];
                        u32x4 w; w.x = cvtpk(v0[0], v0[1]); w.y = cvtpk(v0[2], v0[3]); w.z = cvtpk(v1[0], v1[1]); w.w = cvtpk(v1[2], v1[3]);
                        *(u32x4*)(QH + ((size_t)(((4 + (row >> 13)) * 8 + hh)) * SEQ + (row & (SEQ - 1))) * 64 + (col & 63)) = w; } }
        } else {
            const float sc = (u.pn == 7) ? QSCALE : 1.f;
#pragma unroll
            for (int ai = 0; ai < 2; ++ai)
#pragma unroll
                for (int m = 0; m < 4; ++m) { bf16_t* rowp = O + (size_t)(row0 + ai * HALF + m * 16) * NIN + colb;
#pragma unroll
                    for (int bj = 0; bj < 2; ++bj) { const f32x4 v0 = acc[ai][bj][m][0] * sc, v1 = acc[ai][bj][m][1] * sc;
                        u32x4 w; w.x = cvtpk(v0[0], v0[1]); w.y = cvtpk(v0[2], v0[3]); w.z = cvtpk(v1[0], v1[1]); w.w = cvtpk(v1[2], v1[3]);
                        *(u32x4*)(rowp + bj * HALF) = w; } }
        }
    }
};
struct EpiBf16 {
    static constexpr bool PERM = true, AFTER_DRAIN = false;
    bf16_t* O; int ldc; const float* bias; int bias_estride; float scale;
    __device__ __forceinline__ void operator()(const f32x4 (&acc)[2][2][4][2], const Unit& u, int wr, int wc, int fr, int fq) const {
        const int row0 = u.pm * BM + wr * 64 + fr, col0 = u.pn * BM + wc * 32 + 8 * fq;
        f32x4 bv[2][2];
#pragma unroll
        for (int bj = 0; bj < 2; ++bj)
#pragma unroll
            for (int n = 0; n < 2; ++n) bv[bj][n] = bias ? *(const f32x4*)(bias + (size_t)u.e * bias_estride + col0 + bj * HALF + 4 * n) : (f32x4){0.f, 0.f, 0.f, 0.f};
#pragma unroll
        for (int ai = 0; ai < 2; ++ai)
#pragma unroll
            for (int m = 0; m < 4; ++m) { bf16_t* rowp = O + (size_t)(row0 + ai * HALF + m * 16) * ldc + col0;
#pragma unroll
                for (int bj = 0; bj < 2; ++bj) { const f32x4 v0 = acc[ai][bj][m][0] * scale + bv[bj][0], v1 = acc[ai][bj][m][1] * scale + bv[bj][1];
                    u32x4 w; w.x = cvtpk(v0[0], v0[1]); w.y = cvtpk(v0[2], v0[3]); w.z = cvtpk(v1[0], v1[1]); w.w = cvtpk(v1[2], v1[3]);
                    *(u32x4*)(rowp + bj * HALF) = w; } }
    }
};
struct EpiF8 {
    static constexpr bool PERM = true, AFTER_DRAIN = false;
    unsigned char* O; int ldc; const float* bias; int bias_estride; float scale;
    __device__ __forceinline__ void operator()(const f32x4 (&acc)[2][2][4][2], const Unit& u, int wr, int wc, int fr, int fq) const {
        const int row0 = u.pm * BM + wr * 64 + fr, col0 = u.pn * BM + wc * 32 + 8 * fq;
        f32x4 bv[2][2];
#pragma unroll
        for (int bj = 0; bj < 2; ++bj)
#pragma unroll
            for (int n = 0; n < 2; ++n) bv[bj][n] = *(const f32x4*)(bias + (size_t)u.e * bias_estride + col0 + bj * HALF + 4 * n);
#pragma unroll
        for (int ai = 0; ai < 2; ++ai)
#pragma unroll
            for (int mp = 0; mp < 2; ++mp)
#pragma unroll
                for (int bj = 0; bj < 2; ++bj) { u32x2 w[2];
#pragma unroll
                    for (int q = 0; q < 2; ++q) { const int m = 2 * mp + q; const f32x4 v0 = acc[ai][bj][m][0] * scale + bv[bj][0], v1 = acc[ai][bj][m][1] * scale + bv[bj][1];
                        int w0 = 0, w1 = 0; w0 = __builtin_amdgcn_cvt_pk_fp8_f32(v0[0], v0[1], w0, false); w0 = __builtin_amdgcn_cvt_pk_fp8_f32(v0[2], v0[3], w0, true);
                        w1 = __builtin_amdgcn_cvt_pk_fp8_f32(v1[0], v1[1], w1, false); w1 = __builtin_amdgcn_cvt_pk_fp8_f32(v1[2], v1[3], w1, true);
                        w[q].x = (unsigned)w0; w[q].y = (unsigned)w1; }
                    const int msel = 2 * mp + (fq & 1);
                    *(u32x4*)(O + (size_t)(row0 + ai * HALF + msel * 16) * ldc + u.pn * BM + wc * 32 + 8 * (fq & ~1) + bj * HALF) = pair16(w[0], w[1]); }
    }
};
struct EpiSwiglu {
    static constexpr bool PERM = true, AFTER_DRAIN = false;
    unsigned char* O; const float* bias; float scale;
    __device__ __forceinline__ static float act1(float g, float up) {
        g = fminf(g, 7.0f); up = fminf(fmaxf(up, -7.0f), 7.0f);
        const float sg = __builtin_amdgcn_rcpf(1.0f + __builtin_amdgcn_exp2f(g * (-1.702f * 1.4426950408889634f)));
        return (up + 1.0f) * g * sg;
    }
    __device__ __forceinline__ static f32x2 act2(f32x2 g, f32x2 up) {
        g.x = fminf(g.x, 7.0f); g.y = fminf(g.y, 7.0f); up.x = fminf(fmaxf(up.x, -7.0f), 7.0f); up.y = fminf(fmaxf(up.y, -7.0f), 7.0f);
        const f32x2 z = g * (-1.702f * 1.4426950408889634f); f32x2 e; e.x = __builtin_amdgcn_exp2f(z.x); e.y = __builtin_amdgcn_exp2f(z.y);
        const f32x2 d = e + 1.0f; f32x2 r; r.x = __builtin_amdgcn_rcpf(d.x); r.y = __builtin_amdgcn_rcpf(d.y);
        return (up + 1.0f) * g * r;
    }
    __device__ __forceinline__ void operator()(const f32x4 (&acc)[2][2][4][2], const Unit& u, int wr, int wc, int fr, int fq) const {
        const int row0 = u.pm * BM + wr * 64 + fr, j0 = u.pn * HALF + wc * 32 + 8 * fq;
        const float* bg = bias + (size_t)u.e * 2048 + j0; const float* bu = bg + 1024;
        const f32x4 bg0 = *(const f32x4*)bg, bg1 = *(const f32x4*)(bg + 4), bu0 = *(const f32x4*)bu, bu1 = *(const f32x4*)(bu + 4);
#pragma unroll
        for (int ai = 0; ai < 2; ++ai)
#pragma unroll
            for (int mp = 0; mp < 2; ++mp) { u32x2 w[2];
#pragma unroll
                for (int q = 0; q < 2; ++q) { const int m = 2 * mp + q;
                    const f32x4 g0 = acc[ai][0][m][0] * scale + bg0, g1 = acc[ai][0][m][1] * scale + bg1, u0 = acc[ai][1][m][0] * scale + bu0, u1 = acc[ai][1][m][1] * scale + bu1;
                    int w0 = 0, w1 = 0;
                    const f32x2 a0 = act2((f32x2){g0[0], g0[1]}, (f32x2){u0[0], u0[1]}), a1 = act2((f32x2){g0[2], g0[3]}, (f32x2){u0[2], u0[3]}), a2 = act2((f32x2){g1[0], g1[1]}, (f32x2){u1[0], u1[1]}), a3 = act2((f32x2){g1[2], g1[3]}, (f32x2){u1[2], u1[3]});
                    w0 = __builtin_amdgcn_cvt_pk_fp8_f32(a0.x, a0.y, w0, false); w0 = __builtin_amdgcn_cvt_pk_fp8_f32(a1.x, a1.y, w0, true);
                    w1 = __builtin_amdgcn_cvt_pk_fp8_f32(a2.x, a2.y, w1, false); w1 = __builtin_amdgcn_cvt_pk_fp8_f32(a3.x, a3.y, w1, true);
                    w[q].x = (unsigned)w0; w[q].y = (unsigned)w1; }
                const int msel = 2 * mp + (fq & 1);
                *(u32x4*)(O + (size_t)(row0 + ai * HALF + msel * 16) * DM + u.pn * HALF + wc * 32 + 8 * (fq & ~1)) = pair16(w[0], w[1]); }
    }
};
template <bool BASE_BF16>
struct EpiRes {
    static constexpr bool PERM = true, AFTER_DRAIN = false;
    const void* base; bf16_t* out;
    __device__ __forceinline__ void operator()(const f32x4 (&acc)[2][2][4][2], const Unit& u, int wr, int wc, int fr, int fq) const {
        const int row0 = u.pm * BM + wr * 64 + fr, col0 = u.pn * BM + wc * 32 + 8 * fq;
#pragma unroll
        for (int ai = 0; ai < 2; ++ai) {
            f32x4 bs[4][2][2];
#pragma unroll
            for (int m = 0; m < 4; ++m) { const size_t off = (size_t)(row0 + ai * HALF + m * 16) * DM + col0;
#pragma unroll
                for (int bj = 0; bj < 2; ++bj) {
                    if constexpr (BASE_BF16) { const u32x4 r = __builtin_nontemporal_load((const u32x4*)((const bf16_t*)base + off + bj * HALF));
                        bs[m][bj][0] = (f32x4){bflo(r.x), bfhi(r.x), bflo(r.y), bfhi(r.y)}; bs[m][bj][1] = (f32x4){bflo(r.z), bfhi(r.z), bflo(r.w), bfhi(r.w)}; }
                    else { bs[m][bj][0] = __builtin_nontemporal_load((const f32x4*)((const float*)base + off + bj * HALF)); bs[m][bj][1] = __builtin_nontemporal_load((const f32x4*)((const float*)base + off + bj * HALF + 4)); } } }
#pragma unroll
            for (int m = 0; m < 4; ++m) { const size_t off = (size_t)(row0 + ai * HALF + m * 16) * DM + col0;
#pragma unroll
                for (int bj = 0; bj < 2; ++bj) { const f32x4 v0 = bs[m][bj][0] + acc[ai][bj][m][0], v1 = bs[m][bj][1] + acc[ai][bj][m][1];
                    u32x4 w; w.x = cvtpk(v0[0], v0[1]); w.y = cvtpk(v0[2], v0[3]); w.z = cvtpk(v1[0], v1[1]); w.w = cvtpk(v1[2], v1[3]);
                    *(u32x4*)(out + off + bj * HALF) = w; } }
            asm volatile("" ::: "memory");
        }
    }
};

template <class Epi, class Sched, bool ALIGN_EPI = false, bool SP2 = true, bool FP8 = false, bool GATHER = false>
__device__ __forceinline__ void gemm_phase(LAS unsigned char* lds, const int tid, const Gemm g, const Sched& S, const Epi& E) {
    const int wid = __builtin_amdgcn_readfirstlane(tid >> 6), lane = tid & 63, wr = wid >> 2, wc = wid & 3, fr = lane & 15, fq = lane >> 4;
    const int K = g.K, rowb = FP8 ? K : 2 * K, nt = rowb / 128;
    unsigned voffA[2], voffB[2];
#pragma unroll
    for (int i = 0; i < 2; ++i) { int R, C; stage_rc(tid * 16 + i * 8192, R, C); const int Rb = Epi::PERM ? ((R & ~31) + perm32(R & 31)) : R;
        voffA[i] = (unsigned)(R * rowb + C * 2); voffB[i] = (unsigned)(Rb * rowb + C * 2); }
    const size_t kstep = (size_t)(BK * 2);
    const size_t hstep = (size_t)HALF * rowb;
    const size_t tstep = 2 * hstep;
    const unsigned ldsw = (unsigned)wid * 1024u;
    const int aoff = lds_byte(wr * 64 + fr, fq * 8), boff = lds_byte(wc * 32 + fr, fq * 8);
#define PG8_SA(b, h) (((b) * 2 + (h)) * HTB)
#define PG8_SB(b, h) ((4 + (b) * 2 + (h)) * HTB)
#define PG8_STAGE(bufoff, gbase, voff) do { _Pragma("unroll") for (int _i = 0; _i < 2; ++_i) \
        __builtin_amdgcn_global_load_lds((const unsigned*)((const char*)(gbase) + (voff)[_i]), (LAS unsigned*)(lds + (bufoff) + ldsw + _i * 8192), 16, 0, 0); } while (0)
#define PG8_STAGE_A(bufoff, gbase, h, nx) do { if constexpr (GATHER) { unsigned vo_[2]; vo_[0] = (nx) ? gAn[h][0] : gAc[h][0]; vo_[1] = (nx) ? gAn[h][1] : gAc[h][1]; PG8_STAGE(bufoff, gbase, vo_); } \
        else PG8_STAGE(bufoff, (gbase) + (h) * hstep, voffA); } while (0)
#define PG8_LDA(dst, b, h) do { if constexpr (FP8) { _Pragma("unroll") for (int m = 0; m < 4; ++m) { const i32x4_t lo_ = *(const LAS i32x4_t*)(lds + PG8_SA(b, h) + aoff + m * 2048), hi_ = *(const LAS i32x4_t*)(lds + PG8_SA(b, h) + aoff + m * 2048 + 1024); \
            dst##8[m] = __builtin_shufflevector(lo_, hi_, 0, 1, 2, 3, 4, 5, 6, 7); } } \
        else { _Pragma("unroll") for (int m = 0; m < 4; ++m) _Pragma("unroll") for (int k = 0; k < 2; ++k) dst[m][k] = *(const LAS bf16x8*)(lds + PG8_SA(b, h) + aoff + m * 2048 + k * 1024); } } while (0)
#define PG8_LDB(dst, b, h) do { if constexpr (FP8) { _Pragma("unroll") for (int n = 0; n < 2; ++n) { const i32x4_t lo_ = *(const LAS i32x4_t*)(lds + PG8_SB(b, h) + boff + n * 2048), hi_ = *(const LAS i32x4_t*)(lds + PG8_SB(b, h) + boff + n * 2048 + 1024); \
            dst##8[n] = __builtin_shufflevector(lo_, hi_, 0, 1, 2, 3, 4, 5, 6, 7); } } \
        else { _Pragma("unroll") for (int n = 0; n < 2; ++n) _Pragma("unroll") for (int k = 0; k < 2; ++k) dst[n][k] = *(const LAS bf16x8*)(lds + PG8_SB(b, h) + boff + n * 2048 + k * 1024); } } while (0)
#define PG8_MMA(ai, bj, At, Bt) do { __builtin_amdgcn_s_setprio(1); \
        if constexpr (FP8) { _Pragma("unroll") for (int m = 0; m < 4; ++m) _Pragma("unroll") for (int n = 0; n < 2; ++n) \
            asm volatile("v_mfma_scale_f32_16x16x128_f8f6f4 %0, %1, %2, %0, %3, %3 op_sel_hi:[0,0,0]" : "+v"(acc[ai][bj][m][n]) : "v"(Bt##8[n]), "v"(At##8[m]), "v"(0x7f7f7f7f)); } \
        else { _Pragma("unroll") for (int m = 0; m < 4; ++m) _Pragma("unroll") for (int n = 0; n < 2; ++n) _Pragma("unroll") for (int k = 0; k < 2; ++k) \
            acc[ai][bj][m][n] = __builtin_amdgcn_mfma_f32_16x16x32_bf16(Bt[n][k], At[m][k], acc[ai][bj][m][n], 0, 0, 0); } \
        __builtin_amdgcn_s_setprio(0); } while (0)
#define PG8_WAIT_V(n) asm volatile("s_waitcnt vmcnt(" #n ")" ::: "memory")
#define PG8_WAIT_L(n) asm volatile("s_waitcnt lgkmcnt(" #n ")" ::: "memory")
#define PG8_BAR __builtin_amdgcn_s_barrier()
#define PG8_SCHED __builtin_amdgcn_sched_barrier(0)
#define PG8_UA(u) (GATHER ? (const char*)g.A : (const char*)g.A + (size_t)(u).pm * tstep)
    unsigned gAc[2][2], gAn[2][2];
#define PG8_GLOAD(dst, ui_) do { if constexpr (GATHER) { _Pragma("unroll") for (int h = 0; h < 2; ++h) _Pragma("unroll") for (int i = 0; i < 2; ++i) { int R, C; stage_rc(tid * 16 + i * 8192, R, C); \
            dst[h][i] = (unsigned)(g.gtok[(ui_) * 256 + h * HALF + R] * rowb + C * 2); } } } while (0)
#define PG8_UB(u) ((const char*)g.Bt + (size_t)(u).e * g.ebytes + (size_t)(u).pn * tstep)
    Unit cur, nxt; int ui = 0;
    if (!S.next(0, cur)) return;
    f32x4 acc[2][2][4][2];
#pragma unroll
    for (int a = 0; a < 2; ++a)
#pragma unroll
        for (int b = 0; b < 2; ++b)
#pragma unroll
            for (int m = 0; m < 4; ++m)
#pragma unroll
                for (int n = 0; n < 2; ++n) acc[a][b][m][n] = (f32x4){0.f, 0.f, 0.f, 0.f};
    bf16x8 At[4][2], B0[2][2], B1[2][2]; i32x8_t At8[4], B08[2], B18[2];
    const char* cA = PG8_UA(cur); const char* cB = PG8_UB(cur);
    PG8_GLOAD(gAc, 0);
    if constexpr (SP2) {
        PG8_STAGE(PG8_SB(0, 0), cB, voffB); PG8_STAGE(PG8_SB(0, 1), cB + hstep, voffB); PG8_STAGE_A(PG8_SA(0, 0), cA, 0, false); PG8_STAGE_A(PG8_SA(0, 1), cA, 1, false);
        if (wr == 1) PG8_BAR;
        PG8_WAIT_V(2); PG8_BAR;
        PG8_STAGE(PG8_SB(1, 0), cB + kstep, voffB); PG8_STAGE_A(PG8_SA(1, 0), cA + kstep, 0, false); PG8_STAGE(PG8_SB(1, 1), cB + hstep + kstep, voffB);
        PG8_WAIT_V(6); PG8_BAR;
    } else {
        PG8_STAGE(PG8_SB(0, 0), cB, voffB); PG8_STAGE_A(PG8_SA(0, 0), cA, 0, false); PG8_STAGE(PG8_SB(0, 1), cB + hstep, voffB); PG8_STAGE_A(PG8_SA(0, 1), cA, 1, false);
        if (wr == 1) PG8_BAR;
        PG8_WAIT_V(4); PG8_BAR;
        PG8_STAGE(PG8_SB(1, 0), cB + kstep, voffB); PG8_STAGE_A(PG8_SA(1, 0), cA + kstep, 0, false); PG8_STAGE(PG8_SB(1, 1), cB + hstep + kstep, voffB);
        PG8_WAIT_V(6); PG8_BAR;
    }
    for (;;) {
        const bool has_next = S.next(ui + 1, nxt);
        if constexpr (GATHER) { if (has_next) PG8_GLOAD(gAn, ui + 1); else { gAn[0][0] = gAc[0][0]; gAn[0][1] = gAc[0][1]; gAn[1][0] = gAc[1][0]; gAn[1][1] = gAc[1][1]; } }
        const char* nA = has_next ? PG8_UA(nxt) : cA; const char* nB = has_next ? PG8_UB(nxt) : cB;
#pragma unroll 1
        for (int t = 0; t < nt; t += 2) {
            const bool last = (t == nt - 2);
            const char* a1 = cA + (size_t)(t + 1) * kstep;
            const char* a2 = last ? nA : cA + (size_t)(t + 2) * kstep; const char* b2 = last ? nB : cB + (size_t)(t + 2) * kstep;
            const char* a3 = a2 + kstep; const char* b3 = b2 + kstep;
            if constexpr (SP2) {
            PG8_LDB(B0, 0, 0); PG8_LDB(B1, 0, 1); PG8_SCHED; PG8_LDA(At, 0, 0); PG8_STAGE_A(PG8_SA(1, 1), a1, 1, false);
            PG8_WAIT_V(8); PG8_WAIT_L(0); PG8_BAR; PG8_MMA(0, 0, At, B0); PG8_MMA(0, 1, At, B1); PG8_BAR; PG8_SCHED;
            PG8_LDA(At, 0, 1); PG8_STAGE(PG8_SB(0, 0), b2, voffB); PG8_STAGE(PG8_SB(0, 1), b2 + hstep, voffB); PG8_STAGE_A(PG8_SA(0, 0), a2, 0, last);
            PG8_WAIT_V(8); PG8_WAIT_L(0); PG8_BAR; PG8_MMA(1, 0, At, B0); PG8_MMA(1, 1, At, B1); PG8_BAR; PG8_SCHED;
            PG8_LDB(B0, 1, 0); PG8_LDB(B1, 1, 1); PG8_SCHED; PG8_LDA(At, 1, 0); PG8_STAGE_A(PG8_SA(0, 1), a2, 1, last);
            PG8_WAIT_V(8); PG8_WAIT_L(0); PG8_BAR; PG8_MMA(0, 0, At, B0); PG8_MMA(0, 1, At, B1); PG8_BAR; PG8_SCHED;
            PG8_LDA(At, 1, 1); PG8_STAGE(PG8_SB(1, 0), b3, voffB); PG8_STAGE(PG8_SB(1, 1), b3 + hstep, voffB); PG8_STAGE_A(PG8_SA(1, 0), a3, 0, last);
            PG8_WAIT_V(8); PG8_WAIT_L(0); PG8_BAR; PG8_MMA(1, 0, At, B0); PG8_MMA(1, 1, At, B1); PG8_BAR; PG8_SCHED;
            } else {
            PG8_LDB(B0, 0, 0); PG8_SCHED; PG8_LDA(At, 0, 0); PG8_STAGE_A(PG8_SA(1, 1), a1, 1, false);
            PG8_WAIT_L(8); PG8_BAR; PG8_WAIT_L(0); PG8_MMA(0, 0, At, B0); PG8_BAR; PG8_SCHED;
            PG8_LDB(B1, 0, 1); PG8_STAGE(PG8_SB(0, 0), b2, voffB);
            PG8_BAR; PG8_WAIT_L(0); PG8_MMA(0, 1, At, B1); PG8_BAR;
            PG8_LDA(At, 0, 1); PG8_STAGE_A(PG8_SA(0, 0), a2, 0, last);
            PG8_BAR; PG8_WAIT_L(0); PG8_MMA(1, 0, At, B0); PG8_BAR; PG8_SCHED;
            PG8_STAGE(PG8_SB(0, 1), b2 + hstep, voffB);
            PG8_WAIT_V(6); PG8_BAR; PG8_MMA(1, 1, At, B1); PG8_BAR;
            PG8_LDB(B0, 1, 0); PG8_SCHED; PG8_LDA(At, 1, 0); PG8_STAGE_A(PG8_SA(0, 1), a2, 1, last);
            PG8_WAIT_L(8); PG8_BAR; PG8_WAIT_L(0); PG8_MMA(0, 0, At, B0); PG8_BAR; PG8_SCHED;
            PG8_LDB(B1, 1, 1); PG8_STAGE(PG8_SB(1, 0), b3, voffB);
            PG8_BAR; PG8_WAIT_L(0); PG8_MMA(0, 1, At, B1); PG8_BAR;
            PG8_LDA(At, 1, 1); PG8_STAGE_A(PG8_SA(1, 0), a3, 0, last);
            PG8_BAR; PG8_WAIT_L(0); PG8_MMA(1, 0, At, B0); PG8_BAR; PG8_SCHED;
            PG8_STAGE(PG8_SB(1, 1), b3 + hstep, voffB);
            PG8_WAIT_V(6); PG8_BAR; PG8_MMA(1, 1, At, B1); PG8_BAR;
            }
        }
        if constexpr (ALIGN_EPI) { if (wr == 0) PG8_BAR; }
        if constexpr (FP8) asm volatile("s_nop 15\n\ts_nop 15" ::: "memory");
        E(acc, cur, wr, wc, fr, fq);
        if (!has_next) break;
#pragma unroll
        for (int a = 0; a < 2; ++a)
#pragma unroll
            for (int b = 0; b < 2; ++b)
#pragma unroll
                for (int m = 0; m < 4; ++m)
#pragma unroll
                    for (int n = 0; n < 2; ++n) acc[a][b][m][n] = (f32x4){0.f, 0.f, 0.f, 0.f};
        cur = nxt; cA = nA; cB = nB; ++ui;
        if constexpr (GATHER) { gAc[0][0] = gAn[0][0]; gAc[0][1] = gAn[0][1]; gAc[1][0] = gAn[1][0]; gAc[1][1] = gAn[1][1]; }
        if constexpr (ALIGN_EPI) { if (wr == 1) PG8_BAR; }
    }
    PG8_WAIT_V(0);
    if constexpr (!ALIGN_EPI) { if (wr == 0) PG8_BAR; }
    PG8_BAR;
#undef PG8_SA
#undef PG8_SB
#undef PG8_STAGE
#undef PG8_STAGE_A
#undef PG8_GLOAD
#undef PG8_LDA
#undef PG8_LDB
#undef PG8_MMA
#undef PG8_WAIT_V
#undef PG8_WAIT_L
#undef PG8_BAR
#undef PG8_SCHED
#undef PG8_UA
#undef PG8_UB
}
}


#define XB_TMO      128
#define XB_XCNT(j)  (256  + 64 * (j))
#define XB_XSUB(j)  (1280 + 64 * (j))
#define XB_XGEN(j)  (2304 + 64 * (j))
#define XB_TOP      3328
#define XB_TOPGEN   3392
#define XCD_BAR_WORDS 3456
#define XB_SPIN_CAP (1u << 18)
__device__ __forceinline__ unsigned xb_ld(unsigned* p)              { return __hip_atomic_load(p, __ATOMIC_RELAXED, __HIP_MEMORY_SCOPE_AGENT); }
__device__ __forceinline__ unsigned xb_add(unsigned* p, unsigned v) { return __hip_atomic_fetch_add(p, v, __ATOMIC_RELAXED, __HIP_MEMORY_SCOPE_AGENT); }
__device__ __forceinline__ unsigned xb_xcc_id() { return (unsigned)__builtin_amdgcn_s_getreg((3 << 11) | 20) & 0xFu; }
#define XB_SPIN(cond, bar) do { unsigned _sp = 0; while (cond) { __builtin_amdgcn_s_sleep(1); \
    if ((++_sp & 255u) == 0u) { if (xb_ld(&(bar)[XB_TMO])) break; if (_sp > XB_SPIN_CAP) { atomicAdd(&(bar)[XB_TMO], 1u); break; } } } } while (0)
struct XcdBarrier { unsigned* bar; unsigned x; volatile LAS unsigned* st; };
__device__ __forceinline__ XcdBarrier xcd_barrier_post(unsigned* bar, volatile LAS unsigned* st, int tid) {
    XcdBarrier b; b.bar = bar; b.x = xb_xcc_id(); b.st = st;
    if (tid == 0) (void)xb_add(&bar[XB_XCNT(b.x)], 1u);
    return b;
}
__device__ __forceinline__ void xcd_barrier_complete(unsigned* bar, unsigned x, unsigned& nloc, unsigned& nx) {
    const unsigned G = gridDim.x * gridDim.y * gridDim.z;
    unsigned sum, cnt, mine, sp = 0u;
    for (;;) {
        sum = 0u; cnt = 0u; mine = 0u;
#pragma unroll
        for (unsigned j = 0; j < 16; ++j) { const unsigned c = xb_ld(&bar[XB_XCNT(j)]); sum += c; cnt += (c > 0u) ? 1u : 0u; mine = (j == x) ? c : mine; }
        if (sum == G) break;
        __builtin_amdgcn_s_sleep(1);
        if ((++sp & 255u) == 0u) { if (xb_ld(&bar[XB_TMO])) break; if (sp > XB_SPIN_CAP) { atomicAdd(&bar[XB_TMO], 1u); break; } }
    }
    nloc = mine > 0u ? mine : 1u; nx = cnt > 0u ? cnt : 1u;
}
__device__ __forceinline__ void xcd_barrier(const XcdBarrier& b, int tid) {
    asm volatile("s_waitcnt vmcnt(0)" ::: "memory");
    __syncthreads();
    if (tid == 0) {
        unsigned* bar = b.bar;
        __builtin_amdgcn_s_waitcnt(0);
        unsigned nloc = b.st[0], nx = b.st[1];
        if (nloc == 0u) { xcd_barrier_complete(bar, b.x, nloc, nx); b.st[0] = nloc; b.st[1] = nx; }
        const unsigned old = xb_add(&bar[XB_XSUB(b.x)], 1u);
        const unsigned gen = old / nloc;
        if (old + 1u == (gen + 1u) * nloc) {
            __builtin_amdgcn_fence(__ATOMIC_RELEASE, "agent");
            asm volatile("s_waitcnt vmcnt(0)" ::: "memory");
            const unsigned og = xb_add(&bar[XB_TOP], 1u);
            const unsigned tg = og / nx;
            if (og + 1u == (tg + 1u) * nx) xb_add(&bar[XB_TOPGEN], 1u);
            else XB_SPIN(xb_ld(&bar[XB_TOPGEN]) == tg, bar);
            __builtin_amdgcn_fence(__ATOMIC_ACQUIRE, "agent");
            xb_add(&bar[XB_XGEN(b.x)], 1u);
            asm volatile("s_waitcnt vmcnt(0)" ::: "memory");
        } else {
            XB_SPIN(xb_ld(&bar[XB_XGEN(b.x)]) == gen, bar);
            __builtin_amdgcn_fence(__ATOMIC_ACQUIRE, "agent");
            asm volatile("s_waitcnt vmcnt(0)" ::: "memory");
        }
    }
    __syncthreads();
}

struct Args { const float* in[18]; float* out; unsigned char* ws; int ph_lo, ph_hi; };
enum { IN_X = 0, IN_MEM, IN_N1G, IN_WIN, IN_POOLW, IN_POOLS, IN_MEMNG, IN_WMKV, IN_GRPG, IN_WOUT, IN_N2G, IN_RW, IN_RB, IN_WGU, IN_BGU, IN_WDN, IN_BDN, IN_FING };

#define GAS __attribute__((address_space(1)))
#define CAS __attribute__((address_space(4)))
struct Frame {
    LAS unsigned char* lds; int tid, lane, wave, G, bid;
    const CAS unsigned char* kp;
    __device__ __forceinline__ const float* in(int i) const { return (const float*)*(GAS const float* const CAS*)(kp + 8 * i); }
    __device__ __forceinline__ float* out() const { return (float*)*(GAS float* const CAS*)(kp + 144); }
    __device__ __forceinline__ unsigned char* ws() const { return (unsigned char*)*(GAS unsigned char* const CAS*)(kp + 152); }
};

template <int MODE> __device__ __forceinline__ int perm_col(int c) {
    if (MODE == 1) { if (c >= 1024) return c; const int head = c >> 6, d = c & 63, g8 = (d & 31) >> 2, i = (d & 3) + ((d >> 5) << 2); return (head << 6) + (g8 << 3) + i; }
    if (MODE == 2) { const int up = c >> 10, cc = c & 1023; return ((cc >> 7) << 8) + (up << 7) + (cc & 127); }
    return c;
}
struct TItem { const float* W; bf16_t* WT; int N, mode, k0, n0; };
__device__ __forceinline__ int perm_col_rt(int mode, int c) { return mode == 1 ? perm_col<1>(c) : (mode == 2 ? perm_col<2>(c) : c); }
__device__ __forceinline__ void titem_load(const TItem& I, float (&tmp)[32], int lane) {
#pragma unroll
    for (int i = 0; i < 32; ++i) { const int kk = 2 * i + (lane >> 5); tmp[i] = __builtin_nontemporal_load(I.W + (size_t)(I.k0 + kk) * I.N + I.n0 + (lane & 31)); }
}
__device__ __forceinline__ void titem_store(const TItem& I, const float (&tmp)[32], LAS float* scr, int lane) {
#pragma unroll
    for (int i = 0; i < 32; ++i) { const int kk = 2 * i + (lane >> 5); scr[kk * 33 + (lane & 31)] = tmp[i]; }
    LDS_WAIT();
    if (I.mode >= 2) {
        const int c = lane & 3; unsigned char* W8 = (unsigned char*)I.WT;
#pragma unroll
        for (int j = 0; j < 2; ++j) { const int n = (lane >> 2) + 16 * j; const LAS float* s = scr + (16 * c) * 33 + n; u32x4 o;
#pragma unroll
            for (int q = 0; q < 4; ++q) { int w = 0; w = __builtin_amdgcn_cvt_pk_fp8_f32(s[(4 * q) * 33] * W8SCALE, s[(4 * q + 1) * 33] * W8SCALE, w, false);
                w = __builtin_amdgcn_cvt_pk_fp8_f32(s[(4 * q + 2) * 33] * W8SCALE, s[(4 * q + 3) * 33] * W8SCALE, w, true); o[q] = (unsigned)w; }
            const int row = (I.mode == 2) ? perm_col<2>(I.n0 + n) : (I.n0 + n);
            *(u32x4*)(W8 + (size_t)row * DM + I.k0 + 16 * c) = o; }
    } else {
        const int c = lane & 7;
#pragma unroll
        for (int j = 0; j < 4; ++j) { const int n = (lane >> 3) + 8 * j; const LAS float* s = scr + (8 * c) * 33 + n;
            u32x4 o; o.x = cvtpk(s[0 * 33], s[1 * 33]); o.y = cvtpk(s[2 * 33], s[3 * 33]); o.z = cvtpk(s[4 * 33], s[5 * 33]); o.w = cvtpk(s[6 * 33], s[7 * 33]);
            *(u32x4*)(I.WT + (size_t)perm_col_rt(I.mode, I.n0 + n) * DM + I.k0 + 8 * c) = o; }
    }
    LDS_WAIT();
}
struct W8Step { const float* W; unsigned char* W8; int N, gu, k0, n0; };
__device__ __forceinline__ void w8_load(const W8Step& I, f32x4 (&r)[16], int wave, int lane) {
#pragma unroll
    for (int h = 0; h < 2; ++h)
#pragma unroll
        for (int i = 0; i < 8; ++i) r[8 * h + i] = __builtin_nontemporal_load((const f32x4*)(I.W + (size_t)(I.k0 + 8 * (wave + 8 * h) + i) * I.N + I.n0 + 4 * lane));
}
__device__ __forceinline__ void w8_store(const W8Step& I, const f32x4 (&r)[16], LAS unsigned char* T, int tid, int wave, int lane) {
#pragma unroll
    for (int h = 0; h < 2; ++h) { const int a = wave + 8 * h;
#pragma unroll
        for (int j = 0; j < 4; ++j) { int w0 = 0, w1 = 0;
            w0 = __builtin_amdgcn_cvt_pk_fp8_f32(r[8 * h + 0][j] * W8SCALE, r[8 * h + 1][j] * W8SCALE, w0, false); w0 = __builtin_amdgcn_cvt_pk_fp8_f32(r[8 * h + 2][j] * W8SCALE, r[8 * h + 3][j] * W8SCALE, w0, true);
            w1 = __builtin_amdgcn_cvt_pk_fp8_f32(r[8 * h + 4][j] * W8SCALE, r[8 * h + 5][j] * W8SCALE, w1, false); w1 = __builtin_amdgcn_cvt_pk_fp8_f32(r[8 * h + 6][j] * W8SCALE, r[8 * h + 7][j] * W8SCALE, w1, true);
            u32x2 w; w.x = (unsigned)w0; w.y = (unsigned)w1;
            *(LAS u32x2*)(T + (4 * lane + j) * 128 + ((a ^ (lane & 15)) << 3)) = w; } }
    __syncthreads();
#pragma unroll
    for (int i = 0; i < 4; ++i) { const int p = tid + 512 * i, row = p >> 3, c16 = p & 7, f = (row >> 2) & 15;
        u32x4 v = *(const LAS u32x4*)(T + row * 128 + ((c16 ^ (f >> 1)) << 4));
        if (f & 1) v = (u32x4){v.z, v.w, v.x, v.y};
        const int orow = I.gu ? perm_col<2>(I.n0 + row) : (I.n0 + row);
        *(u32x4*)(I.W8 + (size_t)orow * DM + I.k0 + 16 * c16) = v; }
}
constexpr int W8_GU_STEPS = 32 * 64, W8_PER_LAYER = W8_GU_STEPS + 32 * 32;
__device__ __forceinline__ void w8_decode(Frame& F, W8Step& I, int layer, int j) {
    if (j < W8_GU_STEPS) { const int le = layer * NE + (j >> 6), r_ = j & 63; I.W = F.in(IN_WGU) + (size_t)le * DM * 2048; I.W8 = F.ws() + WS_WGU + (size_t)le * 2048 * DM; I.N = 2048; I.gu = 1; I.k0 = 128 * (r_ >> 3); I.n0 = 256 * (r_ & 7); }
    else { const int q_ = j - W8_GU_STEPS, le = layer * NE + (q_ >> 5), r_ = q_ & 31; I.W = F.in(IN_WDN) + (size_t)le * DM * DM; I.W8 = F.ws() + WS_WDN + (size_t)le * DM * DM; I.N = DM; I.gu = 0; I.k0 = 128 * (r_ >> 2); I.n0 = 256 * (r_ & 3); }
}
constexpr int W8_Q_DN0 = 32 * 32, W8_Q_TOTAL = W8_Q_DN0 + W8_PER_LAYER;
__device__ __forceinline__ void w8_decode_q(Frame& F, W8Step& I, int q) { if (q < W8_Q_DN0) w8_decode(F, I, 0, W8_GU_STEPS + q); else w8_decode(F, I, 1, q - W8_Q_DN0); }
__device__ __forceinline__ int w8_grab(Frame& F, unsigned* next, unsigned* done, int limit) {
    volatile LAS int* bc = (volatile LAS int*)(F.lds + MISC_OFF + 128);
    __syncthreads();
    if (F.tid == 0) { int go = 1; if (done != nullptr && __hip_atomic_load(done, __ATOMIC_RELAXED, __HIP_MEMORY_SCOPE_AGENT) >= (unsigned)F.G) go = 0;
        if (go && limit < W8_Q_TOTAL && __hip_atomic_load(next, __ATOMIC_RELAXED, __HIP_MEMORY_SCOPE_AGENT) >= (unsigned)limit) go = 0;
        int j = W8_Q_TOTAL; if (go) j = (int)__hip_atomic_fetch_add(next, 1u, __ATOMIC_RELAXED, __HIP_MEMORY_SCOPE_AGENT); bc[0] = j; }
    __syncthreads();
    return bc[0];
}
__device__ __forceinline__ void w8_help(Frame& F, unsigned* next, unsigned* done, int limit = W8_Q_TOTAL) {
    f32x4 ra[16], rb[16]; W8Step A, B; LAS unsigned char* T0 = F.lds; LAS unsigned char* T1 = F.lds + 32768;
    int j = w8_grab(F, next, done, limit);
    if (j < W8_Q_TOTAL) { w8_decode_q(F, A, j); w8_load(A, ra, F.wave, F.lane); }
    while (j < W8_Q_TOTAL) {
        int jn = w8_grab(F, next, done, limit); if (jn < W8_Q_TOTAL) { w8_decode_q(F, B, jn); w8_load(B, rb, F.wave, F.lane); }
        w8_store(A, ra, T0, F.tid, F.wave, F.lane); j = jn; if (j >= W8_Q_TOTAL) break;
        jn = w8_grab(F, next, done, limit); if (jn < W8_Q_TOTAL) { w8_decode_q(F, A, jn); w8_load(A, ra, F.wave, F.lane); }
        w8_store(B, rb, T1, F.tid, F.wave, F.lane); j = jn;
    }
    __syncthreads();
}
__device__ __forceinline__ void w8_static(Frame& F, int layer, int first, int end, int stride) {
    f32x4 ra[16], rb[16]; W8Step A, B; int st = first; LAS unsigned char* T0 = F.lds; LAS unsigned char* T1 = F.lds + 32768;
    __syncthreads();
    if (st < end) { w8_decode(F, A, layer, st); w8_load(A, ra, F.wave, F.lane); }
    while (st < end) {
        int nx = st + stride; if (nx < end) { w8_decode(F, B, layer, nx); w8_load(B, rb, F.wave, F.lane); }
        w8_store(A, ra, T0, F.tid, F.wave, F.lane); st = nx; if (st >= end) break;
        nx = st + stride; if (nx < end) { w8_decode(F, A, layer, nx); w8_load(A, ra, F.wave, F.lane); }
        w8_store(B, rb, T1, F.tid, F.wave, F.lane); st = nx;
    }
    __syncthreads();
}
__device__ __forceinline__ void rms_row_bf16(const float* xrow, const float* g, bf16_t* orow, int lane) {
    f32x4 v[4]; float ss = 0.f;
#pragma unroll
    for (int j = 0; j < 4; ++j) { v[j] = ((const f32x4*)xrow)[lane + 64 * j]; ss += (v[j].x * v[j].x + v[j].y * v[j].y) + (v[j].z * v[j].z + v[j].w * v[j].w); }
    const float rs = rsqrtf(wave_sum(ss) * (1.f / DM) + EPS);
#pragma unroll
    for (int j = 0; j < 4; ++j) { const f32x4 gv = ((const f32x4*)g)[lane + 64 * j]; const f32x4 o = v[j] * rs * gv;
        u32x2 w; w.x = cvtpk(o.x, o.y); w.y = cvtpk(o.z, o.w); ((u32x2*)orow)[lane + 64 * j] = w; }
}
__device__ __forceinline__ void prologue(Frame& F) {
    LAS float* scr = (LAS float*)(F.lds + F.wave * 16384);
    const int gw = F.bid * 8 + F.wave, NGW = F.G * 8;
    constexpr int I_IN = 16 * 64, I_OUT = 16 * 32, I_MKV = 16 * 16;
    constexpr int S0 = 2 * I_IN, S1 = S0 + 2 * I_OUT, S2 = S1 + 2 * I_MKV, S4 = S2;
#define TI_DECODE(I, it_) do { const int it__ = (it_); int r_, N_; \
        if (it__ < S0) { const int l = it__ / I_IN; r_ = it__ % I_IN; N_ = NIN; (I).W = F.in(IN_WIN) + (size_t)l * DM * NIN; (I).WT = (bf16_t*)(F.ws() + WS_WIN) + (size_t)l * NIN * DM; (I).mode = 1; } \
        else if (it__ < S1) { const int q = it__ - S0, l = q / I_OUT; r_ = q % I_OUT; N_ = DM; (I).W = F.in(IN_WOUT) + (size_t)l * DM * DM; (I).WT = (bf16_t*)(F.ws() + WS_WOUT) + (size_t)l * DM * DM; (I).mode = 0; } \
        else { const int q = it__ - S1, l = q / I_MKV; r_ = q % I_MKV; N_ = 512; (I).W = F.in(IN_WMKV) + (size_t)l * DM * 512; (I).WT = (bf16_t*)(F.ws() + WS_WMKV) + (size_t)l * 512 * DM; (I).mode = 0; } \
        const int nblk_ = N_ / 32; (I).N = N_; (I).k0 = 64 * (r_ / nblk_); (I).n0 = 32 * (r_ % nblk_); } while (0)
    { float ta[32], tb[32]; TItem A, B; int it = gw;
      if (it < S4) { TI_DECODE(A, it); titem_load(A, ta, F.lane); }
      while (it < S4) {
          int nx = it + NGW; if (nx < S4) { TI_DECODE(B, nx); titem_load(B, tb, F.lane); }
          titem_store(A, ta, scr, F.lane); it = nx; if (it >= S4) break;
          nx = it + NGW; if (nx < S4) { TI_DECODE(A, nx); titem_load(A, ta, F.lane); }
          titem_store(B, tb, scr, F.lane); it = nx;
      } }
#undef TI_DECODE
    { float* cs = (float*)(F.ws() + WS_COS); float* sn = (float*)(F.ws() + WS_SIN);
      for (int i = F.bid * 512 + F.tid; i < SEQ * 32; i += F.G * 512) { const int pos = i >> 5, f = i & 31;
          const float inv = exp2f(-(float)f * (13.287712379549449f / 32.0f));
          const float angf = (float)pos * inv; const double rev = (double)angf * 0.15915494309189535; const float fr = (float)(rev - rint(rev));
          cs[i] = __builtin_amdgcn_cosf(fr); sn[i] = __builtin_amdgcn_sinf(fr); } }
    for (int r = gw; r < 2 * 512; r += NGW) { const int l = r >> 9, m = r & 511; rms_row_bf16(F.in(IN_MEM) + (size_t)m * DM, F.in(IN_MEMNG) + l * DM, (bf16_t*)(F.ws() + WS_MEMN) + (size_t)r * DM, F.lane); }
    { const float* xin = F.in(IN_X); const float* g1 = F.in(IN_N1G); bf16_t* XN = (bf16_t*)(F.ws() + WS_XN);
      for (int r0 = gw; r0 < TOK; r0 += 2 * NGW) {
          f32x4 v[2][4]; float ss[2] = {0.f, 0.f};
#pragma unroll
          for (int a = 0; a < 2; ++a) { const int r = min(r0 + a * NGW, TOK - 1);
#pragma unroll
              for (int j = 0; j < 4; ++j) { v[a][j] = __builtin_nontemporal_load((const f32x4*)(xin + (size_t)r * DM) + F.lane + 64 * j); ss[a] += (v[a][j].x * v[a][j].x + v[a][j].y * v[a][j].y) + (v[a][j].z * v[a][j].z + v[a][j].w * v[a][j].w); } }
#pragma unroll
          for (int a = 0; a < 2; ++a) { const int r = r0 + a * NGW; if (r >= TOK) break; const float rs = rsqrtf(wave_sum(ss[a]) * (1.f / DM) + EPS);
#pragma unroll
              for (int j = 0; j < 4; ++j) { const f32x4 gv = ((const f32x4*)g1)[F.lane + 64 * j]; const f32x4 o = v[a][j] * rs * gv;
                  u32x2 w; w.x = cvtpk(o.x, o.y); w.y = cvtpk(o.z, o.w); ((u32x2*)(XN + (size_t)r * DM))[F.lane + 64 * j] = w; } } } }
}

__device__ __forceinline__ int crow(int r, int hi) { return (r & 3) + 8 * (r >> 2) + 4 * hi; }
__device__ __forceinline__ s16x4 vtr(LAS const unsigned char* p) { typedef short v4i16_t __attribute__((ext_vector_type(4))); return __builtin_bit_cast(s16x4, __builtin_amdgcn_ds_read_tr16_b64_v4i16((LAS v4i16_t*)p)); }

struct AttnJob {
    const bf16_t* Q; int qpitch, qrow0, qstep;
    const bf16_t* K; const bf16_t* V; int kvpitch, krow0, kstep;
    int t0, ntiles;
    bf16_t* O; int opitch; float* lse; int lsepitch;
};
template <bool MEM> struct AttnStage { static constexpr int NSLOT = MEM ? 8 : 12, NL = NSLOT * 256 / 512; u32x4 k[NL], v[NL]; };

template <bool MEM>
__device__ __forceinline__ void attn_issue_loads(const AttnJob& J, AttnStage<MEM>& S, int tid) {
#pragma unroll
    for (int i = 0; i < AttnStage<MEM>::NL; ++i) { const int q = tid + 512 * i, slot = q >> 8, row = (q >> 3) & 31, c = q & 7;
        const int t = min(max(J.t0 + slot, 0), J.ntiles - 1); const size_t off = (size_t)(J.krow0 + (t * 32 + row) * J.kstep) * J.kvpitch + c * 8;
        S.k[i] = *(const u32x4*)(J.K + off); S.v[i] = *(const u32x4*)(J.V + off); }
}
template <bool MEM>
__device__ __forceinline__ void attn_write_lds(const AttnStage<MEM>& S, LAS unsigned char* lds, int tid) {
#pragma unroll
    for (int i = 0; i < AttnStage<MEM>::NL; ++i) { const int q = tid + 512 * i, slot = q >> 8, row = (q >> 3) & 31, c = q & 7;
        *(LAS u32x4*)(lds + slot * 4096 + row * 128 + ((c ^ ((row >> 1) & 7)) << 4)) = S.k[i];
        *(LAS u32x4*)(lds + 49152 + slot * 4096 + row * 128 + ((c << 4) ^ (((row >> 1) & 1) << 6))) = S.v[i]; }
}
template <bool MEM, int NTC, int LI0>
__device__ __forceinline__ void attn_chunk(const AttnJob& J, const bf16x8 (&qf)[4], LAS unsigned char* lds, int wave, const int (&ka)[4], int tv0, int tv1, int mt,
                                           f32x16 (&o)[2], float& m_run, f32x2& l_run) {
    f32x16 s[NTC];
#pragma unroll
    for (int kt = 0; kt < NTC; ++kt) {
        constexpr int dummy = 0; (void)dummy;
        const int li = LI0 + kt, slot = MEM ? li : (wave + li);
        bf16x8 kf[4];
#pragma unroll
        for (int d0 = 0; d0 < 4; ++d0) kf[d0] = *(const LAS bf16x8*)(lds + ka[d0] + li * 4096);
        f32x16 a;
#pragma unroll
        for (int r = 0; r < 16; ++r) a[r] = 0.f;
#pragma unroll
        for (int d0 = 0; d0 < 4; ++d0) a = __builtin_amdgcn_mfma_f32_32x32x16_bf16(kf[d0], qf[d0], a, 0, 0, 0);
        if (!MEM) { const int traw = J.t0 + slot;
            if (li == 0 || li == 4) {
#pragma unroll
                for (int r = 0; r < 16; ++r) { const int cr = (r & 3) + 8 * (r >> 2); const bool keep = (li == 0) ? (cr >= mt) : (cr <= mt); a[r] = keep ? a[r] : -1e30f; } }
            if (traw < 0 || traw >= J.ntiles) {
                asm volatile("" ::: "memory");
#pragma unroll
                for (int r = 0; r < 16; ++r) a[r] = -1e30f; } }
        s[kt] = a;
    }
    float mx = -1e30f;
#pragma unroll
    for (int kt = 0; kt < NTC; ++kt)
#pragma unroll
        for (int r = 0; r < 16; ++r) mx = fmaxf(mx, s[kt][r]);
    mx = xor32_max(mx);
    const float m_new = fmaxf(m_run, mx);
    if (LI0 > 0) { const float alpha = __builtin_amdgcn_exp2f(m_run - m_new); const f32x2 al2 = {alpha, alpha}; l_run *= al2;
#pragma unroll
        for (int r = 0; r < 16; r += 2) { const f32x2 x0 = (f32x2){o[0][r], o[0][r + 1]} * al2, x1 = (f32x2){o[1][r], o[1][r + 1]} * al2; o[0][r] = x0.x; o[0][r + 1] = x0.y; o[1][r] = x1.x; o[1][r + 1] = x1.y; } }
    m_run = m_new; const f32x2 mn2 = {m_new, m_new};
#pragma unroll
    for (int kt = 0; kt < NTC; ++kt) {
        const int li = LI0 + kt;
#pragma unroll
        for (int r = 0; r < 16; r += 2) { f32x2 d = (f32x2){s[kt][r], s[kt][r + 1]} - mn2; d.x = __builtin_amdgcn_exp2f(d.x); d.y = __builtin_amdgcn_exp2f(d.y); s[kt][r] = d.x; s[kt][r + 1] = d.y; l_run += d; }
        bf16x8 pb[2];
#pragma unroll
        for (int s2 = 0; s2 < 2; ++s2) { u32x4 w; w.x = cvtpk(s[kt][8 * s2 + 0], s[kt][8 * s2 + 1]); w.y = cvtpk(s[kt][8 * s2 + 2], s[kt][8 * s2 + 3]);
            w.z = cvtpk(s[kt][8 * s2 + 4], s[kt][8 * s2 + 5]); w.w = cvtpk(s[kt][8 * s2 + 6], s[kt][8 * s2 + 7]); pb[s2] = __builtin_bit_cast(bf16x8, w); }
#pragma unroll
        for (int db = 0; db < 2; ++db)
#pragma unroll
            for (int s2 = 0; s2 < 2; ++s2) { const int tb = (db == 0) ? tv0 : tv1;
                const s16x4 lo = vtr(lds + tb + li * 4096 + s2 * 2048), h8 = vtr(lds + tb + li * 4096 + s2 * 2048 + 1024);
                const bf16x8 va = (bf16x8){lo[0], lo[1], lo[2], lo[3], h8[0], h8[1], h8[2], h8[3]};
                o[db] = __builtin_amdgcn_mfma_f32_32x32x16_bf16(va, pb[s2], o[db], 0, 0, 0); }
    }
}
template <bool MEM>
__device__ __forceinline__ void attn_compute(const AttnJob& J, const bf16x8 (&qf)[4], LAS unsigned char* lds, int wave, int lane) {
    const int r32 = lane & 31, hi = lane >> 5;
    f32x16 o[2];
#pragma unroll
    for (int r = 0; r < 16; ++r) { o[0][r] = 0.f; o[1][r] = 0.f; }
    float m_run = -1e30f; f32x2 l_run = {0.f, 0.f};
    const int ksw = (r32 >> 1) & 7, koff = r32 * 128 + (MEM ? 0 : wave * 4096);
    const int q4 = (lane & 15) >> 2, sw = (q4 >> 1) & 1, trow = (4 * hi + q4) * 128, tcol = ((lane >> 4) & 1) * 32 + (lane & 3) * 8;
    const int tv0 = 49152 + (MEM ? 0 : wave * 4096) + trow + ((sw << 6) | tcol), tv1 = 49152 + (MEM ? 0 : wave * 4096) + trow + (((1 ^ sw) << 6) | tcol);
    int ka[4];
#pragma unroll
    for (int d0 = 0; d0 < 4; ++d0) ka[d0] = koff + (((2 * d0 + hi) ^ ksw) << 4);
    int mt = r32 - 4 * hi; asm volatile("" : "+v"(mt));
    if (MEM) { attn_chunk<MEM, 3, 0>(J, qf, lds, wave, ka, tv0, tv1, mt, o, m_run, l_run); attn_chunk<MEM, 3, 3>(J, qf, lds, wave, ka, tv0, tv1, mt, o, m_run, l_run);
               attn_chunk<MEM, 2, 6>(J, qf, lds, wave, ka, tv0, tv1, mt, o, m_run, l_run); }
    else     { attn_chunk<MEM, 3, 0>(J, qf, lds, wave, ka, tv0, tv1, mt, o, m_run, l_run); attn_chunk<MEM, 2, 3>(J, qf, lds, wave, ka, tv0, tv1, mt, o, m_run, l_run); }
    const float l = xor32_sum(l_run.x + l_run.y);
    const float inv = 1.0f / l;
    const int qrow = J.qrow0 + (wave * 32 + r32) * J.qstep;
    LAS unsigned char* ot = lds + 98304 + wave * 4096;
#pragma unroll
    for (int db = 0; db < 2; ++db)
#pragma unroll
        for (int g = 0; g < 4; ++g) { u32x2 w; w.x = cvtpk(o[db][4 * g] * inv, o[db][4 * g + 1] * inv); w.y = cvtpk(o[db][4 * g + 2] * inv, o[db][4 * g + 3] * inv);
            *(LAS u32x2*)(ot + r32 * 128 + (32 * db + 8 * g + 4 * hi) * 2) = w; }
    if (J.lse != nullptr && hi == 0) J.lse[(size_t)qrow * J.lsepitch] = m_run + __builtin_amdgcn_logf(l);
    LDS_WAIT();
    { const int c = lane & 7, rr = lane >> 3; const size_t obase = (size_t)(J.qrow0 + wave * 32 * J.qstep) * J.opitch;
#pragma unroll
      for (int i = 0; i < 4; ++i) { const int row = rr + 8 * i; *(u32x4*)(J.O + obase + (size_t)(row * J.qstep) * J.opitch + c * 8) = *(const LAS u32x4*)(ot + row * 128 + c * 16); } }
}
template <bool MEM, class MakeJob>
__device__ __forceinline__ void attn_block_units(Frame& F, int first, int count, int stride, const MakeJob& mk) {
    if (first >= count) return;
    AttnStage<MEM> S; AttnJob J = mk(first); bf16x8 qn[4];
#define ATTN_LOAD_Q(JJ) do { const int qrow_ = (JJ).qrow0 + (F.wave * 32 + (F.lane & 31)) * (JJ).qstep; const bf16_t* qp_ = (JJ).Q + (size_t)qrow_ * (JJ).qpitch + (F.lane >> 5) * 8; \
        _Pragma("unroll") for (int d0 = 0; d0 < 4; ++d0) qn[d0] = *(const bf16x8*)(qp_ + d0 * 16); } while (0)
    attn_issue_loads<MEM>(J, S, F.tid); ATTN_LOAD_Q(J);
    for (int u = first; u < count; u += stride) {
        bf16x8 qf[4];
#pragma unroll
        for (int d0 = 0; d0 < 4; ++d0) qf[d0] = qn[d0];
        __syncthreads();
        attn_write_lds<MEM>(S, F.lds, F.tid);
        __syncthreads();
        const int un = u + stride; AttnJob Jn = J;
        if (un < count) { Jn = mk(un); attn_issue_loads<MEM>(Jn, S, F.tid); ATTN_LOAD_Q(Jn); }
        attn_compute<MEM>(J, qf, F.lds, F.wave, F.lane);
        J = Jn;
    }
    __syncthreads();
#undef ATTN_LOAD_Q
}

constexpr int POOL_DH = 40960, POOL_WT = POOL_DH + 64 * 528, POOL_DPITCH = 528, POOL_WPITCH = 144;
__device__ __forceinline__ void pool_unit(Frame& F, const bf16_t* PROJ, const float* pw, const float* pscale, bf16_t* YRAW, int tile) {
    const int tid = F.tid, row0 = tile * 64, pos0 = row0 & (SEQ - 1);
    LAS bf16_t* U = (LAS bf16_t*)F.lds;
    LAS unsigned char* Dh = F.lds + POOL_DH; LAS unsigned char* WT = F.lds + POOL_WT;
    { u32x4 uv[5];
#pragma unroll
      for (int q = 0; q < 5; ++q) { const int i = tid + 512 * q, r = i >> 5, ch = i & 31, pos = min(max(pos0 - 8 + r, 0), SEQ - 1);
          uv[q] = *(const u32x4*)(PROJ + (size_t)(row0 - pos0 + pos) * NIN + 1536 + ch * 8); }
#pragma unroll
      for (int q = 0; q < 5; ++q) { const int i = tid + 512 * q, r = i >> 5, ch = i & 31, pos = pos0 - 8 + r;
          *(LAS u32x4*)(U + r * 256 + ch * 8) = (pos >= 0 && pos < SEQ) ? uv[q] : (u32x4){0u, 0u, 0u, 0u}; } }
    { float pwv[32];
#pragma unroll
      for (int i = 0; i < 32; ++i) pwv[i] = pw[tid + 512 * i];
#pragma unroll
      for (int i = 0; i < 32; ++i) { const int idx = tid + 512 * i, dout = idx & 63, c = (idx >> 6) & 63, g = idx >> 12;
          *(LAS bf16_t*)(WT + (g * 64 + dout) * POOL_WPITCH + c * 2) = f2bf(pwv[i]); } }
    __syncthreads();
    { const int ch = tid & 255, g = ch >> 6, half = tid >> 8, w = 2 << g, left = w >> 1, right = w - 1 - left, i0 = half * 32;
      float s = 0.f;
#pragma unroll
      for (int k = 0; k < 16; ++k) if (k < w) s += bf1(U[(i0 - left + k + 8) * 256 + ch]);
#pragma unroll 2
      for (int ii = 0; ii < 32; ++ii) { const int i = i0 + ii, pos = pos0 + i; const int lo = max(pos - left, 0), hi = min(pos + right, SEQ - 1);
          *(LAS bf16_t*)(Dh + i * POOL_DPITCH + ch * 2) = f2bf(s / (float)(hi - lo + 1) - bf1(U[(i + 8) * 256 + ch]));
          s += bf1(U[(i + 1 + right + 8) * 256 + ch]) - bf1(U[(i - left + 8) * 256 + ch]); } }
    __syncthreads();
    { const int lane = F.lane, r32 = lane & 31, hi = lane >> 5, g = F.wave & 3, th = F.wave >> 2;
      bf16x8 af[4];
#pragma unroll
      for (int s = 0; s < 4; ++s) af[s] = *(const LAS bf16x8*)(Dh + (th * 32 + r32) * POOL_DPITCH + (g * 64 + 16 * s + 8 * hi) * 2);
#pragma unroll 1
      for (int nt = 0; nt < 2; ++nt) {
          f32x16 acc;
#pragma unroll
          for (int r = 0; r < 16; ++r) acc[r] = 0.f;
#pragma unroll
          for (int s = 0; s < 4; ++s) { const bf16x8 bfr = *(const LAS bf16x8*)(WT + (g * 64 + nt * 32 + r32) * POOL_WPITCH + (16 * s + 8 * hi) * 2);
              acc = __builtin_amdgcn_mfma_f32_32x32x16_bf16(bfr, af[s], acc, 0, 0, 0); }
          LAS unsigned char* yt = F.lds + (th * 32 + r32) * 528 + (g * 64 + nt * 32 + 4 * hi) * 2; const float* ps = pscale + g * 64 + nt * 32 + 4 * hi;
#pragma unroll
          for (int gq = 0; gq < 4; ++gq) { const f32x4 sc = *(const f32x4*)(ps + 8 * gq);
              u32x2 w; w.x = cvtpk(acc[4 * gq] * sc.x, acc[4 * gq + 1] * sc.y); w.y = cvtpk(acc[4 * gq + 2] * sc.z, acc[4 * gq + 3] * sc.w); *(LAS u32x2*)(yt + 16 * gq) = w; }
      } }
    __syncthreads();
#pragma unroll
    for (int i = 0; i < 4; ++i) { const int q = tid + 512 * i, tok = q >> 5, c = q & 31;
        *(u32x4*)(YRAW + (size_t)(row0 + tok) * 512 + c * 8) = *(const LAS u32x4*)(F.lds + tok * 528 + c * 16); }
    __syncthreads();
}

struct DilJob { const bf16_t* QH; bf16_t* AO; float* LSE;
    __device__ __forceinline__ AttnJob operator()(int bu) const {
        const int i8 = bu & 31, bhp = bu >> 5, p = bhp % 3, bh = bhp / 3, h = bh & 7, b = bh >> 3;
        const int dil = (p == 0) ? 1 : (p == 1 ? 4 : 16), tpr = 256 / dil, g8 = tpr >> 3, r = i8 / g8, jt0 = 8 * (i8 % g8);
        const size_t hs = (size_t)SEQ * 64;
        AttnJob J; J.Q = QH + (size_t)(b * 8 + h) * hs; J.qpitch = 64; J.qrow0 = r + jt0 * 32 * dil; J.qstep = dil;
        J.K = QH + (size_t)((2 + b) * 8 + h) * hs; J.V = QH + (size_t)((4 + b) * 8 + h) * hs; J.kvpitch = 64; J.krow0 = r; J.kstep = dil; J.t0 = jt0 - 2; J.ntiles = tpr;
        J.O = AO + (size_t)p * TOK * 512 + (size_t)b * SEQ * 512 + h * 64; J.opitch = 512; J.lse = LSE + (size_t)p * TOK * 8 + (size_t)b * SEQ * 8 + h; J.lsepitch = 8; return J; } };
struct MemJob { const bf16_t* PROJ; const bf16_t* MKV; bf16_t* YRAW;
    __device__ __forceinline__ AttnJob operator()(int mu) const {
        const int q8 = mu & 31, bh = mu >> 5, hm = bh & 3, b = bh >> 2;
        AttnJob J; J.Q = PROJ + 1792 + hm * 64; J.qpitch = NIN; J.qrow0 = b * SEQ + q8 * 256; J.qstep = 1;
        J.K = MKV + hm * 64; J.V = MKV + 256 + hm * 64; J.kvpitch = 512; J.krow0 = b * NMEM; J.kstep = 1; J.t0 = 0; J.ntiles = 8;
        J.O = YRAW + 256 + hm * 64; J.opitch = 512; J.lse = nullptr; J.lsepitch = 0; return J; } };

__device__ __forceinline__ void phase_mixers(Frame& F, int l, int parts = 7) {
    const bf16_t* PROJ = (const bf16_t*)(F.ws() + WS_PROJ); const bf16_t* QH = (const bf16_t*)(F.ws() + WS_QKVH);
    bf16_t* AO = (bf16_t*)(F.ws() + WS_AO); float* LSE = (float*)(F.ws() + WS_LSE); bf16_t* YRAW = (bf16_t*)(F.ws() + WS_YRAW);
    const bf16_t* MKV = (const bf16_t*)(F.ws() + WS_MEMKV) + (size_t)l * 512 * 512;
    const int pt = (parts == 7 && l == 0) ? (F.bid & 3) : -1;
    if (pt == 0) w8_static(F, 0, W8_GU_STEPS / 2 + F.bid, W8_GU_STEPS, F.G);
    if (parts & 1) { DilJob mk{QH, AO, LSE}; attn_block_units<false>(F, F.bid, 1536, F.G, mk); }
    if (pt == 1) w8_static(F, 0, W8_GU_STEPS / 2 + F.bid, W8_GU_STEPS, F.G);
    if (parts & 2) { MemJob mk{PROJ, MKV, YRAW}; attn_block_units<true>(F, F.bid, 256, F.G, mk); }
    if (pt == 2) w8_static(F, 0, W8_GU_STEPS / 2 + F.bid, W8_GU_STEPS, F.G);
    if (parts & 4) for (int tile = F.bid; tile < TOK / 64; tile += F.G) pool_unit(F, PROJ, F.in(IN_POOLW) + (size_t)l * 4 * 64 * 64, F.in(IN_POOLS) + l * 256, YRAW, tile);
    if (pt == 3) w8_static(F, 0, W8_GU_STEPS / 2 + F.bid, W8_GU_STEPS, F.G);
}

__device__ __forceinline__ void phase_combine_norm(Frame& F, int l) {
    const bf16_t* AO = (const bf16_t*)(F.ws() + WS_AO); const float* LSE = (const float*)(F.ws() + WS_LSE); const bf16_t* YRAW = (const bf16_t*)(F.ws() + WS_YRAW);
    bf16_t* Y = (bf16_t*)(F.ws() + WS_Y); const float* gg = F.in(IN_GRPG) + l * DM;
    const int gw = F.bid * 8 + F.wave, NGW = F.G * 8, lane = F.lane, head = lane >> 3;
    float lsn[2][3]; u32x4 avn[2][3]; u32x2 pvn[2], mvn[2];
#define CN_LOAD(r0_) do { _Pragma("unroll") for (int a = 0; a < 2; ++a) { const size_t row = (size_t)min((r0_) + a * NGW, TOK - 1); \
            _Pragma("unroll") for (int p = 0; p < 3; ++p) { lsn[a][p] = LSE[(size_t)p * TOK * 8 + row * 8 + head]; avn[a][p] = __builtin_nontemporal_load((const u32x4*)(AO + (size_t)p * TOK * 512 + row * 512 + lane * 8)); } \
            pvn[a] = *(const u32x2*)(YRAW + row * 512 + lane * 4); mvn[a] = *(const u32x2*)(YRAW + row * 512 + 256 + lane * 4); } } while (0)
    CN_LOAD(gw);
    for (int r0 = gw; r0 < TOK; r0 += 2 * NGW) {
        float ls[2][3]; u32x4 av[2][3]; u32x2 pv[2], mv[2];
#pragma unroll
        for (int a = 0; a < 2; ++a) { pv[a] = pvn[a]; mv[a] = mvn[a];
#pragma unroll
            for (int p = 0; p < 3; ++p) { ls[a][p] = lsn[a][p]; av[a][p] = avn[a][p]; } }
        if (r0 + 2 * NGW < TOK) CN_LOAD(r0 + 2 * NGW);
#pragma unroll
        for (int a = 0; a < 2; ++a) { const int rowi = r0 + a * NGW; if (rowi >= TOK) break; const size_t row = (size_t)rowi;
            const float l0 = ls[a][0], l1 = ls[a][1], l2 = ls[a][2]; const u32x4 a0 = av[a][0], a1 = av[a][1], a2 = av[a][2];
            const float mx = fmaxf(l0, fmaxf(l1, l2));
            float w0 = __builtin_amdgcn_exp2f(l0 - mx), w1 = __builtin_amdgcn_exp2f(l1 - mx), w2 = __builtin_amdgcn_exp2f(l2 - mx);
            const float wi = 1.0f / (w0 + w1 + w2); w0 *= wi; w1 *= wi; w2 *= wi;
            float y[8]; float ss = 0.f;
#pragma unroll
            for (int i = 0; i < 4; ++i) { y[2 * i] = w0 * bflo(a0[i]) + w1 * bflo(a1[i]) + w2 * bflo(a2[i]); y[2 * i + 1] = w0 * bfhi(a0[i]) + w1 * bfhi(a1[i]) + w2 * bfhi(a2[i]); ss += y[2 * i] * y[2 * i] + y[2 * i + 1] * y[2 * i + 1]; }
            const float p0 = bflo(pv[a].x), p1 = bfhi(pv[a].x), p2 = bflo(pv[a].y), p3 = bfhi(pv[a].y);
            const float q0 = bflo(mv[a].x), q1 = bfhi(mv[a].x), q2 = bflo(mv[a].y), q3 = bfhi(mv[a].y);
            float sp = p0 * p0 + p1 * p1 + p2 * p2 + p3 * p3, sq = q0 * q0 + q1 * q1 + q2 * q2 + q3 * q3;
            ss = wave_sum(ss); sp = wave_sum(sp); sq = wave_sum(sq);
            const float rs = rsqrtf(ss * (1.f / 512.f) + EPS), rp = rsqrtf(sp * (1.f / 256.f) + EPS), rq = rsqrtf(sq * (1.f / 256.f) + EPS);
            const f32x4 g0 = *(const f32x4*)(gg + lane * 8), g1 = *(const f32x4*)(gg + lane * 8 + 4), gp = *(const f32x4*)(gg + 512 + lane * 4), gq = *(const f32x4*)(gg + 768 + lane * 4);
            u32x4 wv; wv.x = cvtpk(y[0] * rs * g0.x, y[1] * rs * g0.y); wv.y = cvtpk(y[2] * rs * g0.z, y[3] * rs * g0.w); wv.z = cvtpk(y[4] * rs * g1.x, y[5] * rs * g1.y); wv.w = cvtpk(y[6] * rs * g1.z, y[7] * rs * g1.w);
            *(u32x4*)(Y + row * DM + lane * 8) = wv;
            u32x2 op; op.x = cvtpk(p0 * rp * gp.x, p1 * rp * gp.y); op.y = cvtpk(p2 * rp * gp.z, p3 * rp * gp.w); *(u32x2*)(Y + row * DM + 512 + lane * 4) = op;
            u32x2 oq; oq.x = cvtpk(q0 * rq * gq.x, q1 * rq * gq.y); oq.y = cvtpk(q2 * rq * gq.z, q3 * rq * gq.w); *(u32x2*)(Y + row * DM + 768 + lane * 4) = oq; }
    }
}

#undef CN_LOAD
__device__ __forceinline__ void phase_router(Frame& F, int l) {
    const bf16_t* X1 = (const bf16_t*)(F.ws() + WS_X1); unsigned char* H2 = F.ws() + WS_H2;
    const float* g2 = F.in(IN_N2G) + l * DM; const float* Wr = F.in(IN_RW) + (size_t)l * DM * NE; const float* rb = F.in(IN_RB) + l * NE;
    int* rt_e = (int*)(F.ws() + WS_RT); int* rt_rank = rt_e + TOK * TOPK; float* rt_gate = (float*)(rt_rank + TOK * TOPK); int* elist = (int*)(F.ws() + WS_ELIST);
    unsigned* gcnt = (unsigned*)(F.ws() + WS_CTL) + CW_CNT + 64 * l;
    LAS float* hb = (LAS float*)F.lds;
    LAS float* pl = (LAS float*)(F.lds + 65536);
    LAS int* lcnt = (LAS int*)(F.lds + MISC_OFF + 1024);
    LAS int* lbase = lcnt + 32;
    LAS int* le = lcnt + 64;
    LAS int* lrank = le + 256;
    const int lane = F.lane, e = lane & 31, half = lane >> 5, w = F.wave;
    f32x2 wreg[32];
#pragma unroll
    for (int i = 0; i < 32; ++i) { wreg[i].x = Wr[(size_t)(128 * w + 64 * half + 2 * i) * NE + e]; wreg[i].y = Wr[(size_t)(128 * w + 64 * half + 2 * i + 1) * NE + e]; }
    const float bias = rb[e];
    for (int tg = F.bid; tg < TOK / 64; tg += F.G) {
        if (F.tid < 32) lcnt[F.tid] = 0;
        __syncthreads();
        u32x2 xv[2][4];
#pragma unroll
        for (int i2 = 0; i2 < 2; ++i2)
#pragma unroll
            for (int j = 0; j < 4; ++j) xv[i2][j] = __builtin_nontemporal_load((const u32x2*)(X1 + ((size_t)tg * 64 + 2 * w + i2) * DM) + lane + 64 * j);
#pragma unroll 1
        for (int b = 0; b < 4; ++b) {
#pragma unroll
            for (int i2 = 0; i2 < 2; ++i2) { const int ti = 2 * w + i2; const size_t row = (size_t)tg * 64 + 16 * b + ti;
                f32x4 v[4]; float ss = 0.f;
#pragma unroll
                for (int j = 0; j < 4; ++j) { v[j] = (f32x4){bflo(xv[i2][j].x), bfhi(xv[i2][j].x), bflo(xv[i2][j].y), bfhi(xv[i2][j].y)}; ss += (v[j].x * v[j].x + v[j].y * v[j].y) + (v[j].z * v[j].z + v[j].w * v[j].w); }
                const float rs = rsqrtf(wave_sum(ss) * (1.f / DM) + EPS);
#pragma unroll
                for (int j = 0; j < 4; ++j) { const f32x4 gv = ((const f32x4*)g2)[lane + 64 * j]; const f32x4 o = v[j] * rs * gv;
                    int w8 = 0; w8 = __builtin_amdgcn_cvt_pk_fp8_f32(o.x, o.y, w8, false); w8 = __builtin_amdgcn_cvt_pk_fp8_f32(o.z, o.w, w8, true); ((int*)(H2 + row * DM))[lane + 64 * j] = w8;
                    *(LAS f32x4*)(hb + ti * 1024 + (lane + 64 * j) * 4) = o; } }
            if (b < 3) {
#pragma unroll
                for (int i2 = 0; i2 < 2; ++i2)
#pragma unroll
                    for (int j = 0; j < 4; ++j) xv[i2][j] = __builtin_nontemporal_load((const u32x2*)(X1 + ((size_t)tg * 64 + 16 * (b + 1) + 2 * w + i2) * DM) + lane + 64 * j); }
            __syncthreads();
#pragma unroll 2
            for (int t = 0; t < 16; ++t) { const LAS float* hp = hb + t * 1024 + 128 * w + 64 * half; f32x2 a0 = {0.f, 0.f}, a1 = {0.f, 0.f};
#pragma unroll
                for (int i = 0; i < 64; i += 4) { const f32x4 hv = *(const LAS f32x4*)(hp + i); a0 += (f32x2){hv.x, hv.y} * wreg[i >> 1]; a1 += (f32x2){hv.z, hv.w} * wreg[(i >> 1) + 1]; }
                const float p = xor32_sum((a0.x + a0.y) + (a1.x + a1.y));
                if (lane < 32) pl[(w * 16 + t) * 32 + e] = p; }
            __syncthreads();
#pragma unroll
            for (int i2 = 0; i2 < 2; ++i2) { const int ti = 2 * w + i2, tl = 16 * b + ti;
                float v = bias;
#pragma unroll
                for (int ww = 0; ww < 8; ++ww) v += pl[(ww * 16 + ti) * 32 + e];
                float tv[4]; int tix[4];
#pragma unroll
                for (int k = 0; k < 4; ++k) { float bv = v; int bi = e;
#define TOPK_STEP(M) { const float ov = swz_f<M>(bv); const int oi = swz_i<M>(bi); if (ov > bv || (ov == bv && oi < bi)) { bv = ov; bi = oi; } }
                    TOPK_STEP(1) TOPK_STEP(2) TOPK_STEP(4) TOPK_STEP(8)
#undef TOPK_STEP
                    { const auto rv = __builtin_amdgcn_permlane16_swap(__float_as_uint(bv), __float_as_uint(bv), false, false); const auto ri = __builtin_amdgcn_permlane16_swap((unsigned)bi, (unsigned)bi, false, false);
                      const float v0 = __uint_as_float(rv[0]), v1 = __uint_as_float(rv[1]); const int i0 = (int)ri[0], i1 = (int)ri[1];
                      const bool t1 = (v1 > v0) || (v1 == v0 && i1 < i0); bv = t1 ? v1 : v0; bi = t1 ? i1 : i0; }
                    tv[k] = bv; tix[k] = bi; if (e == bi) v = -3.0e38f; }
                const float e1 = __expf(tv[1] - tv[0]), e2 = __expf(tv[2] - tv[0]), e3 = __expf(tv[3] - tv[0]); const float isum = 1.0f / (1.0f + e1 + e2 + e3);
                if (lane < 4) { const int me = (lane == 0) ? tix[0] : (lane == 1) ? tix[1] : (lane == 2) ? tix[2] : tix[3];
                    const float gt = ((lane == 0) ? 1.0f : (lane == 1) ? e1 : (lane == 2) ? e2 : e3) * isum;
                    const int lr = __hip_atomic_fetch_add(lcnt + me, 1, __ATOMIC_RELAXED, __HIP_MEMORY_SCOPE_WORKGROUP);
                    le[tl * 4 + lane] = me; lrank[tl * 4 + lane] = lr; rt_gate[((size_t)tg * 64 + tl) * 4 + lane] = gt; } }
        }
        __syncthreads();
        if (F.tid < 32) lbase[F.tid] = (int)__hip_atomic_fetch_add(gcnt + F.tid, (unsigned)lcnt[F.tid], __ATOMIC_RELAXED, __HIP_MEMORY_SCOPE_AGENT);
        __syncthreads();
        if (F.tid < 256) { const int me = le[F.tid], rk = lbase[me] + lrank[F.tid]; rt_e[(size_t)tg * 256 + F.tid] = me; rt_rank[(size_t)tg * 256 + F.tid] = rk; elist[(size_t)me * TOK + rk] = tg * 64 + (F.tid >> 2); }
        __syncthreads();
    }
}

__device__ __forceinline__ LAS int* moe_tile_table(Frame& F, int l) {
    LAS int* tstart = (LAS int*)(F.lds + MISC_OFF + 512);
    const unsigned* gcnt = (const unsigned*)(F.ws() + WS_CTL) + CW_CNT + 64 * l;
    if (F.tid < 64) {
        const int e = F.lane & 31; const int cnt = (int)__hip_atomic_load(gcnt + e, __ATOMIC_RELAXED, __HIP_MEMORY_SCOPE_AGENT); const int mt = (cnt + 255) >> 8;
        int inc = mt;
#pragma unroll
        for (int o = 1; o < 32; o <<= 1) { const int t = __builtin_amdgcn_ds_bpermute(((F.lane - o) & 63) << 2, inc); if (e >= o) inc += t; }
        if (F.lane < 32) { tstart[80 + e] = cnt; tstart[40 + e] = mt; tstart[e] = inc - mt; if (e == 31) tstart[32] = inc; } }
    __syncthreads();
    return tstart;
}

__device__ __forceinline__ void phase_moe_combine(Frame& F, int l) {
    const bf16_t* X1 = (const bf16_t*)(F.ws() + WS_X1); bf16_t* X2 = (bf16_t*)(F.ws() + WS_X2); const unsigned char* YS = F.ws() + WS_YS;
    LAS int* tstart = moe_tile_table(F, l);
    const int* rt_e = (const int*)(F.ws() + WS_RT); const int* rt_rank = rt_e + TOK * TOPK; const float* rt_gate = (const float*)(F.ws() + WS_RT) + 2 * TOK * TOPK;
    bf16_t* XN = (bf16_t*)(F.ws() + WS_XN);
    const bool lastl = (l == DEPTH - 1);
    const float* gn = lastl ? F.in(IN_FING) : (F.in(IN_N1G) + (l + 1) * DM);
    const int gw = F.bid * 8 + F.wave, NGW = F.G * 8, lane = F.lane;
    typedef int i32x4 __attribute__((ext_vector_type(4)));
    i32x4 een[2], sln[2]; f32x4 gtn[2];
#pragma unroll
    for (int a = 0; a < 2; ++a) { const int t = min(gw + a * NGW, TOK - 1); een[a] = *(const i32x4*)(rt_e + (size_t)t * 4); sln[a] = *(const i32x4*)(rt_rank + (size_t)t * 4); gtn[a] = *(const f32x4*)(rt_gate + (size_t)t * 4); }
    for (int t0 = gw; t0 < TOK; t0 += 2 * NGW) {
        i32x4 sl[2]; f32x4 gt[2]; f32x4 v[2][4]; u32x4 xb[2][2]; u32x2 y[2][4][2];
#pragma unroll
        for (int a = 0; a < 2; ++a) { const int t = min(t0 + a * NGW, TOK - 1); const i32x4 ee = een[a]; sl[a] = sln[a]; gt[a] = gtn[a];
            sl[a].x += tstart[ee.x] * 256; sl[a].y += tstart[ee.y] * 256; sl[a].z += tstart[ee.z] * 256; sl[a].w += tstart[ee.w] * 256;
            const bf16_t* xr = X1 + (size_t)t * DM + lane * 8; xb[a][0] = __builtin_nontemporal_load((const u32x4*)xr); xb[a][1] = __builtin_nontemporal_load((const u32x4*)(xr + 512)); }
#pragma unroll
        for (int a = 0; a < 2; ++a)
#pragma unroll
            for (int k = 0; k < 4; ++k) { const unsigned char* yr = YS + (size_t)sl[a][k] * DM + lane * 8; y[a][k][0] = __builtin_nontemporal_load((const u32x2*)yr); y[a][k][1] = __builtin_nontemporal_load((const u32x2*)(yr + 512)); }
#pragma unroll
        for (int a = 0; a < 2; ++a) { const int t = min(t0 + 2 * NGW + a * NGW, TOK - 1); een[a] = *(const i32x4*)(rt_e + (size_t)t * 4); sln[a] = *(const i32x4*)(rt_rank + (size_t)t * 4); gtn[a] = *(const f32x4*)(rt_gate + (size_t)t * 4); }
#pragma unroll
        for (int a = 0; a < 2; ++a) { const int t = t0 + a * NGW; if (t >= TOK) break;
#pragma unroll
            for (int hf = 0; hf < 2; ++hf) { const u32x4 r = xb[a][hf]; v[a][2 * hf] = (f32x4){bflo(r.x), bfhi(r.x), bflo(r.y), bfhi(r.y)}; v[a][2 * hf + 1] = (f32x4){bflo(r.z), bfhi(r.z), bflo(r.w), bfhi(r.w)}; }
#pragma unroll
            for (int k = 0; k < 4; ++k) { const float g = gt[a][k];
#pragma unroll
                for (int hf = 0; hf < 2; ++hf) { const u32x2 yy = y[a][k][hf];
                    const f32x2 p0 = __builtin_amdgcn_cvt_pk_f32_fp8((int)yy.x, false), p1 = __builtin_amdgcn_cvt_pk_f32_fp8((int)yy.x, true), p2 = __builtin_amdgcn_cvt_pk_f32_fp8((int)yy.y, false), p3 = __builtin_amdgcn_cvt_pk_f32_fp8((int)yy.y, true);
                    v[a][2 * hf][0] += g * p0.x; v[a][2 * hf][1] += g * p0.y; v[a][2 * hf][2] += g * p1.x; v[a][2 * hf][3] += g * p1.y;
                    v[a][2 * hf + 1][0] += g * p2.x; v[a][2 * hf + 1][1] += g * p2.y; v[a][2 * hf + 1][2] += g * p3.x; v[a][2 * hf + 1][3] += g * p3.y; } }
            float ss = 0.f;
#pragma unroll
            for (int j = 0; j < 4; ++j) ss += (v[a][j].x * v[a][j].x + v[a][j].y * v[a][j].y) + (v[a][j].z * v[a][j].z + v[a][j].w * v[a][j].w);
            const float rs = rsqrtf(wave_sum(ss) * (1.f / DM) + EPS);
            const float* gr = gn + lane * 8; f32x4 o[4];
            o[0] = v[a][0] * rs * *(const f32x4*)gr; o[1] = v[a][1] * rs * *(const f32x4*)(gr + 4); o[2] = v[a][2] * rs * *(const f32x4*)(gr + 512); o[3] = v[a][3] * rs * *(const f32x4*)(gr + 516);
            if (lastl) { float* orow = F.out() + (size_t)t * DM + lane * 8; *(f32x4*)orow = o[0]; *(f32x4*)(orow + 4) = o[1]; *(f32x4*)(orow + 512) = o[2]; *(f32x4*)(orow + 516) = o[3]; }
            else { bf16_t* xr = X2 + (size_t)t * DM + lane * 8; u32x4 x0, x1;
                x0.x = cvtpk(v[a][0].x, v[a][0].y); x0.y = cvtpk(v[a][0].z, v[a][0].w); x0.z = cvtpk(v[a][1].x, v[a][1].y); x0.w = cvtpk(v[a][1].z, v[a][1].w);
                x1.x = cvtpk(v[a][2].x, v[a][2].y); x1.y = cvtpk(v[a][2].z, v[a][2].w); x1.z = cvtpk(v[a][3].x, v[a][3].y); x1.w = cvtpk(v[a][3].z, v[a][3].w);
                *(u32x4*)xr = x0; *(u32x4*)(xr + 512) = x1;
                bf16_t* nr = XN + (size_t)t * DM + lane * 8; u32x4 w0, w1;
                w0.x = cvtpk(o[0].x, o[0].y); w0.y = cvtpk(o[0].z, o[0].w); w0.z = cvtpk(o[1].x, o[1].y); w0.w = cvtpk(o[1].z, o[1].w);
                w1.x = cvtpk(o[2].x, o[2].y); w1.y = cvtpk(o[2].z, o[2].w); w1.z = cvtpk(o[3].x, o[3].y); w1.w = cvtpk(o[3].z, o[3].w);
                *(u32x4*)nr = w0; *(u32x4*)(nr + 512) = w1; }
        }
    }
}

constexpr int PH_PER_LAYER = 8, N_PHASES = 1 + DEPTH * PH_PER_LAYER;

__global__ void __launch_bounds__(512, 2) enc_fwd(Args args) {
    extern __shared__ __attribute__((aligned(16))) unsigned char lds_raw[];
    Frame F;
    const int wave0 = __builtin_amdgcn_readfirstlane((int)threadIdx.x >> 6);
    F.lds = (LAS unsigned char*)lds_raw; F.lane = (int)__builtin_amdgcn_mbcnt_hi(~0u, __builtin_amdgcn_mbcnt_lo(~0u, 0u)); F.wave = wave0; F.tid = wave0 * 64 + F.lane; F.G = gridDim.x; F.bid = blockIdx.x;
    static_assert(sizeof(Args) == 168, "kernarg layout: in[18] | out | ws | ph_lo, ph_hi");
    F.kp = (const CAS unsigned char*)__builtin_amdgcn_kernarg_segment_ptr();
    const int lo = args.ph_lo, hi = args.ph_hi;
    volatile LAS unsigned* bst = (volatile LAS unsigned*)(F.lds + MISC_OFF + 64);
    if (F.tid < 2) bst[F.tid] = 0u;
    __syncthreads();
    XcdBarrier xbar; xbar.bar = (unsigned*)(F.ws() + WS_CTL) + CW_BAR; xbar.x = 0; xbar.st = bst;
    if (hi - lo > 1) xbar = xcd_barrier_post((unsigned*)(F.ws() + WS_CTL) + CW_BAR, bst, F.tid);
    for (int ph = lo; ph < hi; ++ph) {
        int phv = ph; asm volatile("" : "+s"(phv));
        { int lv = (int)__builtin_amdgcn_mbcnt_hi(~0u, __builtin_amdgcn_mbcnt_lo(~0u, 0u)); asm volatile("" : "+v"(lv)); F.lane = lv; F.wave = wave0; F.tid = wave0 * 64 + lv;
          int bv = blockIdx.x; asm volatile("" : "+s"(bv)); F.bid = bv;
          const CAS unsigned char* kpv = (const CAS unsigned char*)__builtin_amdgcn_kernarg_segment_ptr(); asm volatile("" : "+s"(kpv)); F.kp = kpv; }
        if (phv == 0) prologue(F);
#ifdef PROBE_VARIANT
        else if (phv >= 100) phase_mixers(F, 0, phv - 100);
#endif
        else {
            const int l = (phv - 1) / PH_PER_LAYER, k = (phv - 1) % PH_PER_LAYER;
            const int vcu = (F.G % 8 == 0) ? (F.bid % 8) * (F.G / 8) + F.bid / 8 : F.bid;
            if (k == 0) {
                { pg8::Gemm g{(const bf16_t*)(F.ws() + WS_XN), (const bf16_t*)(F.ws() + WS_WIN) + (size_t)l * NIN * DM, DM, 0}; pg8::StaticOrder S; S.init(TOK, NIN, F.G, F.bid);
                  pg8::EpiProj E{(bf16_t*)(F.ws() + WS_PROJ), (const float*)(F.ws() + WS_COS), (const float*)(F.ws() + WS_SIN), (bf16_t*)(F.ws() + WS_QKVH)};
                  pg8::gemm_phase<pg8::EpiProj, pg8::StaticOrder, true, true>(F.lds, F.tid, g, S, E); }
                if (l == 0) {
                    for (int ll = 0; ll < DEPTH; ++ll) {
                        pg8::Gemm g{(const bf16_t*)(F.ws() + WS_MEMN) + (size_t)ll * 512 * DM, (const bf16_t*)(F.ws() + WS_WMKV) + (size_t)ll * 512 * DM, DM, 0}; pg8::StaticOrder S; S.init(512, 512, F.G, (F.bid + F.G - 8 - 8 * ll) % F.G);
                        pg8::EpiBf16 E{(bf16_t*)(F.ws() + WS_MEMKV) + (size_t)ll * 512 * 512, 512, nullptr, 0, 1.0f};
                        pg8::gemm_phase<pg8::EpiBf16, pg8::StaticOrder, false, true>(F.lds, F.tid, g, S, E); }
                    { const int hb = F.G >> 1; if (F.bid >= hb) w8_static(F, 0, F.bid - hb, W8_GU_STEPS / 2, F.G - hb); }
                    { unsigned* ctl = (unsigned*)(F.ws() + WS_CTL); __syncthreads(); if (F.tid == 0) __hip_atomic_fetch_add(ctl + CW_DONE, 1u, __ATOMIC_RELAXED, __HIP_MEMORY_SCOPE_AGENT); w8_help(F, ctl + CW_W8NEXT, ctl + CW_DONE); }
                }
            } else if (k == 1) phase_mixers(F, l);
            else if (k == 2) phase_combine_norm(F, l);
            else if (k == 3) {
                pg8::Gemm g{(const bf16_t*)(F.ws() + WS_Y), (const bf16_t*)(F.ws() + WS_WOUT) + (size_t)l * DM * DM, DM, 0}; pg8::StaticOrder S; S.init(TOK, DM, F.G, F.bid);
                if (l == 0) { pg8::EpiRes<false> E{F.in(IN_X), (bf16_t*)(F.ws() + WS_X1)}; pg8::gemm_phase<pg8::EpiRes<false>, pg8::StaticOrder, false, true>(F.lds, F.tid, g, S, E); }
                else        { pg8::EpiRes<true> E{F.ws() + WS_X2, (bf16_t*)(F.ws() + WS_X1)}; pg8::gemm_phase<pg8::EpiRes<true>, pg8::StaticOrder, false, true>(F.lds, F.tid, g, S, E); }
            } else if (k == 4) { if (l == 1) w8_help(F, (unsigned*)(F.ws() + WS_CTL) + CW_W8NEXT, nullptr, W8_Q_DN0 + W8_GU_STEPS); phase_router(F, l); }
            else if (k == 5) {
                LAS int* tstart = moe_tile_table(F, l);
                pg8::MoeOrder S{tstart, 8, 4, F.G, vcu};
                LAS int* gtok = (LAS int*)(F.lds + MISC_OFF + 4096);
                { const int* elist = (const int*)(F.ws() + WS_ELIST); int tkv[9];
#pragma unroll
                  for (int i = 0; i < 9; ++i) { pg8::Unit u; const bool ok = S.next(i, u); const int ee = ok ? u.e : 0, idx = ok ? (u.pm - tstart[ee]) * 256 + (F.tid & 255) : 0;
                      const int tk = elist[(size_t)ee * TOK + idx]; tkv[i] = (ok && idx < tstart[80 + ee]) ? tk : 0; }
                  if (F.tid < 256) {
#pragma unroll
                      for (int i = 0; i < 9; ++i) gtok[i * 256 + F.tid] = tkv[i]; }
                  __syncthreads(); }
                pg8::Gemm g{(const bf16_t*)(F.ws() + WS_H2), (const bf16_t*)(F.ws() + WS_WGU + (size_t)l * NE * 2048 * DM), DM, (size_t)2048 * DM, gtok};
                pg8::EpiSwiglu E{F.ws() + WS_ACT, F.in(IN_BGU) + (size_t)l * NE * 2048, 1.0f / W8SCALE};
                pg8::gemm_phase<pg8::EpiSwiglu, pg8::MoeOrder, true, true, true, true>(F.lds, F.tid, g, S, E);
                w8_help(F, (unsigned*)(F.ws() + WS_CTL) + CW_W8NEXT, nullptr, (l == 0) ? W8_Q_DN0 : W8_Q_TOTAL);
                if (l == 0) { unsigned* ctl = (unsigned*)(F.ws() + WS_CTL); __syncthreads(); if (F.tid == 0) __hip_atomic_fetch_add(ctl + CW_DONE + 64 * 5, 1u, __ATOMIC_RELAXED, __HIP_MEMORY_SCOPE_AGENT); w8_help(F, ctl + CW_W8NEXT, ctl + CW_DONE + 64 * 5); }
            } else if (k == 6) {
                LAS int* tstart = moe_tile_table(F, l);
                pg8::Gemm g{(const bf16_t*)(F.ws() + WS_ACT), (const bf16_t*)(F.ws() + WS_WDN + (size_t)l * NE * DM * DM), DM, (size_t)DM * DM};
                pg8::MoeOrder S{tstart, 4, 8, F.G, vcu};
                pg8::EpiF8 E{F.ws() + WS_YS, DM, F.in(IN_BDN) + (size_t)l * NE * DM, DM, 1.0f / W8SCALE};
                pg8::gemm_phase<pg8::EpiF8, pg8::MoeOrder, true, true, true>(F.lds, F.tid, g, S, E);
                if (l == 0) { unsigned* ctl = (unsigned*)(F.ws() + WS_CTL); __syncthreads(); if (F.tid == 0) __hip_atomic_fetch_add(ctl + CW_DONE + 64 * 6, 1u, __ATOMIC_RELAXED, __HIP_MEMORY_SCOPE_AGENT); w8_help(F, ctl + CW_W8NEXT, ctl + CW_DONE + 64 * 6); }
            } else phase_moe_combine(F, l);
        }
        if (ph + 1 < hi) { if (lo < 0) cg::this_grid().sync(); else { xbar.bar = (unsigned*)(F.ws() + WS_CTL) + CW_BAR; xcd_barrier(xbar, F.tid); } }
    }
}

extern "C" void kernel_launch(void* const* d_in, const int* in_sizes, int n_in, void* d_out, int out_size, void* d_ws, size_t ws_size, hipStream_t stream) {
    static int grid = 0;
    if (grid == 0) {
        if (n_in != 18 || in_sizes[0] != TOK * DM || out_size != TOK * DM || ws_size < WS_END) { fprintf(stderr, "kernel_launch: unexpected shapes / workspace (n_in %d, ws %zu)\n", n_in, ws_size); grid = -1; return; }
        int dev = 0, cus = 0, per_cu = 0;
        if (hipGetDevice(&dev) != hipSuccess || hipDeviceGetAttribute(&cus, hipDeviceAttributeMultiprocessorCount, dev) != hipSuccess) { grid = -1; return; }
        if (hipFuncSetAttribute((const void*)enc_fwd, hipFuncAttributeMaxDynamicSharedMemorySize, LDS_BYTES) != hipSuccess) { fprintf(stderr, "kernel_launch: hipFuncSetAttribute failed\n"); grid = -1; return; }
        if (hipOccupancyMaxActiveBlocksPerMultiprocessor(&per_cu, (const void*)enc_fwd, 512, LDS_BYTES) != hipSuccess || per_cu < 1) { fprintf(stderr, "kernel_launch: note: occupancy query says %d blocks/CU\n", per_cu); (void)hipGetLastError(); }
        grid = cus;
    }
    if (grid < 0) return;
    (void)hipMemsetAsync((char*)d_ws + WS_CTL, 0, CTL_BYTES, stream);
    Args a{};
    for (int i = 0; i < 18; ++i) a.in[i] = (const float*)d_in[i];
    a.out = (float*)d_out; a.ws = (unsigned char*)d_ws;
#if MK_ONE_LAUNCH
    a.ph_lo = 0; a.ph_hi = N_PHASES;
    void* kargs[] = {&a};
    hipError_t e = hipLaunchCooperativeKernel((const void*)enc_fwd, dim3(grid), dim3(512), kargs, LDS_BYTES, stream);
    if (e != hipSuccess) fprintf(stderr, "cooperative launch failed: %s (grid %d)\n", hipGetErrorString(e), grid);
#else
    for (int p = 0; p < N_PHASES; ++p) { a.ph_lo = p; a.ph_hi = p + 1; hipLaunchKernelGGL(enc_fwd, dim3(grid), dim3(512), LDS_BYTES, stream, a);
#ifdef PROBE_PH
        if (p == PROBE_PH) for (int r = 0; r < PROBE_REP; ++r) {
#ifdef PROBE_VARIANT
            a.ph_lo = PROBE_VARIANT; a.ph_hi = PROBE_VARIANT + 1;
#endif
            hipLaunchKernelGGL(enc_fwd, dim3(grid), dim3(512), LDS_BYTES, stream, a); }
#endif
    }
#endif
}
```

```cpp
#include <hip/hip_runtime.h>
#include <hip/hip_cooperative_groups.h>
#include <cstdio>
#include <cstdint>
namespace cg = cooperative_groups;

#ifndef MK_ONE_LAUNCH
#define MK_ONE_LAUNCH 1
#endif

#define LAS __attribute__((address_space(3)))
typedef unsigned short bf16_t;
typedef short bf16x8 __attribute__((ext_vector_type(8)));
typedef short s16x4 __attribute__((ext_vector_type(4)));
typedef float f32x4 __attribute__((ext_vector_type(4)));
typedef float f32x2 __attribute__((ext_vector_type(2)));
typedef float f32x16 __attribute__((ext_vector_type(16)));
typedef unsigned u32x4 __attribute__((ext_vector_type(4)));
typedef unsigned u32x2 __attribute__((ext_vector_type(2)));

constexpr int BATCH = 2, SEQ = 8192, TOK = BATCH * SEQ, DM = 1024, NIN = 2048, NE = 32, TOPK = 4, NMEM = 256, DEPTH = 2;
constexpr float EPS = 1e-5f;
constexpr float QSCALE = 0.125f * 1.4426950408889634f;
constexpr int MAXT = 288;
constexpr float W8SCALE = 32.0f;

constexpr size_t MiB = 1u << 20;
constexpr size_t WS_CTL = 0, CTL_BYTES = 64 * 1024;
constexpr size_t WS_COS = 1 * MiB, WS_SIN = 2 * MiB;
constexpr size_t WS_WIN = 4 * MiB;
constexpr size_t WS_WOUT = 12 * MiB;
constexpr size_t WS_WMKV = 16 * MiB;
constexpr size_t WS_MEMKV = 18 * MiB;
constexpr size_t WS_MEMN = 20 * MiB;
constexpr size_t WS_RT = 22 * MiB;
constexpr size_t WS_LSE = 24 * MiB;
constexpr size_t WS_WGU = 32 * MiB;
constexpr size_t WS_WDN = 288 * MiB;
constexpr size_t WS_XN = 416 * MiB;
constexpr size_t WS_PROJ = 448 * MiB;
constexpr size_t WS_AO = 512 * MiB;
constexpr size_t WS_YRAW = 560 * MiB;
constexpr size_t WS_Y = 576 * MiB;
constexpr size_t WS_X1 = 608 * MiB;
constexpr size_t WS_X2 = 672 * MiB;
constexpr size_t WS_H2 = 736 * MiB;
constexpr size_t WS_ASLOT = 768 * MiB;
constexpr size_t WS_PWT = WS_ASLOT + 1 * MiB;
constexpr size_t WS_RS = WS_ASLOT;
constexpr size_t WS_ACT = 912 * MiB;
constexpr size_t WS_YS = 1056 * MiB;
constexpr size_t WS_QKVH = 1200 * MiB;
constexpr size_t WS_ELIST = 1248 * MiB;
constexpr size_t WS_END = 1252 * MiB;
constexpr int CW_CNT = 1024;
constexpr int CW_BAR = 4096;
constexpr int CW_W8NEXT = 2048;
constexpr int CW_DONE = 2112;

constexpr int RING_BYTES = 131072, MISC_OFF = RING_BYTES, LDS_BYTES = 147456;

__device__ __forceinline__ unsigned cvtpk(float lo, float hi) { typedef __bf16 bf2 __attribute__((ext_vector_type(2))); f32x2 v = {lo, hi}; bf2 b = __builtin_convertvector(v, bf2); return __builtin_bit_cast(unsigned, b); }
__device__ __forceinline__ float bflo(unsigned u) { return __uint_as_float(u << 16); }
__device__ __forceinline__ float bfhi(unsigned u) { return __uint_as_float(u & 0xffff0000u); }
__device__ __forceinline__ float bf1(bf16_t u) { return __uint_as_float(((unsigned)u) << 16); }
__device__ __forceinline__ bf16_t f2bf(float f) { return (bf16_t)(cvtpk(f, 0.f) & 0xffffu); }
template <int M> __device__ __forceinline__ int swz_i(int v) { constexpr int ctrl = (M == 1) ? 0xB1 : (M == 2) ? 0x4E : (M == 4) ? 0x141 : 0x140; static_assert(M == 1 || M == 2 || M == 4 || M == 8, "dpp step");
    return __builtin_amdgcn_update_dpp(v, v, ctrl, 0xf, 0xf, true); }
template <int M> __device__ __forceinline__ float swz_f(float v) { return __int_as_float(swz_i<M>(__float_as_int(v))); }
__device__ __forceinline__ float xor16_sum(float v) { auto r = __builtin_amdgcn_permlane16_swap(__float_as_uint(v), __float_as_uint(v), false, false); return __uint_as_float(r[0]) + __uint_as_float(r[1]); }
__device__ __forceinline__ float xor32_sum(float v) { auto r = __builtin_amdgcn_permlane32_swap(__float_as_uint(v), __float_as_uint(v), false, false); return __uint_as_float(r[0]) + __uint_as_float(r[1]); }
__device__ __forceinline__ float xor32_max(float v) { auto r = __builtin_amdgcn_permlane32_swap(__float_as_uint(v), __float_as_uint(v), false, false); return fmaxf(__uint_as_float(r[0]), __uint_as_float(r[1])); }
__device__ __forceinline__ float wave_sum(float v) {
    v += swz_f<1>(v); v += swz_f<2>(v); v += swz_f<4>(v); v += swz_f<8>(v);
    return xor32_sum(xor16_sum(v));
}
#define LDS_WAIT() asm volatile("s_waitcnt lgkmcnt(0)" ::: "memory")

namespace pg8 {
typedef int i32x4_t __attribute__((ext_vector_type(4)));
typedef int i32x8_t __attribute__((ext_vector_type(8)));
constexpr int BM = 256, BK = 64, HALF = 128, HTB = HALF * BK * 2, STAGE_BYTES = 8 * HTB, NXCD = 8, WGM = 4;
__host__ __device__ __forceinline__ int lds_byte(int r, int c) { const int st = (r >> 4) * 2 + (c >> 5), rr = r & 15, cc = c & 31, ob = rr * 64 + cc * 2; return st * 1024 + (ob ^ (((ob >> 9) & 1) << 5)); }
__host__ __device__ __forceinline__ void stage_rc(int b, int& R, int& C) { const int st = b / 1024, sb = b % 1024, swz = sb ^ (((sb >> 9) & 1) << 5); R = (st >> 1) * 16 + swz / 64; C = (st & 1) * 32 + (swz % 64) / 2; }
__host__ __device__ __forceinline__ int perm32(int rho) { const int n = rho >> 4, i = rho & 15; return 8 * (i >> 2) + 4 * n + (i & 3); }

struct Unit { int pm, pn, e; };
struct Gemm { const bf16_t* A; const bf16_t* Bt; int K; size_t ebytes; const LAS int* gtok; };

struct StaticOrder {
    int nM, nN, nwg, G, c;
    __device__ void init(int M, int N, int G_, int c_) { nM = M / BM; nN = N / BM; nwg = nM * nN; G = G_; c = c_; }
    __device__ bool next(int i, Unit& u) const {
        const long L = (long)i * G + c; if (L >= nwg) return false;
        int wgid = (int)L; { const int q = nwg / NXCD, r = nwg % NXCD, xcd = wgid % NXCD, off = wgid / NXCD; wgid = (xcd < r ? xcd * (q + 1) : r * (q + 1) + (xcd - r) * q) + off; }
        const int nig = WGM * nN, gid = wgid / nig, fm = gid * WGM, gsz = (nM - fm) < WGM ? (nM - fm) : WGM;
        u.pm = fm + ((wgid % nig) % gsz); u.pn = (wgid % nig) / gsz; u.e = 0; return true;
    }
};
struct MoeOrder {
    const LAS int* tstart; int nN, GM, G, c;
    __device__ bool next(int i, Unit& u) const {
        const int total = tstart[32] * nN; long L;
        if (G == 256) { const int R = (((total + 31) >> 5) + 7) >> 3; if (i >= R) return false; L = (long)((c >> 5) * R + i) * 32 + (c & 31); } else L = (long)i * G + c;
        if (L >= total) return false;
        const int pmL = (int)L / nN; int e = 0;
#pragma unroll
        for (int k = 1; k < 32; ++k) e += (tstart[k] <= pmL) ? 1 : 0;
        const int t0 = tstart[e], mt = tstart[e + 1] - t0, w = (int)L - t0 * nN;
        const int grp = w / (GM * nN), wg = w - grp * GM * nN, rem = mt - grp * GM, gsz = rem < GM ? rem : GM;
        u.pm = __builtin_amdgcn_readfirstlane(t0 + grp * GM + wg % gsz); u.pn = __builtin_amdgcn_readfirstlane(wg / gsz); u.e = __builtin_amdgcn_readfirstlane(e); return true;
    }
};


__device__ __forceinline__ u32x4 pair16(u32x2 a, u32x2 b) {
    const auto rx = __builtin_amdgcn_permlane16_swap(a.x, b.x, false, false); const auto ry = __builtin_amdgcn_permlane16_swap(a.y, b.y, false, false);
    return (u32x4){rx[0], ry[0], rx[1], ry[1]};
}
struct EpiProj {
    static constexpr bool PERM = true, AFTER_DRAIN = false;
    bf16_t* O; const float* cs; const float* sn; bf16_t* QH; const float* rs;
    __device__ __forceinline__ void operator()(const f32x4 (&acc)[2][2][4][2], const Unit& u, int wr, int wc, int fr, int fq) const {
        const int row0 = u.pm * BM + wr * 64 + fr, colb = u.pn * BM + wc * 32 + 8 * fq;
        float rsv[2][4];
#pragma unroll
        for (int ai = 0; ai < 2; ++ai)
#pragma unroll
            for (int m = 0; m < 4; ++m) rsv[ai][m] = rs[row0 + ai * HALF + m * 16];
        if (u.pn < 4) {
            const float sc = (u.pn < 2) ? QSCALE : 1.f;
#pragma unroll
            for (int ai = 0; ai < 2; ++ai) {
                f32x4 cv[4][2], sv[4][2];
#pragma unroll
                for (int m = 0; m < 4; ++m) { const int pos = (row0 + ai * HALF + m * 16) & (SEQ - 1);
#pragma unroll
                    for (int bj = 0; bj < 2; ++bj) { const int g8 = ((colb + bj * HALF) & 63) >> 3; cv[m][bj] = *(const f32x4*)(cs + pos * 32 + g8 * 4); sv[m][bj] = *(const f32x4*)(sn + pos * 32 + g8 * 4); } }
#pragma unroll
                for (int mp = 0; mp < 2; ++mp)
#pragma unroll
                    for (int bj = 0; bj < 2; ++bj) { const int col = colb + bj * HALF, head = col >> 6, g8 = (col & 63) >> 3;
                        u32x2 w1[2], w2[2];
#pragma unroll
                        for (int q = 0; q < 2; ++q) { const int m = 2 * mp + q; const f32x4 c = cv[m][bj], s = sv[m][bj];
                            const f32x4 t1 = acc[ai][bj][m][0], t2 = acc[ai][bj][m][1];
                            const float scr = sc * rsv[ai][m];
                            const f32x4 o1 = (t1 * c - t2 * s) * scr, o2 = (t1 * s + t2 * c) * scr;
                            w1[q].x = cvtpk(o1[0], o1[1]); w1[q].y = cvtpk(o1[2], o1[3]); w2[q].x = cvtpk(o2[0], o2[1]); w2[q].y = cvtpk(o2[2], o2[3]); }
                        const int msel = 2 * mp + (fq & 1), row = row0 + ai * HALF + msel * 16, pos = row & (SEQ - 1);
                        bf16_t* p = QH + ((size_t)((((head >> 3) * 2 + (row >> 13)) * 8 + (head & 7))) * SEQ + pos) * 64 + (g8 & ~1) * 4;
                        *(u32x4*)p = pair16(w1[0], w1[1]); *(u32x4*)(p + 32) = pair16(w2[0], w2[1]); }
                asm volatile("" ::: "memory");
            }
        } else if (u.pn < 6) {
#pragma unroll
            for (int ai = 0; ai < 2; ++ai)
#pragma unroll
                for (int m = 0; m < 4; ++m) { const int row = row0 + ai * HALF + m * 16;
#pragma unroll
                    for (int bj = 0; bj < 2; ++bj) { const int col = colb + bj * HALF - 1024, hh = col >> 6; const f32x4 v0 = acc[ai][bj][m][0] * rsv[ai][m], v1 = acc[ai][bj][m][1] * rsv[ai][m];
                        u32x4 w; w.x = cvtpk(v0[0], v0[1]); w.y = cvtpk(v0[2], v0[3]); w.z = cvtpk(v1[0], v1[1]); w.w = cvtpk(v1[2], v1[3]);
                        *(u32x4*)(QH + ((size_t)(((4 + (row >> 13)) * 8 + hh)) * SEQ + (row & (SEQ - 1))) * 64 + (col & 63)) = w; } }
        } else {
            const float sc = (u.pn == 7) ? QSCALE : 1.f;
#pragma unroll
            for (int ai = 0; ai < 2; ++ai)
#pragma unroll
                for (int m = 0; m < 4; ++m) { bf16_t* rowp = O + (size_t)(row0 + ai * HALF + m * 16) * NIN + colb;
#pragma unroll
                    for (int bj = 0; bj < 2; ++bj) { const float scr = sc * rsv[ai][m]; const f32x4 v0 = acc[ai][bj][m][0] * scr, v1 = acc[ai][bj][m][1] * scr;
                        u32x4 w; w.x = cvtpk(v0[0], v0[1]); w.y = cvtpk(v0[2], v0[3]); w.z = cvtpk(v1[0], v1[1]); w.w = cvtpk(v1[2], v1[3]);
                        *(u32x4*)(rowp + bj * HALF) = w; } }
        }
    }
};
struct EpiBf16 {
    static constexpr bool PERM = true, AFTER_DRAIN = false;
    bf16_t* O; int ldc; const float* bias; int bias_estride; float scale;
    __device__ __forceinline__ void operator()(const f32x4 (&acc)[2][2][4][2], const Unit& u, int wr, int wc, int fr, int fq) const {
        const int row0 = u.pm * BM + wr * 64 + fr, col0 = u.pn * BM + wc * 32 + 8 * fq;
        f32x4 bv[2][2];
#pragma unroll
        for (int bj = 0; bj < 2; ++bj)
#pragma unroll
            for (int n = 0; n < 2; ++n) bv[bj][n] = bias ? *(const f32x4*)(bias + (size_t)u.e * bias_estride + col0 + bj * HALF + 4 * n) : (f32x4){0.f, 0.f, 0.f, 0.f};
#pragma unroll
        for (int ai = 0; ai < 2; ++ai)
#pragma unroll
            for (int m = 0; m < 4; ++m) { bf16_t* rowp = O + (size_t)(row0 + ai * HALF + m * 16) * ldc + col0;
#pragma unroll
                for (int bj = 0; bj < 2; ++bj) { const f32x4 v0 = acc[ai][bj][m][0] * scale + bv[bj][0], v1 = acc[ai][bj][m][1] * scale + bv[bj][1];
                    u32x4 w; w.x = cvtpk(v0[0], v0[1]); w.y = cvtpk(v0[2], v0[3]); w.z = cvtpk(v1[0], v1[1]); w.w = cvtpk(v1[2], v1[3]);
                    *(u32x4*)(rowp + bj * HALF) = w; } }
    }
};
struct EpiF8 {
    static constexpr bool PERM = true, AFTER_DRAIN = false;
    unsigned char* O; int ldc; const float* bias; int bias_estride; float scale;
    __device__ __forceinline__ void operator()(const f32x4 (&acc)[2][2][4][2], const Unit& u, int wr, int wc, int fr, int fq) const {
        const int row0 = u.pm * BM + wr * 64 + fr, col0 = u.pn * BM + wc * 32 + 8 * fq;
        f32x4 bv[2][2];
#pragma unroll
        for (int bj = 0; bj < 2; ++bj)
#pragma unroll
            for (int n = 0; n < 2; ++n) bv[bj][n] = *(const f32x4*)(bias + (size_t)u.e * bias_estride + col0 + bj * HALF + 4 * n);
#pragma unroll
        for (int ai = 0; ai < 2; ++ai)
#pragma unroll
            for (int mp = 0; mp < 2; ++mp)
#pragma unroll
                for (int bj = 0; bj < 2; ++bj) { u32x2 w[2];
#pragma unroll
                    for (int q = 0; q < 2; ++q) { const int m = 2 * mp + q; const f32x4 v0 = acc[ai][bj][m][0] * scale + bv[bj][0], v1 = acc[ai][bj][m][1] * scale + bv[bj][1];
                        int w0 = 0, w1 = 0; w0 = __builtin_amdgcn_cvt_pk_fp8_f32(v0[0], v0[1], w0, false); w0 = __builtin_amdgcn_cvt_pk_fp8_f32(v0[2], v0[3], w0, true);
                        w1 = __builtin_amdgcn_cvt_pk_fp8_f32(v1[0], v1[1], w1, false); w1 = __builtin_amdgcn_cvt_pk_fp8_f32(v1[2], v1[3], w1, true);
                        w[q].x = (unsigned)w0; w[q].y = (unsigned)w1; }
                    const int msel = 2 * mp + (fq & 1);
                    *(u32x4*)(O + (size_t)(row0 + ai * HALF + msel * 16) * ldc + u.pn * BM + wc * 32 + 8 * (fq & ~1) + bj * HALF) = pair16(w[0], w[1]); }
    }
};
struct EpiSwiglu {
    static constexpr bool PERM = true, AFTER_DRAIN = false;
    unsigned char* O; const float* bias; float scale;
    __device__ __forceinline__ static float act1(float g, float up) {
        g = fminf(g, 7.0f); up = fminf(fmaxf(up, -7.0f), 7.0f);
        const float sg = __builtin_amdgcn_rcpf(1.0f + __builtin_amdgcn_exp2f(g * (-1.702f * 1.4426950408889634f)));
        return (up + 1.0f) * g * sg;
    }
    __device__ __forceinline__ static f32x2 act2(f32x2 g, f32x2 up) {
        g.x = fminf(g.x, 7.0f); g.y = fminf(g.y, 7.0f); up.x = fminf(fmaxf(up.x, -7.0f), 7.0f); up.y = fminf(fmaxf(up.y, -7.0f), 7.0f);
        const f32x2 z = g * (-1.702f * 1.4426950408889634f); f32x2 e; e.x = __builtin_amdgcn_exp2f(z.x); e.y = __builtin_amdgcn_exp2f(z.y);
        const f32x2 d = e + 1.0f; f32x2 r; r.x = __builtin_amdgcn_rcpf(d.x); r.y = __builtin_amdgcn_rcpf(d.y);
        return (up + 1.0f) * g * r;
    }
    __device__ __forceinline__ void operator()(const f32x4 (&acc)[2][2][4][2], const Unit& u, int wr, int wc, int fr, int fq) const {
        const int row0 = u.pm * BM + wr * 64 + fr, j0 = u.pn * HALF + wc * 32 + 8 * fq;
        const float* bg = bias + (size_t)u.e * 2048 + j0; const float* bu = bg + 1024;
        const f32x4 bg0 = *(const f32x4*)bg, bg1 = *(const f32x4*)(bg + 4), bu0 = *(const f32x4*)bu, bu1 = *(const f32x4*)(bu + 4);
#pragma unroll
        for (int ai = 0; ai < 2; ++ai)
#pragma unroll
            for (int mp = 0; mp < 2; ++mp) { u32x2 w[2];
#pragma unroll
                for (int q = 0; q < 2; ++q) { const int m = 2 * mp + q;
                    const f32x4 g0 = acc[ai][0][m][0] * scale + bg0, g1 = acc[ai][0][m][1] * scale + bg1, u0 = acc[ai][1][m][0] * scale + bu0, u1 = acc[ai][1][m][1] * scale + bu1;
                    int w0 = 0, w1 = 0;
                    const f32x2 a0 = act2((f32x2){g0[0], g0[1]}, (f32x2){u0[0], u0[1]}), a1 = act2((f32x2){g0[2], g0[3]}, (f32x2){u0[2], u0[3]}), a2 = act2((f32x2){g1[0], g1[1]}, (f32x2){u1[0], u1[1]}), a3 = act2((f32x2){g1[2], g1[3]}, (f32x2){u1[2], u1[3]});
                    w0 = __builtin_amdgcn_cvt_pk_fp8_f32(a0.x, a0.y, w0, false); w0 = __builtin_amdgcn_cvt_pk_fp8_f32(a1.x, a1.y, w0, true);
                    w1 = __builtin_amdgcn_cvt_pk_fp8_f32(a2.x, a2.y, w1, false); w1 = __builtin_amdgcn_cvt_pk_fp8_f32(a3.x, a3.y, w1, true);
                    w[q].x = (unsigned)w0; w[q].y = (unsigned)w1; }
                const int msel = 2 * mp + (fq & 1);
                *(u32x4*)(O + (size_t)(row0 + ai * HALF + msel * 16) * DM + u.pn * HALF + wc * 32 + 8 * (fq & ~1)) = pair16(w[0], w[1]); }
    }
};
template <bool BASE_BF16>
struct EpiRes {
    static constexpr bool PERM = true, AFTER_DRAIN = false;
    const void* base; bf16_t* out;
    __device__ __forceinline__ void operator()(const f32x4 (&acc)[2][2][4][2], const Unit& u, int wr, int wc, int fr, int fq) const {
        const int row0 = u.pm * BM + wr * 64 + fr, col0 = u.pn * BM + wc * 32 + 8 * fq;
        if constexpr (BASE_BF16) {
            u32x4 rr[2][4][2];
#pragma unroll
            for (int ai = 0; ai < 2; ++ai)
#pragma unroll
                for (int m = 0; m < 4; ++m) { const size_t off = (size_t)(row0 + ai * HALF + m * 16) * DM + col0;
#pragma unroll
                    for (int bj = 0; bj < 2; ++bj) rr[ai][m][bj] = __builtin_nontemporal_load((const u32x4*)((const bf16_t*)base + off + bj * HALF)); }
#pragma unroll
            for (int ai = 0; ai < 2; ++ai)
#pragma unroll
                for (int m = 0; m < 4; ++m) { const size_t off = (size_t)(row0 + ai * HALF + m * 16) * DM + col0;
#pragma unroll
                    for (int bj = 0; bj < 2; ++bj) { const u32x4 r = rr[ai][m][bj];
                        const f32x4 v0 = (f32x4){bflo(r.x), bfhi(r.x), bflo(r.y), bfhi(r.y)} + acc[ai][bj][m][0], v1 = (f32x4){bflo(r.z), bfhi(r.z), bflo(r.w), bfhi(r.w)} + acc[ai][bj][m][1];
                        u32x4 w; w.x = cvtpk(v0[0], v0[1]); w.y = cvtpk(v0[2], v0[3]); w.z = cvtpk(v1[0], v1[1]); w.w = cvtpk(v1[2], v1[3]);
                        *(u32x4*)(out + off + bj * HALF) = w; } }
        } else {
#pragma unroll
        for (int ai = 0; ai < 2; ++ai) {
            f32x4 bs[4][2][2];
#pragma unroll
            for (int m = 0; m < 4; ++m) { const size_t off = (size_t)(row0 + ai * HALF + m * 16) * DM + col0;
#pragma unroll
                for (int bj = 0; bj < 2; ++bj) { bs[m][bj][0] = __builtin_nontemporal_load((const f32x4*)((const float*)base + off + bj * HALF)); bs[m][bj][1] = __builtin_nontemporal_load((const f32x4*)((const float*)base + off + bj * HALF + 4)); } }
#pragma unroll
            for (int m = 0; m < 4; ++m) { const size_t off = (size_t)(row0 + ai * HALF + m * 16) * DM + col0;
#pragma unroll
                for (int bj = 0; bj < 2; ++bj) { const f32x4 v0 = bs[m][bj][0] + acc[ai][bj][m][0], v1 = bs[m][bj][1] + acc[ai][bj][m][1];
                    u32x4 w; w.x = cvtpk(v0[0], v0[1]); w.y = cvtpk(v0[2], v0[3]); w.z = cvtpk(v1[0], v1[1]); w.w = cvtpk(v1[2], v1[3]);
                    *(u32x4*)(out + off + bj * HALF) = w; } }
            asm volatile("" ::: "memory");
        }
        }
    }
};

template <class Epi, class Sched, bool ALIGN_EPI = false, bool SP2 = true, bool FP8 = false, bool GATHER = false>
__device__ __forceinline__ void gemm_phase(LAS unsigned char* lds, const int tid, const Gemm g, const Sched& S, const Epi& E) {
    const int wid = __builtin_amdgcn_readfirstlane(tid >> 6), lane = tid & 63, wr = wid >> 2, wc = wid & 3, fr = lane & 15, fq = lane >> 4;
    const int K = g.K, rowb = FP8 ? K : 2 * K, nt = rowb / 128;
    unsigned voffA[2], voffB[2];
#pragma unroll
    for (int i = 0; i < 2; ++i) { int R, C; stage_rc(tid * 16 + i * 8192, R, C); const int Rb = Epi::PERM ? ((R & ~31) + perm32(R & 31)) : R;
        voffA[i] = (unsigned)(R * rowb + C * 2); voffB[i] = (unsigned)(Rb * rowb + C * 2); }
    const size_t kstep = (size_t)(BK * 2);
    const size_t hstep = (size_t)HALF * rowb;
    const size_t tstep = 2 * hstep;
    const unsigned ldsw = (unsigned)wid * 1024u;
    const int aoff = lds_byte(wr * 64 + fr, fq * 8), boff = lds_byte(wc * 32 + fr, fq * 8);
#define PG8_SA(b, h) (((b) * 2 + (h)) * HTB)
#define PG8_SB(b, h) ((4 + (b) * 2 + (h)) * HTB)
#define PG8_STAGE(bufoff, gbase, voff) do { _Pragma("unroll") for (int _i = 0; _i < 2; ++_i) \
        __builtin_amdgcn_global_load_lds((const unsigned*)((const char*)(gbase) + (voff)[_i]), (LAS unsigned*)(lds + (bufoff) + ldsw + _i * 8192), 16, 0, 0); } while (0)
#define PG8_STAGE_A(bufoff, gbase, h, nx) do { if constexpr (GATHER) { unsigned vo_[2]; vo_[0] = (nx) ? gAn[h][0] : gAc[h][0]; vo_[1] = (nx) ? gAn[h][1] : gAc[h][1]; PG8_STAGE(bufoff, gbase, vo_); } \
        else PG8_STAGE(bufoff, (gbase) + (h) * hstep, voffA); } while (0)
#define PG8_LDA(dst, b, h) do { if constexpr (FP8) { _Pragma("unroll") for (int m = 0; m < 4; ++m) { const i32x4_t lo_ = *(const LAS i32x4_t*)(lds + PG8_SA(b, h) + aoff + m * 2048), hi_ = *(const LAS i32x4_t*)(lds + PG8_SA(b, h) + aoff + m * 2048 + 1024); \
            dst##8[m] = __builtin_shufflevector(lo_, hi_, 0, 1, 2, 3, 4, 5, 6, 7); } } \
        else { _Pragma("unroll") for (int m = 0; m < 4; ++m) _Pragma("unroll") for (int k = 0; k < 2; ++k) dst[m][k] = *(const LAS bf16x8*)(lds + PG8_SA(b, h) + aoff + m * 2048 + k * 1024); } } while (0)
#define PG8_LDB(dst, b, h) do { if constexpr (FP8) { _Pragma("unroll") for (int n = 0; n < 2; ++n) { const i32x4_t lo_ = *(const LAS i32x4_t*)(lds + PG8_SB(b, h) + boff + n * 2048), hi_ = *(const LAS i32x4_t*)(lds + PG8_SB(b, h) + boff + n * 2048 + 1024); \
            dst##8[n] = __builtin_shufflevector(lo_, hi_, 0, 1, 2, 3, 4, 5, 6, 7); } } \
        else { _Pragma("unroll") for (int n = 0; n < 2; ++n) _Pragma("unroll") for (int k = 0; k < 2; ++k) dst[n][k] = *(const LAS bf16x8*)(lds + PG8_SB(b, h) + boff + n * 2048 + k * 1024); } } while (0)
#define PG8_MMA(ai, bj, At, Bt) do { __builtin_amdgcn_s_setprio(1); \
        if constexpr (FP8) { _Pragma("unroll") for (int m = 0; m < 4; ++m) _Pragma("unroll") for (int n = 0; n < 2; ++n) \
            asm volatile("v_mfma_scale_f32_16x16x128_f8f6f4 %0, %1, %2, %0, %3, %3 op_sel_hi:[0,0,0]" : "+v"(acc[ai][bj][m][n]) : "v"(Bt##8[n]), "v"(At##8[m]), "v"(0x7f7f7f7f)); } \
        else { _Pragma("unroll") for (int m = 0; m < 4; ++m) _Pragma("unroll") for (int n = 0; n < 2; ++n) _Pragma("unroll") for (int k = 0; k < 2; ++k) \
            acc[ai][bj][m][n] = __builtin_amdgcn_mfma_f32_16x16x32_bf16(Bt[n][k], At[m][k], acc[ai][bj][m][n], 0, 0, 0); } \
        __builtin_amdgcn_s_setprio(0); } while (0)
#define PG8_WAIT_V(n) asm volatile("s_waitcnt vmcnt(" #n ")" ::: "memory")
#define PG8_WAIT_L(n) asm volatile("s_waitcnt lgkmcnt(" #n ")" ::: "memory")
#define PG8_BAR __builtin_amdgcn_s_barrier()
#define PG8_SCHED __builtin_amdgcn_sched_barrier(0)
#define PG8_UA(u) (GATHER ? (const char*)g.A : (const char*)g.A + (size_t)(u).pm * tstep)
    unsigned gAc[2][2], gAn[2][2];
#define PG8_GLOAD(dst, ui_) do { if constexpr (GATHER) { _Pragma("unroll") for (int h = 0; h < 2; ++h) _Pragma("unroll") for (int i = 0; i < 2; ++i) { int R, C; stage_rc(tid * 16 + i * 8192, R, C); \
            dst[h][i] = (unsigned)(g.gtok[(ui_) * 256 + h * HALF + R] * rowb + C * 2); } } } while (0)
#define PG8_UB(u) ((const char*)g.Bt + (size_t)(u).e * g.ebytes + (size_t)(u).pn * tstep)
    Unit cur, nxt; int ui = 0;
    if (!S.next(0, cur)) return;
    f32x4 acc[2][2][4][2];
#pragma unroll
    for (int a = 0; a < 2; ++a)
#pragma unroll
        for (int b = 0; b < 2; ++b)
#pragma unroll
            for (int m = 0; m < 4; ++m)
#pragma unroll
                for (int n = 0; n < 2; ++n) acc[a][b][m][n] = (f32x4){0.f, 0.f, 0.f, 0.f};
    bf16x8 At[4][2], B0[2][2], B1[2][2]; i32x8_t At8[4], B08[2], B18[2];
    const char* cA = PG8_UA(cur); const char* cB = PG8_UB(cur);
    PG8_GLOAD(gAc, 0);
    if constexpr (SP2) {
        PG8_STAGE(PG8_SB(0, 0), cB, voffB); PG8_STAGE(PG8_SB(0, 1), cB + hstep, voffB); PG8_STAGE_A(PG8_SA(0, 0), cA, 0, false); PG8_STAGE_A(PG8_SA(0, 1), cA, 1, false);
        if (wr == 1) PG8_BAR;
        PG8_WAIT_V(2); PG8_BAR;
        PG8_STAGE(PG8_SB(1, 0), cB + kstep, voffB); PG8_STAGE_A(PG8_SA(1, 0), cA + kstep, 0, false); PG8_STAGE(PG8_SB(1, 1), cB + hstep + kstep, voffB);
        PG8_WAIT_V(6); PG8_BAR;
    } else {
        PG8_STAGE(PG8_SB(0, 0), cB, voffB); PG8_STAGE_A(PG8_SA(0, 0), cA, 0, false); PG8_STAGE(PG8_SB(0, 1), cB + hstep, voffB); PG8_STAGE_A(PG8_SA(0, 1), cA, 1, false);
        if (wr == 1) PG8_BAR;
        PG8_WAIT_V(4); PG8_BAR;
        PG8_STAGE(PG8_SB(1, 0), cB + kstep, voffB); PG8_STAGE_A(PG8_SA(1, 0), cA + kstep, 0, false); PG8_STAGE(PG8_SB(1, 1), cB + hstep + kstep, voffB);
        PG8_WAIT_V(6); PG8_BAR;
    }
    for (;;) {
        const bool has_next = S.next(ui + 1, nxt);
        if constexpr (GATHER) { if (has_next) PG8_GLOAD(gAn, ui + 1); else { gAn[0][0] = gAc[0][0]; gAn[0][1] = gAc[0][1]; gAn[1][0] = gAc[1][0]; gAn[1][1] = gAc[1][1]; } }
        const char* nA = has_next ? PG8_UA(nxt) : cA; const char* nB = has_next ? PG8_UB(nxt) : cB;
#pragma unroll 1
        for (int t = 0; t < nt; t += 2) {
            const bool last = (t == nt - 2);
            const char* a1 = cA + (size_t)(t + 1) * kstep;
            const char* a2 = last ? nA : cA + (size_t)(t + 2) * kstep; const char* b2 = last ? nB : cB + (size_t)(t + 2) * kstep;
            const char* a3 = a2 + kstep; const char* b3 = b2 + kstep;
            if constexpr (SP2) {
            PG8_LDB(B0, 0, 0); PG8_LDB(B1, 0, 1); PG8_SCHED; PG8_LDA(At, 0, 0); PG8_STAGE_A(PG8_SA(1, 1), a1, 1, false);
            PG8_WAIT_V(8); PG8_WAIT_L(0); PG8_BAR; PG8_MMA(0, 0, At, B0); PG8_MMA(0, 1, At, B1); PG8_BAR; PG8_SCHED;
            PG8_LDA(At, 0, 1); PG8_STAGE(PG8_SB(0, 0), b2, voffB); PG8_STAGE(PG8_SB(0, 1), b2 + hstep, voffB); PG8_STAGE_A(PG8_SA(0, 0), a2, 0, last);
            PG8_WAIT_V(8); PG8_WAIT_L(0); PG8_BAR; PG8_MMA(1, 0, At, B0); PG8_MMA(1, 1, At, B1); PG8_BAR; PG8_SCHED;
            PG8_LDB(B0, 1, 0); PG8_LDB(B1, 1, 1); PG8_SCHED; PG8_LDA(At, 1, 0); PG8_STAGE_A(PG8_SA(0, 1), a2, 1, last);
            PG8_WAIT_V(8); PG8_WAIT_L(0); PG8_BAR; PG8_MMA(0, 0, At, B0); PG8_MMA(0, 1, At, B1); PG8_BAR; PG8_SCHED;
            PG8_LDA(At, 1, 1); PG8_STAGE(PG8_SB(1, 0), b3, voffB); PG8_STAGE(PG8_SB(1, 1), b3 + hstep, voffB); PG8_STAGE_A(PG8_SA(1, 0), a3, 0, last);
            PG8_WAIT_V(8); PG8_WAIT_L(0); PG8_BAR; PG8_MMA(1, 0, At, B0); PG8_MMA(1, 1, At, B1); PG8_BAR; PG8_SCHED;
            } else {
            PG8_LDB(B0, 0, 0); PG8_SCHED; PG8_LDA(At, 0, 0); PG8_STAGE_A(PG8_SA(1, 1), a1, 1, false);
            PG8_WAIT_L(8); PG8_BAR; PG8_WAIT_L(0); PG8_MMA(0, 0, At, B0); PG8_BAR; PG8_SCHED;
            PG8_LDB(B1, 0, 1); PG8_STAGE(PG8_SB(0, 0), b2, voffB);
            PG8_BAR; PG8_WAIT_L(0); PG8_MMA(0, 1, At, B1); PG8_BAR;
            PG8_LDA(At, 0, 1); PG8_STAGE_A(PG8_SA(0, 0), a2, 0, last);
            PG8_BAR; PG8_WAIT_L(0); PG8_MMA(1, 0, At, B0); PG8_BAR; PG8_SCHED;
            PG8_STAGE(PG8_SB(0, 1), b2 + hstep, voffB);
            PG8_WAIT_V(6); PG8_BAR; PG8_MMA(1, 1, At, B1); PG8_BAR;
            PG8_LDB(B0, 1, 0); PG8_SCHED; PG8_LDA(At, 1, 0); PG8_STAGE_A(PG8_SA(0, 1), a2, 1, last);
            PG8_WAIT_L(8); PG8_BAR; PG8_WAIT_L(0); PG8_MMA(0, 0, At, B0); PG8_BAR; PG8_SCHED;
            PG8_LDB(B1, 1, 1); PG8_STAGE(PG8_SB(1, 0), b3, voffB);
            PG8_BAR; PG8_WAIT_L(0); PG8_MMA(0, 1, At, B1); PG8_BAR;
            PG8_LDA(At, 1, 1); PG8_STAGE_A(PG8_SA(1, 0), a3, 0, last);
            PG8_BAR; PG8_WAIT_L(0); PG8_MMA(1, 0, At, B0); PG8_BAR; PG8_SCHED;
            PG8_STAGE(PG8_SB(1, 1), b3 + hstep, voffB);
            PG8_WAIT_V(6); PG8_BAR; PG8_MMA(1, 1, At, B1); PG8_BAR;
            }
        }
        if constexpr (ALIGN_EPI) { if (wr == 0) PG8_BAR; }
        if constexpr (FP8) asm volatile("s_nop 15\n\ts_nop 15" ::: "memory");
        E(acc, cur, wr, wc, fr, fq);
        if (!has_next) break;
#pragma unroll
        for (int a = 0; a < 2; ++a)
#pragma unroll
            for (int b = 0; b < 2; ++b)
#pragma unroll
                for (int m = 0; m < 4; ++m)
#pragma unroll
                    for (int n = 0; n < 2; ++n) acc[a][b][m][n] = (f32x4){0.f, 0.f, 0.f, 0.f};
        cur = nxt; cA = nA; cB = nB; ++ui;
        if constexpr (GATHER) { gAc[0][0] = gAn[0][0]; gAc[0][1] = gAn[0][1]; gAc[1][0] = gAn[1][0]; gAc[1][1] = gAn[1][1]; }
        if constexpr (ALIGN_EPI) { if (wr == 1) PG8_BAR; }
    }
    PG8_WAIT_V(0);
    if constexpr (!ALIGN_EPI) { if (wr == 0) PG8_BAR; }
    PG8_BAR;
#undef PG8_SA
#undef PG8_SB
#undef PG8_STAGE
#undef PG8_STAGE_A
#undef PG8_GLOAD
#undef PG8_LDA
#undef PG8_LDB
#undef PG8_MMA
#undef PG8_WAIT_V
#undef PG8_WAIT_L
#undef PG8_BAR
#undef PG8_SCHED
#undef PG8_UA
#undef PG8_UB
}
}


#define XB_TMO      128
#define XB_XCNT(j)  (256  + 64 * (j))
#define XB_XSUB(j)  (1280 + 64 * (j))
#define XB_XGEN(j)  (2304 + 64 * (j))
#define XB_TOP      3328
#define XB_TOPGEN   3392
#define XCD_BAR_WORDS 3456
#define XB_SPIN_CAP (1u << 18)
__device__ __forceinline__ unsigned xb_ld(unsigned* p)              { return __hip_atomic_load(p, __ATOMIC_RELAXED, __HIP_MEMORY_SCOPE_AGENT); }
__device__ __forceinline__ unsigned xb_add(unsigned* p, unsigned v) { return __hip_atomic_fetch_add(p, v, __ATOMIC_RELAXED, __HIP_MEMORY_SCOPE_AGENT); }
__device__ __forceinline__ unsigned xb_xcc_id() { return (unsigned)__builtin_amdgcn_s_getreg((3 << 11) | 20) & 0xFu; }
#define XB_SPIN(cond, bar) do { unsigned _sp = 0; while (cond) { __builtin_amdgcn_s_sleep(1); \
    if ((++_sp & 255u) == 0u) { if (xb_ld(&(bar)[XB_TMO])) break; if (_sp > XB_SPIN_CAP) { atomicAdd(&(bar)[XB_TMO], 1u); break; } } } } while (0)
struct XcdBarrier { unsigned* bar; unsigned x; volatile LAS unsigned* st; };
__device__ __forceinline__ XcdBarrier xcd_barrier_post(unsigned* bar, volatile LAS unsigned* st, int tid) {
    XcdBarrier b; b.bar = bar; b.x = xb_xcc_id(); b.st = st;
    if (tid == 0) (void)xb_add(&bar[XB_XCNT(b.x)], 1u);
    return b;
}
__device__ __forceinline__ void xcd_barrier_complete(unsigned* bar, unsigned x, unsigned& nloc, unsigned& nx) {
    const unsigned G = gridDim.x * gridDim.y * gridDim.z;
    unsigned sum, cnt, mine, sp = 0u;
    for (;;) {
        sum = 0u; cnt = 0u; mine = 0u;
#pragma unroll
        for (unsigned j = 0; j < 16; ++j) { const unsigned c = xb_ld(&bar[XB_XCNT(j)]); sum += c; cnt += (c > 0u) ? 1u : 0u; mine = (j == x) ? c : mine; }
        if (sum == G) break;
        __builtin_amdgcn_s_sleep(1);
        if ((++sp & 255u) == 0u) { if (xb_ld(&bar[XB_TMO])) break; if (sp > XB_SPIN_CAP) { atomicAdd(&bar[XB_TMO], 1u); break; } }
    }
    nloc = mine > 0u ? mine : 1u; nx = cnt > 0u ? cnt : 1u;
}
__device__ __forceinline__ void xcd_barrier(const XcdBarrier& b, int tid) {
    asm volatile("s_waitcnt vmcnt(0)" ::: "memory");
    __syncthreads();
    if (tid == 0) {
        unsigned* bar = b.bar;
        __builtin_amdgcn_s_waitcnt(0);
        unsigned nloc = b.st[0], nx = b.st[1];
        if (nloc == 0u) { xcd_barrier_complete(bar, b.x, nloc, nx); b.st[0] = nloc; b.st[1] = nx; }
        const unsigned old = xb_add(&bar[XB_XSUB(b.x)], 1u);
        const unsigned gen = old / nloc;
        if (old + 1u == (gen + 1u) * nloc) {
            __builtin_amdgcn_fence(__ATOMIC_RELEASE, "agent");
            asm volatile("s_waitcnt vmcnt(0)" ::: "memory");
            const unsigned og = xb_add(&bar[XB_TOP], 1u);
            __builtin_amdgcn_fence(__ATOMIC_ACQUIRE, "agent");
            const unsigned tg = og / nx;
            if (og + 1u == (tg + 1u) * nx) xb_add(&bar[XB_TOPGEN], 1u);
            else XB_SPIN(xb_ld(&bar[XB_TOPGEN]) == tg, bar);
            asm volatile("s_waitcnt vmcnt(0)" ::: "memory");
            xb_add(&bar[XB_XGEN(b.x)], 1u);
            asm volatile("s_waitcnt vmcnt(0)" ::: "memory");
        } else {
            __builtin_amdgcn_fence(__ATOMIC_ACQUIRE, "agent");
            XB_SPIN(xb_ld(&bar[XB_XGEN(b.x)]) == gen, bar);
            asm volatile("s_waitcnt vmcnt(0)" ::: "memory");
        }
    }
    __syncthreads();
}

struct Args { const float* in[18]; float* out; unsigned char* ws; int ph_lo, ph_hi; };
enum { IN_X = 0, IN_MEM, IN_N1G, IN_WIN, IN_POOLW, IN_POOLS, IN_MEMNG, IN_WMKV, IN_GRPG, IN_WOUT, IN_N2G, IN_RW, IN_RB, IN_WGU, IN_BGU, IN_WDN, IN_BDN, IN_FING };

#define GAS __attribute__((address_space(1)))
#define CAS __attribute__((address_space(4)))
struct Frame {
    LAS unsigned char* lds; int tid, lane, wave, G, bid;
    const CAS unsigned char* kp;
    __device__ __forceinline__ const float* in(int i) const { return (const float*)*(GAS const float* const CAS*)(kp + 8 * i); }
    __device__ __forceinline__ float* out() const { return (float*)*(GAS float* const CAS*)(kp + 144); }
    __device__ __forceinline__ unsigned char* ws() const { return (unsigned char*)*(GAS unsigned char* const CAS*)(kp + 152); }
};

template <int MODE> __device__ __forceinline__ int perm_col(int c) {
    if (MODE == 1) { if (c >= 1024) return c; const int head = c >> 6, d = c & 63, g8 = (d & 31) >> 2, i = (d & 3) + ((d >> 5) << 2); return (head << 6) + (g8 << 3) + i; }
    if (MODE == 2) { const int up = c >> 10, cc = c & 1023; return ((cc >> 7) << 8) + (up << 7) + (cc & 127); }
    return c;
}
struct TItem { const float* W; bf16_t* WT; const float* g; int N, mode, k0, n0; };
__device__ __forceinline__ int perm_col_rt(int mode, int c) { return mode == 1 ? perm_col<1>(c) : (mode == 2 ? perm_col<2>(c) : c); }
__device__ __forceinline__ void titem_load(const TItem& I, float (&tmp)[32], int lane) {
#pragma unroll
    for (int i = 0; i < 32; ++i) { const int kk = 2 * i + (lane >> 5); const float gk = I.g ? I.g[I.k0 + kk] : 1.0f; tmp[i] = __builtin_nontemporal_load(I.W + (size_t)(I.k0 + kk) * I.N + I.n0 + (lane & 31)) * gk; }
}
__device__ __forceinline__ void titem_store(const TItem& I, const float (&tmp)[32], LAS float* scr, int lane) {
#pragma unroll
    for (int i = 0; i < 32; ++i) { const int kk = 2 * i + (lane >> 5); scr[kk * 33 + (lane & 31)] = tmp[i]; }
    LDS_WAIT();
    if (I.mode >= 2) {
        const int c = lane & 3; unsigned char* W8 = (unsigned char*)I.WT;
#pragma unroll
        for (int j = 0; j < 2; ++j) { const int n = (lane >> 2) + 16 * j; const LAS float* s = scr + (16 * c) * 33 + n; u32x4 o;
#pragma unroll
            for (int q = 0; q < 4; ++q) { int w = 0; w = __builtin_amdgcn_cvt_pk_fp8_f32(s[(4 * q) * 33] * W8SCALE, s[(4 * q + 1) * 33] * W8SCALE, w, false);
                w = __builtin_amdgcn_cvt_pk_fp8_f32(s[(4 * q + 2) * 33] * W8SCALE, s[(4 * q + 3) * 33] * W8SCALE, w, true); o[q] = (unsigned)w; }
            const int row = (I.mode == 2) ? perm_col<2>(I.n0 + n) : (I.n0 + n);
            *(u32x4*)(W8 + (size_t)row * DM + I.k0 + 16 * c) = o; }
    } else {
        const int c = lane & 7;
#pragma unroll
        for (int j = 0; j < 4; ++j) { const int n = (lane >> 3) + 8 * j; const LAS float* s = scr + (8 * c) * 33 + n;
            u32x4 o; o.x = cvtpk(s[0 * 33], s[1 * 33]); o.y = cvtpk(s[2 * 33], s[3 * 33]); o.z = cvtpk(s[4 * 33], s[5 * 33]); o.w = cvtpk(s[6 * 33], s[7 * 33]);
            *(u32x4*)(I.WT + (size_t)perm_col_rt(I.mode, I.n0 + n) * DM + I.k0 + 8 * c) = o; }
    }
    LDS_WAIT();
}
struct W8Step { const float* W; unsigned char* W8; int N, gu, k0, n0; };
__device__ __forceinline__ void w8_load(const W8Step& I, f32x4 (&r)[16], int wave, int lane) {
#pragma unroll
    for (int h = 0; h < 2; ++h)
#pragma unroll
        for (int i = 0; i < 8; ++i) r[8 * h + i] = __builtin_nontemporal_load((const f32x4*)(I.W + (size_t)(I.k0 + 8 * (wave + 8 * h) + i) * I.N + I.n0 + 4 * lane));
}
__device__ __forceinline__ void w8_store(const W8Step& I, const f32x4 (&r)[16], LAS unsigned char* T, int tid, int wave, int lane) {
#pragma unroll
    for (int h = 0; h < 2; ++h) { const int a = wave + 8 * h;
#pragma unroll
        for (int j = 0; j < 4; ++j) { int w0 = 0, w1 = 0;
            w0 = __builtin_amdgcn_cvt_pk_fp8_f32(r[8 * h + 0][j] * W8SCALE, r[8 * h + 1][j] * W8SCALE, w0, false); w0 = __builtin_amdgcn_cvt_pk_fp8_f32(r[8 * h + 2][j] * W8SCALE, r[8 * h + 3][j] * W8SCALE, w0, true);
            w1 = __builtin_amdgcn_cvt_pk_fp8_f32(r[8 * h + 4][j] * W8SCALE, r[8 * h + 5][j] * W8SCALE, w1, false); w1 = __builtin_amdgcn_cvt_pk_fp8_f32(r[8 * h + 6][j] * W8SCALE, r[8 * h + 7][j] * W8SCALE, w1, true);
            u32x2 w; w.x = (unsigned)w0; w.y = (unsigned)w1;
            *(LAS u32x2*)(T + (4 * lane + j) * 128 + ((a ^ (lane & 15)) << 3)) = w; } }
    __syncthreads();
#pragma unroll
    for (int i = 0; i < 4; ++i) { const int p = tid + 512 * i, row = p >> 3, c16 = p & 7, f = (row >> 2) & 15;
        u32x4 v = *(const LAS u32x4*)(T + row * 128 + ((c16 ^ (f >> 1)) << 4));
        if (f & 1) v = (u32x4){v.z, v.w, v.x, v.y};
        const int orow = I.gu ? perm_col<2>(I.n0 + row) : (I.n0 + row);
        *(u32x4*)(I.W8 + (size_t)orow * DM + I.k0 + 16 * c16) = v; }
}
constexpr int W8_GU_STEPS = 32 * 64, W8_PER_LAYER = W8_GU_STEPS + 32 * 32;
__device__ __forceinline__ void w8_decode(Frame& F, W8Step& I, int layer, int j) {
    if (j < W8_GU_STEPS) { const int le = layer * NE + (j >> 6), r_ = j & 63; I.W = F.in(IN_WGU) + (size_t)le * DM * 2048; I.W8 = F.ws() + WS_WGU + (size_t)le * 2048 * DM; I.N = 2048; I.gu = 1; I.k0 = 128 * (r_ >> 3); I.n0 = 256 * (r_ & 7); }
    else { const int q_ = j - W8_GU_STEPS, le = layer * NE + (q_ >> 5), r_ = q_ & 31; I.W = F.in(IN_WDN) + (size_t)le * DM * DM; I.W8 = F.ws() + WS_WDN + (size_t)le * DM * DM; I.N = DM; I.gu = 0; I.k0 = 128 * (r_ >> 2); I.n0 = 256 * (r_ & 3); }
}
constexpr int W8_Q_DN0 = 32 * 32, W8_Q_TOTAL = W8_Q_DN0 + W8_PER_LAYER;
__device__ __forceinline__ void w8_decode_q(Frame& F, W8Step& I, int q) { if (q < W8_Q_DN0) w8_decode(F, I, 0, W8_GU_STEPS + q); else w8_decode(F, I, 1, q - W8_Q_DN0); }
__device__ __forceinline__ int w8_grab(Frame& F, unsigned* next, unsigned* done, int limit) {
    volatile LAS int* bc = (volatile LAS int*)(F.lds + MISC_OFF + 128);
    __syncthreads();
    if (F.tid == 0) { int go = 1; if (done != nullptr && __hip_atomic_load(done, __ATOMIC_RELAXED, __HIP_MEMORY_SCOPE_AGENT) >= (unsigned)F.G) go = 0;
        if (go && limit < W8_Q_TOTAL && __hip_atomic_load(next, __ATOMIC_RELAXED, __HIP_MEMORY_SCOPE_AGENT) >= (unsigned)limit) go = 0;
        int j = W8_Q_TOTAL; if (go) j = (int)__hip_atomic_fetch_add(next, 1u, __ATOMIC_RELAXED, __HIP_MEMORY_SCOPE_AGENT); bc[0] = j; }
    __syncthreads();
    return bc[0];
}
__device__ __forceinline__ void w8_help(Frame& F, unsigned* next, unsigned* done, int limit = W8_Q_TOTAL) {
    f32x4 ra[16], rb[16]; W8Step A, B; LAS unsigned char* T0 = F.lds; LAS unsigned char* T1 = F.lds + 32768;
    int j = w8_grab(F, next, done, limit);
    if (j < W8_Q_TOTAL) { w8_decode_q(F, A, j); w8_load(A, ra, F.wave, F.lane); }
    while (j < W8_Q_TOTAL) {
        int jn = w8_grab(F, next, done, limit); if (jn < W8_Q_TOTAL) { w8_decode_q(F, B, jn); w8_load(B, rb, F.wave, F.lane); }
        w8_store(A, ra, T0, F.tid, F.wave, F.lane); j = jn; if (j >= W8_Q_TOTAL) break;
        jn = w8_grab(F, next, done, limit); if (jn < W8_Q_TOTAL) { w8_decode_q(F, A, jn); w8_load(A, ra, F.wave, F.lane); }
        w8_store(B, rb, T1, F.tid, F.wave, F.lane); j = jn;
    }
    __syncthreads();
}
__device__ __forceinline__ void w8_static(Frame& F, int layer, int first, int end, int stride) {
    f32x4 ra[16], rb[16]; W8Step A, B; int st = first; LAS unsigned char* T0 = F.lds; LAS unsigned char* T1 = F.lds + 32768;
    __syncthreads();
    if (st < end) { w8_decode(F, A, layer, st); w8_load(A, ra, F.wave, F.lane); }
    while (st < end) {
        int nx = st + stride; if (nx < end) { w8_decode(F, B, layer, nx); w8_load(B, rb, F.wave, F.lane); }
        w8_store(A, ra, T0, F.tid, F.wave, F.lane); st = nx; if (st >= end) break;
        nx = st + stride; if (nx < end) { w8_decode(F, A, layer, nx); w8_load(A, ra, F.wave, F.lane); }
        w8_store(B, rb, T1, F.tid, F.wave, F.lane); st = nx;
    }
    __syncthreads();
}
__device__ __forceinline__ void rms_row_bf16(const float* xrow, const float* g, bf16_t* orow, int lane) {
    f32x4 v[4]; float ss = 0.f;
#pragma unroll
    for (int j = 0; j < 4; ++j) { v[j] = ((const f32x4*)xrow)[lane + 64 * j]; ss += (v[j].x * v[j].x + v[j].y * v[j].y) + (v[j].z * v[j].z + v[j].w * v[j].w); }
    const float rs = rsqrtf(wave_sum(ss) * (1.f / DM) + EPS);
#pragma unroll
    for (int j = 0; j < 4; ++j) { const f32x4 gv = ((const f32x4*)g)[lane + 64 * j]; const f32x4 o = v[j] * rs * gv;
        u32x2 w; w.x = cvtpk(o.x, o.y); w.y = cvtpk(o.z, o.w); ((u32x2*)orow)[lane + 64 * j] = w; }
}
__device__ __forceinline__ void prologue(Frame& F) {
    LAS float* scr = (LAS float*)(F.lds + F.wave * 16384);
    const int gw = F.bid * 8 + F.wave, NGW = F.G * 8;
    constexpr int I_IN = 16 * 64, I_OUT = 16 * 32, I_MKV = 16 * 16;
    constexpr int S0 = 2 * I_IN, S1 = S0 + 2 * I_OUT, S2 = S1 + 2 * I_MKV, S4 = S2;
#define TI_DECODE(I, it_) do { const int it__ = (it_); int r_, N_; \
        if (it__ < S0) { const int l = it__ / I_IN; r_ = it__ % I_IN; N_ = NIN; (I).W = F.in(IN_WIN) + (size_t)l * DM * NIN; (I).WT = (bf16_t*)(F.ws() + WS_WIN) + (size_t)l * NIN * DM; (I).mode = 1; (I).g = F.in(IN_N1G) + l * DM; } \
        else if (it__ < S1) { const int q = it__ - S0, l = q / I_OUT; r_ = q % I_OUT; N_ = DM; (I).W = F.in(IN_WOUT) + (size_t)l * DM * DM; (I).WT = (bf16_t*)(F.ws() + WS_WOUT) + (size_t)l * DM * DM; (I).mode = 0; (I).g = nullptr; } \
        else { const int q = it__ - S1, l = q / I_MKV; r_ = q % I_MKV; N_ = 512; (I).W = F.in(IN_WMKV) + (size_t)l * DM * 512; (I).WT = (bf16_t*)(F.ws() + WS_WMKV) + (size_t)l * 512 * DM; (I).mode = 0; (I).g = nullptr; } \
        const int nblk_ = N_ / 32; (I).N = N_; (I).k0 = 64 * (r_ / nblk_); (I).n0 = 32 * (r_ % nblk_); } while (0)
    { float ta[32], tb[32]; TItem A, B; int it = gw;
      if (it < S4) { TI_DECODE(A, it); titem_load(A, ta, F.lane); }
      while (it < S4) {
          int nx = it + NGW; if (nx < S4) { TI_DECODE(B, nx); titem_load(B, tb, F.lane); }
          titem_store(A, ta, scr, F.lane); it = nx; if (it >= S4) break;
          nx = it + NGW; if (nx < S4) { TI_DECODE(A, nx); titem_load(A, ta, F.lane); }
          titem_store(B, tb, scr, F.lane); it = nx;
      } }
#undef TI_DECODE
    { float* cs = (float*)(F.ws() + WS_COS); float* sn = (float*)(F.ws() + WS_SIN);
      int gstride = F.G * 512; asm volatile("" : "+s"(gstride));
      for (int i = F.bid * 512 + F.tid; i < SEQ * 32; i += gstride) { const int pos = i >> 5, f = i & 31;
          const float inv = exp2f(-(float)f * (13.287712379549449f / 32.0f));
          const float angf = (float)pos * inv; const double rev = (double)angf * 0.15915494309189535; const float fr = (float)(rev - rint(rev));
          cs[i] = __builtin_amdgcn_cosf(fr); sn[i] = __builtin_amdgcn_sinf(fr); } }
    { const float* pw = F.in(IN_POOLW); bf16_t* pwt = (bf16_t*)(F.ws() + WS_PWT);
      int gstride = F.G * 512; asm volatile("" : "+s"(gstride));
      for (int i = F.bid * 512 + F.tid; i < 2 * 4 * 64 * 64; i += gstride) { const int c = i & 63, dout = (i >> 6) & 63, lg = i >> 12; pwt[i] = f2bf(pw[(size_t)(lg * 64 + c) * 64 + dout]); } }
    for (int r = gw; r < 2 * 512; r += NGW) { const int l = r >> 9, m = r & 511; rms_row_bf16(F.in(IN_MEM) + (size_t)m * DM, F.in(IN_MEMNG) + l * DM, (bf16_t*)(F.ws() + WS_MEMN) + (size_t)r * DM, F.lane); }
    { const float* xin = F.in(IN_X); const float* g1 = F.in(IN_N1G); bf16_t* XN = (bf16_t*)(F.ws() + WS_XN);
      for (int r0 = gw; r0 < TOK; r0 += 2 * NGW) {
          f32x4 v[2][4]; float ss[2] = {0.f, 0.f};
#pragma unroll
          for (int a = 0; a < 2; ++a) { const int r = min(r0 + a * NGW, TOK - 1);
#pragma unroll
              for (int j = 0; j < 4; ++j) { v[a][j] = __builtin_nontemporal_load((const f32x4*)(xin + (size_t)r * DM) + F.lane + 64 * j); ss[a] += (v[a][j].x * v[a][j].x + v[a][j].y * v[a][j].y) + (v[a][j].z * v[a][j].z + v[a][j].w * v[a][j].w); } }
#pragma unroll
          for (int a = 0; a < 2; ++a) { const int r = r0 + a * NGW; if (r >= TOK) break; const float rs = rsqrtf(wave_sum(ss[a]) * (1.f / DM) + EPS);
              if (F.lane == 0) ((float*)(F.ws() + WS_RS))[r] = rs;
#pragma unroll
              for (int j = 0; j < 4; ++j) { const f32x4 o = v[a][j];
                  u32x2 w; w.x = cvtpk(o.x, o.y); w.y = cvtpk(o.z, o.w); ((u32x2*)(XN + (size_t)r * DM))[F.lane + 64 * j] = w; } } } }
}

__device__ __forceinline__ int crow(int r, int hi) { return (r & 3) + 8 * (r >> 2) + 4 * hi; }
__device__ __forceinline__ s16x4 vtr(LAS const unsigned char* p) { typedef short v4i16_t __attribute__((ext_vector_type(4))); return __builtin_bit_cast(s16x4, __builtin_amdgcn_ds_read_tr16_b64_v4i16((LAS v4i16_t*)p)); }

struct AttnJob {
    const bf16_t* Q; int qpitch, qrow0, qstep;
    const bf16_t* K; const bf16_t* V; int kvpitch, krow0, kstep;
    int t0, ntiles;
    bf16_t* O; int opitch; float* lse; int lsepitch;
};
template <bool MEM> struct AttnStage { static constexpr int NSLOT = MEM ? 8 : 12, NL = NSLOT * 256 / 512; u32x4 k[NL], v[NL]; };

template <bool MEM>
__device__ __forceinline__ void attn_issue_loads(const AttnJob& J, AttnStage<MEM>& S, int tid) {
#pragma unroll
    for (int i = 0; i < AttnStage<MEM>::NL; ++i) { const int q = tid + 512 * i, slot = q >> 8, row = (q >> 3) & 31, c = q & 7;
        const int t = min(max(J.t0 + slot, 0), J.ntiles - 1); const size_t off = (size_t)(J.krow0 + (t * 32 + row) * J.kstep) * J.kvpitch + c * 8;
        S.k[i] = *(const u32x4*)(J.K + off); S.v[i] = *(const u32x4*)(J.V + off); }
}
template <bool MEM>
__device__ __forceinline__ void attn_write_lds(const AttnStage<MEM>& S, LAS unsigned char* lds, int tid) {
#pragma unroll
    for (int i = 0; i < AttnStage<MEM>::NL; ++i) { const int q = tid + 512 * i, slot = q >> 8, row = (q >> 3) & 31, c = q & 7;
        *(LAS u32x4*)(lds + slot * 4096 + row * 128 + ((c ^ ((row >> 1) & 7)) << 4)) = S.k[i];
        *(LAS u32x4*)(lds + 49152 + slot * 4096 + row * 128 + ((c << 4) ^ (((row >> 1) & 1) << 6))) = S.v[i]; }
}
template <bool MEM, int NTC, int LI0>
__device__ __forceinline__ void attn_chunk(const AttnJob& J, const bf16x8 (&qf)[4], LAS unsigned char* lds, int wave, const int (&ka)[4], int tv0, int tv1, int mt,
                                           f32x16 (&o)[2], float& m_run, f32x2& l_run) {
    f32x16 s[NTC];
#pragma unroll
    for (int kt = 0; kt < NTC; ++kt) {
        constexpr int dummy = 0; (void)dummy;
        const int li = LI0 + kt, slot = MEM ? li : (wave + li);
        bf16x8 kf[4];
#pragma unroll
        for (int d0 = 0; d0 < 4; ++d0) kf[d0] = *(const LAS bf16x8*)(lds + ka[d0] + li * 4096);
        f32x16 a;
#pragma unroll
        for (int r = 0; r < 16; ++r) a[r] = 0.f;
#pragma unroll
        for (int d0 = 0; d0 < 4; ++d0) a = __builtin_amdgcn_mfma_f32_32x32x16_bf16(kf[d0], qf[d0], a, 0, 0, 0);
        if (!MEM) { const int traw = J.t0 + slot;
            if (li == 0 || li == 4) {
#pragma unroll
                for (int r = 0; r < 16; ++r) { const int cr = (r & 3) + 8 * (r >> 2); const bool keep = (li == 0) ? (cr >= mt) : (cr <= mt); a[r] = keep ? a[r] : -1e30f; } }
            if (traw < 0 || traw >= J.ntiles) {
                asm volatile("" ::: "memory");
#pragma unroll
                for (int r = 0; r < 16; ++r) a[r] = -1e30f; } }
        s[kt] = a;
    }
    float mx = -1e30f;
#pragma unroll
    for (int kt = 0; kt < NTC; ++kt)
#pragma unroll
        for (int r = 0; r < 16; ++r) mx = fmaxf(mx, s[kt][r]);
    mx = xor32_max(mx);
    const float m_new = fmaxf(m_run, mx);
    if (LI0 > 0) { const float alpha = __builtin_amdgcn_exp2f(m_run - m_new); const f32x2 al2 = {alpha, alpha}; l_run *= al2;
#pragma unroll
        for (int r = 0; r < 16; r += 2) { const f32x2 x0 = (f32x2){o[0][r], o[0][r + 1]} * al2, x1 = (f32x2){o[1][r], o[1][r + 1]} * al2; o[0][r] = x0.x; o[0][r + 1] = x0.y; o[1][r] = x1.x; o[1][r + 1] = x1.y; } }
    m_run = m_new; const f32x2 mn2 = {m_new, m_new};
#pragma unroll
    for (int kt = 0; kt < NTC; ++kt) {
        const int li = LI0 + kt;
#pragma unroll
        for (int r = 0; r < 16; r += 2) { f32x2 d = (f32x2){s[kt][r], s[kt][r + 1]} - mn2; d.x = __builtin_amdgcn_exp2f(d.x); d.y = __builtin_amdgcn_exp2f(d.y); s[kt][r] = d.x; s[kt][r + 1] = d.y; l_run += d; }
        bf16x8 pb[2];
#pragma unroll
        for (int s2 = 0; s2 < 2; ++s2) { u32x4 w; w.x = cvtpk(s[kt][8 * s2 + 0], s[kt][8 * s2 + 1]); w.y = cvtpk(s[kt][8 * s2 + 2], s[kt][8 * s2 + 3]);
            w.z = cvtpk(s[kt][8 * s2 + 4], s[kt][8 * s2 + 5]); w.w = cvtpk(s[kt][8 * s2 + 6], s[kt][8 * s2 + 7]); pb[s2] = __builtin_bit_cast(bf16x8, w); }
#pragma unroll
        for (int db = 0; db < 2; ++db)
#pragma unroll
            for (int s2 = 0; s2 < 2; ++s2) { const int tb = (db == 0) ? tv0 : tv1;
                const s16x4 lo = vtr(lds + tb + li * 4096 + s2 * 2048), h8 = vtr(lds + tb + li * 4096 + s2 * 2048 + 1024);
                const bf16x8 va = (bf16x8){lo[0], lo[1], lo[2], lo[3], h8[0], h8[1], h8[2], h8[3]};
                o[db] = __builtin_amdgcn_mfma_f32_32x32x16_bf16(va, pb[s2], o[db], 0, 0, 0); }
        __builtin_amdgcn_sched_group_barrier(0x100, 8, 0); __builtin_amdgcn_sched_group_barrier(0x008, 4, 0);
    }
}
template <bool MEM>
__device__ __forceinline__ void attn_compute(const AttnJob& J, const bf16x8 (&qf)[4], LAS unsigned char* lds, int wave, int lane) {
    const int r32 = lane & 31, hi = lane >> 5;
    f32x16 o[2];
#pragma unroll
    for (int r = 0; r < 16; ++r) { o[0][r] = 0.f; o[1][r] = 0.f; }
    float m_run = -1e30f; f32x2 l_run = {0.f, 0.f};
    const int ksw = (r32 >> 1) & 7, koff = r32 * 128 + (MEM ? 0 : wave * 4096);
    const int q4 = (lane & 15) >> 2, sw = (q4 >> 1) & 1, trow = (4 * hi + q4) * 128, tcol = ((lane >> 4) & 1) * 32 + (lane & 3) * 8;
    const int tv0 = 49152 + (MEM ? 0 : wave * 4096) + trow + ((sw << 6) | tcol), tv1 = 49152 + (MEM ? 0 : wave * 4096) + trow + (((1 ^ sw) << 6) | tcol);
    int ka[4];
#pragma unroll
    for (int d0 = 0; d0 < 4; ++d0) ka[d0] = koff + (((2 * d0 + hi) ^ ksw) << 4);
    int mt = r32 - 4 * hi; asm volatile("" : "+v"(mt));
    if (MEM) { attn_chunk<MEM, 4, 0>(J, qf, lds, wave, ka, tv0, tv1, mt, o, m_run, l_run); attn_chunk<MEM, 4, 4>(J, qf, lds, wave, ka, tv0, tv1, mt, o, m_run, l_run); }
    else     { attn_chunk<MEM, 3, 0>(J, qf, lds, wave, ka, tv0, tv1, mt, o, m_run, l_run); attn_chunk<MEM, 2, 3>(J, qf, lds, wave, ka, tv0, tv1, mt, o, m_run, l_run); }
    const float l = xor32_sum(l_run.x + l_run.y);
    const float inv = 1.0f / l;
    const int qrow = J.qrow0 + (wave * 32 + r32) * J.qstep;
    LAS unsigned char* ot = lds + 98304 + wave * 4096;
#pragma unroll
    for (int db = 0; db < 2; ++db)
#pragma unroll
        for (int g = 0; g < 4; ++g) { u32x2 w; w.x = cvtpk(o[db][4 * g] * inv, o[db][4 * g + 1] * inv); w.y = cvtpk(o[db][4 * g + 2] * inv, o[db][4 * g + 3] * inv);
            *(LAS u32x2*)(ot + r32 * 128 + (32 * db + 8 * g + 4 * hi) * 2) = w; }
    if (J.lse != nullptr && hi == 0) J.lse[(size_t)qrow * J.lsepitch] = m_run + __builtin_amdgcn_logf(l);
    LDS_WAIT();
    { const int c = lane & 7, rr = lane >> 3; const size_t obase = (size_t)(J.qrow0 + wave * 32 * J.qstep) * J.opitch;
#pragma unroll
      for (int i = 0; i < 4; ++i) { const int row = rr + 8 * i; *(u32x4*)(J.O + obase + (size_t)(row * J.qstep) * J.opitch + c * 8) = *(const LAS u32x4*)(ot + row * 128 + c * 16); } }
}
template <bool MEM, class MakeJob>
__device__ __forceinline__ void attn_block_units(Frame& F, int first, int count, int stride, const MakeJob& mk) {
    if (first >= count) return;
    AttnStage<MEM> S; AttnJob J = mk(first); bf16x8 qn[4];
#define ATTN_LOAD_Q(JJ) do { const int qrow_ = (JJ).qrow0 + (F.wave * 32 + (F.lane & 31)) * (JJ).qstep; const bf16_t* qp_ = (JJ).Q + (size_t)qrow_ * (JJ).qpitch + (F.lane >> 5) * 8; \
        _Pragma("unroll") for (int d0 = 0; d0 < 4; ++d0) qn[d0] = *(const bf16x8*)(qp_ + d0 * 16); } while (0)
    attn_issue_loads<MEM>(J, S, F.tid); ATTN_LOAD_Q(J);
    for (int u = first; u < count; u += stride) {
        bf16x8 qf[4];
#pragma unroll
        for (int d0 = 0; d0 < 4; ++d0) qf[d0] = qn[d0];
        __syncthreads();
        attn_write_lds<MEM>(S, F.lds, F.tid);
        __syncthreads();
        const int un = u + stride; AttnJob Jn = J;
        if (un < count) { Jn = mk(un); attn_issue_loads<MEM>(Jn, S, F.tid); ATTN_LOAD_Q(Jn); }
        attn_compute<MEM>(J, qf, F.lds, F.wave, F.lane);
        J = Jn;
    }
    __syncthreads();
#undef ATTN_LOAD_Q
}

constexpr int POOL_DH = 40960, POOL_WT = POOL_DH + 64 * 528, POOL_DPITCH = 528, POOL_WPITCH = 144;
template <int W>
__device__ __forceinline__ void pool_window(const LAS bf16_t* U, LAS unsigned char* Dh, int ch, int i0, int pos0) {
    constexpr int left = W / 2, right = W - 1 - left, NU = 32 + W - 1;
    const unsigned ua = (unsigned)(uintptr_t)(U + (i0 - left + 8) * 256 + ch);
    unsigned ur[NU];
#pragma unroll
    for (int k = 0; k < NU; ++k) { ur[k] = 0u; asm volatile("ds_read_u16_d16_hi %0, %1 offset:%2" : "+v"(ur[k]) : "v"(ua), "i"(k * 512) : "memory"); }
    asm volatile("s_waitcnt lgkmcnt(0)" ::: "memory");
#pragma unroll
    for (int k = 0; k < NU; ++k) asm volatile("" : "+v"(ur[k]));
    float s = 0.f;
#pragma unroll
    for (int k = 0; k < W; ++k) s += __uint_as_float(ur[k]);
#pragma unroll
    for (int ii = 0; ii < 32; ++ii) { const int i = i0 + ii, pos = pos0 + i; const int lo = max(pos - left, 0), hi = min(pos + right, SEQ - 1);
        *(LAS bf16_t*)(Dh + i * POOL_DPITCH + ch * 2) = f2bf(s * __builtin_amdgcn_rcpf((float)(hi - lo + 1)) - __uint_as_float(ur[ii + left]));
        if (ii < 31) s += __uint_as_float(ur[ii + W]) - __uint_as_float(ur[ii]); }
}
__device__ __forceinline__ void pool_unit(Frame& F, const bf16_t* PROJ, const bf16_t* pwt, const float* pscale, bf16_t* YRAW, int tile) {
    const int tid = F.tid, row0 = tile * 64, pos0 = row0 & (SEQ - 1);
    LAS bf16_t* U = (LAS bf16_t*)F.lds;
    LAS unsigned char* Dh = F.lds + POOL_DH; LAS unsigned char* WT = F.lds + POOL_WT;
    { u32x4 uv[5];
#pragma unroll
      for (int q = 0; q < 5; ++q) { const int i = tid + 512 * q, r = i >> 5, ch = i & 31, pos = min(max(pos0 - 8 + r, 0), SEQ - 1);
          uv[q] = *(const u32x4*)(PROJ + (size_t)(row0 - pos0 + pos) * NIN + 1536 + ch * 8); }
#pragma unroll
      for (int q = 0; q < 5; ++q) { const int i = tid + 512 * q, r = i >> 5, ch = i & 31, pos = pos0 - 8 + r;
          *(LAS u32x4*)(U + r * 256 + ch * 8) = (pos >= 0 && pos < SEQ) ? uv[q] : (u32x4){0u, 0u, 0u, 0u}; } }
    { u32x4 wv[4];
#pragma unroll
      for (int i = 0; i < 4; ++i) wv[i] = *(const u32x4*)(pwt + (size_t)(tid + 512 * i) * 8);
#pragma unroll
      for (int i = 0; i < 4; ++i) { const int q = tid + 512 * i; *(LAS u32x4*)(WT + (q >> 3) * POOL_WPITCH + (q & 7) * 16) = wv[i]; } }
    __syncthreads();
    { const int ch = tid & 255, i0 = (tid >> 8) * 32, g = F.wave & 3;
      if (g == 0) pool_window<2>(U, Dh, ch, i0, pos0); else if (g == 1) pool_window<4>(U, Dh, ch, i0, pos0); else if (g == 2) pool_window<8>(U, Dh, ch, i0, pos0); else pool_window<16>(U, Dh, ch, i0, pos0); }
    __syncthreads();
    { const int lane = F.lane, r32 = lane & 31, hi = lane >> 5, g = F.wave & 3, th = F.wave >> 2;
      bf16x8 af[4];
#pragma unroll
      for (int s = 0; s < 4; ++s) af[s] = *(const LAS bf16x8*)(Dh + (th * 32 + r32) * POOL_DPITCH + (g * 64 + 16 * s + 8 * hi) * 2);
#pragma unroll 1
      for (int nt = 0; nt < 2; ++nt) {
          f32x16 acc;
#pragma unroll
          for (int r = 0; r < 16; ++r) acc[r] = 0.f;
#pragma unroll
          for (int s = 0; s < 4; ++s) { const bf16x8 bfr = *(const LAS bf16x8*)(WT + (g * 64 + nt * 32 + r32) * POOL_WPITCH + (16 * s + 8 * hi) * 2);
              acc = __builtin_amdgcn_mfma_f32_32x32x16_bf16(bfr, af[s], acc, 0, 0, 0); }
          LAS unsigned char* yt = F.lds + (th * 32 + r32) * 528 + (g * 64 + nt * 32 + 4 * hi) * 2; const float* ps = pscale + g * 64 + nt * 32 + 4 * hi;
#pragma unroll
          for (int gq = 0; gq < 4; ++gq) { const f32x4 sc = *(const f32x4*)(ps + 8 * gq);
              u32x2 w; w.x = cvtpk(acc[4 * gq] * sc.x, acc[4 * gq + 1] * sc.y); w.y = cvtpk(acc[4 * gq + 2] * sc.z, acc[4 * gq + 3] * sc.w); *(LAS u32x2*)(yt + 16 * gq) = w; }
      } }
    __syncthreads();
#pragma unroll
    for (int i = 0; i < 4; ++i) { const int q = tid + 512 * i, tok = q >> 5, c = q & 31;
        *(u32x4*)(YRAW + (size_t)(row0 + tok) * 512 + c * 8) = *(const LAS u32x4*)(F.lds + tok * 528 + c * 16); }
    __syncthreads();
}

struct DilJob { const bf16_t* QH; bf16_t* AO; float* LSE;
    __device__ __forceinline__ AttnJob operator()(int bu) const {
        const int i8 = bu & 31, bhp = bu >> 5, p = bhp % 3, bh = bhp / 3, h = bh & 7, b = bh >> 3;
        const int dil = (p == 0) ? 1 : (p == 1 ? 4 : 16), tpr = 256 / dil, g8 = tpr >> 3, r = i8 / g8, jt0 = 8 * (i8 % g8);
        const size_t hs = (size_t)SEQ * 64;
        AttnJob J; J.Q = QH + (size_t)(b * 8 + h) * hs; J.qpitch = 64; J.qrow0 = r + jt0 * 32 * dil; J.qstep = dil;
        J.K = QH + (size_t)((2 + b) * 8 + h) * hs; J.V = QH + (size_t)((4 + b) * 8 + h) * hs; J.kvpitch = 64; J.krow0 = r; J.kstep = dil; J.t0 = jt0 - 2; J.ntiles = tpr;
        J.O = AO + (size_t)p * TOK * 512 + (size_t)b * SEQ * 512 + h * 64; J.opitch = 512; J.lse = LSE + (size_t)p * TOK * 8 + (size_t)b * SEQ * 8 + h; J.lsepitch = 8; return J; } };
struct MemJob { const bf16_t* PROJ; const bf16_t* MKV; bf16_t* YRAW;
    __device__ __forceinline__ AttnJob operator()(int mu) const {
        const int q8 = mu & 31, bh = mu >> 5, hm = bh & 3, b = bh >> 2;
        AttnJob J; J.Q = PROJ + 1792 + hm * 64; J.qpitch = NIN; J.qrow0 = b * SEQ + q8 * 256; J.qstep = 1;
        J.K = MKV + hm * 64; J.V = MKV + 256 + hm * 64; J.kvpitch = 512; J.krow0 = b * NMEM; J.kstep = 1; J.t0 = 0; J.ntiles = 8;
        J.O = YRAW + 256 + hm * 64; J.opitch = 512; J.lse = nullptr; J.lsepitch = 0; return J; } };

__device__ __forceinline__ void phase_mixers(Frame& F, int l, int parts = 7) {
    const bf16_t* PROJ = (const bf16_t*)(F.ws() + WS_PROJ); const bf16_t* QH = (const bf16_t*)(F.ws() + WS_QKVH);
    bf16_t* AO = (bf16_t*)(F.ws() + WS_AO); float* LSE = (float*)(F.ws() + WS_LSE); bf16_t* YRAW = (bf16_t*)(F.ws() + WS_YRAW);
    const bf16_t* MKV = (const bf16_t*)(F.ws() + WS_MEMKV) + (size_t)l * 512 * 512;
    const int pt = (parts == 7 && l == 0) ? (F.bid & 3) : -1;
    if (pt == 0) w8_static(F, 0, W8_GU_STEPS / 2 + F.bid, W8_GU_STEPS, F.G);
    if (parts & 1) { DilJob mk{QH, AO, LSE}; attn_block_units<false>(F, F.bid, 1536, F.G, mk); }
    if (pt == 1) w8_static(F, 0, W8_GU_STEPS / 2 + F.bid, W8_GU_STEPS, F.G);
    if (parts & 2) { MemJob mk{PROJ, MKV, YRAW}; attn_block_units<true>(F, F.bid, 256, F.G, mk); }
    if (pt == 2) w8_static(F, 0, W8_GU_STEPS / 2 + F.bid, W8_GU_STEPS, F.G);
    if (parts & 4) for (int tile = F.bid; tile < TOK / 64; tile += F.G) pool_unit(F, PROJ, (const bf16_t*)(F.ws() + WS_PWT) + (size_t)l * 4 * 64 * 64, F.in(IN_POOLS) + l * 256, YRAW, tile);
    if (pt == 3) w8_static(F, 0, W8_GU_STEPS / 2 + F.bid, W8_GU_STEPS, F.G);
}

__device__ __forceinline__ void phase_combine_norm(Frame& F, int l) {
    const bf16_t* AO = (const bf16_t*)(F.ws() + WS_AO); const float* LSE = (const float*)(F.ws() + WS_LSE); const bf16_t* YRAW = (const bf16_t*)(F.ws() + WS_YRAW);
    bf16_t* Y = (bf16_t*)(F.ws() + WS_Y); const float* gg = F.in(IN_GRPG) + l * DM;
    const int gw = F.bid * 8 + F.wave, NGW = F.G * 8, lane = F.lane, head = lane >> 3;
    float lsn[2][3]; u32x4 avn[2][3]; u32x2 pvn[2], mvn[2];
#define CN_LOAD(r0_) do { _Pragma("unroll") for (int a = 0; a < 2; ++a) { const size_t row = (size_t)min((r0_) + a * NGW, TOK - 1); \
            _Pragma("unroll") for (int p = 0; p < 3; ++p) { lsn[a][p] = LSE[(size_t)p * TOK * 8 + row * 8 + head]; avn[a][p] = __builtin_nontemporal_load((const u32x4*)(AO + (size_t)p * TOK * 512 + row * 512 + lane * 8)); } \
            pvn[a] = *(const u32x2*)(YRAW + row * 512 + lane * 4); mvn[a] = *(const u32x2*)(YRAW + row * 512 + 256 + lane * 4); } } while (0)
    CN_LOAD(gw);
    for (int r0 = gw; r0 < TOK; r0 += 2 * NGW) {
        float ls[2][3]; u32x4 av[2][3]; u32x2 pv[2], mv[2];
#pragma unroll
        for (int a = 0; a < 2; ++a) { pv[a] = pvn[a]; mv[a] = mvn[a];
#pragma unroll
            for (int p = 0; p < 3; ++p) { ls[a][p] = lsn[a][p]; av[a][p] = avn[a][p]; } }
        if (r0 + 2 * NGW < TOK) CN_LOAD(r0 + 2 * NGW);
#pragma unroll
        for (int a = 0; a < 2; ++a) { const int rowi = r0 + a * NGW; if (rowi >= TOK) break; const size_t row = (size_t)rowi;
            const float l0 = ls[a][0], l1 = ls[a][1], l2 = ls[a][2]; const u32x4 a0 = av[a][0], a1 = av[a][1], a2 = av[a][2];
            const float mx = fmaxf(l0, fmaxf(l1, l2));
            float w0 = __builtin_amdgcn_exp2f(l0 - mx), w1 = __builtin_amdgcn_exp2f(l1 - mx), w2 = __builtin_amdgcn_exp2f(l2 - mx);
            const float wi = 1.0f / (w0 + w1 + w2); w0 *= wi; w1 *= wi; w2 *= wi;
            float y[8]; float ss = 0.f;
#pragma unroll
            for (int i = 0; i < 4; ++i) { y[2 * i] = w0 * bflo(a0[i]) + w1 * bflo(a1[i]) + w2 * bflo(a2[i]); y[2 * i + 1] = w0 * bfhi(a0[i]) + w1 * bfhi(a1[i]) + w2 * bfhi(a2[i]); ss += y[2 * i] * y[2 * i] + y[2 * i + 1] * y[2 * i + 1]; }
            const float p0 = bflo(pv[a].x), p1 = bfhi(pv[a].x), p2 = bflo(pv[a].y), p3 = bfhi(pv[a].y);
            const float q0 = bflo(mv[a].x), q1 = bfhi(mv[a].x), q2 = bflo(mv[a].y), q3 = bfhi(mv[a].y);
            float sp = p0 * p0 + p1 * p1 + p2 * p2 + p3 * p3, sq = q0 * q0 + q1 * q1 + q2 * q2 + q3 * q3;
            ss = wave_sum(ss); sp = wave_sum(sp); sq = wave_sum(sq);
            const float rs = rsqrtf(ss * (1.f / 512.f) + EPS), rp = rsqrtf(sp * (1.f / 256.f) + EPS), rq = rsqrtf(sq * (1.f / 256.f) + EPS);
            const f32x4 g0 = *(const f32x4*)(gg + lane * 8), g1 = *(const f32x4*)(gg + lane * 8 + 4), gp = *(const f32x4*)(gg + 512 + lane * 4), gq = *(const f32x4*)(gg + 768 + lane * 4);
            u32x4 wv; wv.x = cvtpk(y[0] * rs * g0.x, y[1] * rs * g0.y); wv.y = cvtpk(y[2] * rs * g0.z, y[3] * rs * g0.w); wv.z = cvtpk(y[4] * rs * g1.x, y[5] * rs * g1.y); wv.w = cvtpk(y[6] * rs * g1.z, y[7] * rs * g1.w);
            *(u32x4*)(Y + row * DM + lane * 8) = wv;
            u32x2 op; op.x = cvtpk(p0 * rp * gp.x, p1 * rp * gp.y); op.y = cvtpk(p2 * rp * gp.z, p3 * rp * gp.w); *(u32x2*)(Y + row * DM + 512 + lane * 4) = op;
            u32x2 oq; oq.x = cvtpk(q0 * rq * gq.x, q1 * rq * gq.y); oq.y = cvtpk(q2 * rq * gq.z, q3 * rq * gq.w); *(u32x2*)(Y + row * DM + 768 + lane * 4) = oq; }
    }
}

#undef CN_LOAD
__device__ __forceinline__ void phase_router(Frame& F, int l) {
    const bf16_t* X1 = (const bf16_t*)(F.ws() + WS_X1); unsigned char* H2 = F.ws() + WS_H2;
    const float* g2 = F.in(IN_N2G) + l * DM; const float* Wr = F.in(IN_RW) + (size_t)l * DM * NE; const float* rb = F.in(IN_RB) + l * NE;
    int* rt_e = (int*)(F.ws() + WS_RT); int* rt_rank = rt_e + TOK * TOPK; float* rt_gate = (float*)(rt_rank + TOK * TOPK); int* elist = (int*)(F.ws() + WS_ELIST);
    unsigned* gcnt = (unsigned*)(F.ws() + WS_CTL) + CW_CNT + 64 * l;
    constexpr int RPITCH = 2064;
    LAS unsigned char* Ahi = F.lds; LAS unsigned char* Alo = F.lds + 16 * RPITCH;
    LAS float* pl = (LAS float*)(F.lds + 69632);
    LAS int* lcnt = (LAS int*)(F.lds + MISC_OFF + 1024);
    LAS int* lbase = lcnt + 32;
    LAS int* le = lcnt + 64;
    LAS int* lrank = le + 256;
    const int lane = F.lane, e = lane & 31, half = lane >> 5, w = F.wave;
    bf16x8 bhi[8], blo[8];
#pragma unroll
    for (int ks = 0; ks < 8; ++ks) { float wv[8]; const int k0 = 128 * w + 16 * ks + 8 * half;
#pragma unroll
        for (int j = 0; j < 8; ++j) wv[j] = Wr[(size_t)(k0 + j) * NE + e];
        u32x4 ph, pq;
        ph.x = cvtpk(wv[0], wv[1]); ph.y = cvtpk(wv[2], wv[3]); ph.z = cvtpk(wv[4], wv[5]); ph.w = cvtpk(wv[6], wv[7]);
        pq.x = cvtpk(wv[0] - bflo(ph.x), wv[1] - bfhi(ph.x)); pq.y = cvtpk(wv[2] - bflo(ph.y), wv[3] - bfhi(ph.y)); pq.z = cvtpk(wv[4] - bflo(ph.z), wv[5] - bfhi(ph.z)); pq.w = cvtpk(wv[6] - bflo(ph.w), wv[7] - bfhi(ph.w));
        bhi[ks] = __builtin_bit_cast(bf16x8, ph); blo[ks] = __builtin_bit_cast(bf16x8, pq); }
    const float bias = rb[e];
    for (int tg = F.bid; tg < TOK / 64; tg += F.G) {
        if (F.tid < 32) lcnt[F.tid] = 0;
        __syncthreads();
        u32x2 xv[2][4];
#pragma unroll
        for (int i2 = 0; i2 < 2; ++i2)
#pragma unroll
            for (int j = 0; j < 4; ++j) xv[i2][j] = __builtin_nontemporal_load((const u32x2*)(X1 + ((size_t)tg * 64 + 2 * w + i2) * DM) + lane + 64 * j);
#pragma unroll 1
        for (int b = 0; b < 4; ++b) {
#pragma unroll
            for (int i2 = 0; i2 < 2; ++i2) { const int ti = 2 * w + i2; const size_t row = (size_t)tg * 64 + 16 * b + ti;
                f32x4 v[4]; float ss = 0.f;
#pragma unroll
                for (int j = 0; j < 4; ++j) { v[j] = (f32x4){bflo(xv[i2][j].x), bfhi(xv[i2][j].x), bflo(xv[i2][j].y), bfhi(xv[i2][j].y)}; ss += (v[j].x * v[j].x + v[j].y * v[j].y) + (v[j].z * v[j].z + v[j].w * v[j].w); }
                const float rs = rsqrtf(wave_sum(ss) * (1.f / DM) + EPS);
#pragma unroll
                for (int j = 0; j < 4; ++j) { const f32x4 gv = ((const f32x4*)g2)[lane + 64 * j]; const f32x4 o = v[j] * rs * gv;
                    int w8 = 0; w8 = __builtin_amdgcn_cvt_pk_fp8_f32(o.x, o.y, w8, false); w8 = __builtin_amdgcn_cvt_pk_fp8_f32(o.z, o.w, w8, true); ((int*)(H2 + row * DM))[lane + 64 * j] = w8;
                    u32x2 hh, hl; hh.x = cvtpk(o.x, o.y); hh.y = cvtpk(o.z, o.w); hl.x = cvtpk(o.x - bflo(hh.x), o.y - bfhi(hh.x)); hl.y = cvtpk(o.z - bflo(hh.y), o.w - bfhi(hh.y));
                    *(LAS u32x2*)(Ahi + ti * RPITCH + (lane + 64 * j) * 8) = hh; *(LAS u32x2*)(Alo + ti * RPITCH + (lane + 64 * j) * 8) = hl; } }
            if (b < 3) {
#pragma unroll
                for (int i2 = 0; i2 < 2; ++i2)
#pragma unroll
                    for (int j = 0; j < 4; ++j) xv[i2][j] = __builtin_nontemporal_load((const u32x2*)(X1 + ((size_t)tg * 64 + 16 * (b + 1) + 2 * w + i2) * DM) + lane + 64 * j); }
            __syncthreads();
            { f32x16 acc;
#pragma unroll
              for (int r = 0; r < 16; ++r) acc[r] = 0.f;
#pragma unroll
              for (int ks = 0; ks < 8; ++ks) { const int ab = (lane & 15) * RPITCH + (128 * w + 16 * ks + 8 * half) * 2;
                  const bf16x8 ah = *(const LAS bf16x8*)(Ahi + ab), al = *(const LAS bf16x8*)(Alo + ab);
                  acc = __builtin_amdgcn_mfma_f32_32x32x16_bf16(ah, bhi[ks], acc, 0, 0, 0); acc = __builtin_amdgcn_mfma_f32_32x32x16_bf16(ah, blo[ks], acc, 0, 0, 0);
                  acc = __builtin_amdgcn_mfma_f32_32x32x16_bf16(al, bhi[ks], acc, 0, 0, 0); }
#pragma unroll
              for (int r = 0; r < 8; ++r) pl[(w * 16 + (r & 3) + 8 * (r >> 2) + 4 * half) * 32 + e] = acc[r]; }
            __syncthreads();
            { const int ti = 2 * w + half, tl = 16 * b + ti;
                float v = bias;
#pragma unroll
                for (int ww = 0; ww < 8; ++ww) v += pl[(ww * 16 + ti) * 32 + e];
                v += 0.0f;
                unsigned key; { const unsigned u = __float_as_uint(v); key = (u & 0x80000000u) ? ~u : (u | 0x80000000u); }
                float tv[4]; int tix[4];
#pragma unroll
                for (int k = 0; k < 4; ++k) { unsigned long long m = ((unsigned long long)key << 32) | (unsigned)(31 - e);
#define TOPK_STEP(M) { const unsigned long long o = ((unsigned long long)(unsigned)swz_i<M>((int)(m >> 32)) << 32) | (unsigned)swz_i<M>((int)(unsigned)m); m = (o > m) ? o : m; }
                    TOPK_STEP(1) TOPK_STEP(2) TOPK_STEP(4) TOPK_STEP(8)
#undef TOPK_STEP
                    { const auto rh = __builtin_amdgcn_permlane16_swap((unsigned)(m >> 32), (unsigned)(m >> 32), false, false); const auto rl = __builtin_amdgcn_permlane16_swap((unsigned)m, (unsigned)m, false, false);
                      const unsigned long long m0 = ((unsigned long long)rh[0] << 32) | rl[0], m1 = ((unsigned long long)rh[1] << 32) | rl[1]; m = (m1 > m0) ? m1 : m0; }
                    const unsigned kk = (unsigned)(m >> 32); tv[k] = __uint_as_float((kk & 0x80000000u) ? (kk & 0x7fffffffu) : ~kk); tix[k] = 31 - (int)(unsigned)m;
                    if (e == tix[k]) key = 0u; }
                const float e1 = __expf(tv[1] - tv[0]), e2 = __expf(tv[2] - tv[0]), e3 = __expf(tv[3] - tv[0]); const float isum = 1.0f / (1.0f + e1 + e2 + e3);
                if (e < 4) { const int me = (e == 0) ? tix[0] : (e == 1) ? tix[1] : (e == 2) ? tix[2] : tix[3];
                    const float gt = ((e == 0) ? 1.0f : (e == 1) ? e1 : (e == 2) ? e2 : e3) * isum;
                    const int lr = __hip_atomic_fetch_add(lcnt + me, 1, __ATOMIC_RELAXED, __HIP_MEMORY_SCOPE_WORKGROUP);
                    le[tl * 4 + e] = me; lrank[tl * 4 + e] = lr; rt_gate[((size_t)tg * 64 + tl) * 4 + e] = gt; } }
        }
        __syncthreads();
        if (F.tid < 32) lbase[F.tid] = (int)__hip_atomic_fetch_add(gcnt + F.tid, (unsigned)lcnt[F.tid], __ATOMIC_RELAXED, __HIP_MEMORY_SCOPE_AGENT);
        __syncthreads();
        if (F.tid < 256) { const int me = le[F.tid], rk = lbase[me] + lrank[F.tid]; rt_e[(size_t)tg * 256 + F.tid] = me; rt_rank[(size_t)tg * 256 + F.tid] = rk; elist[(size_t)me * TOK + rk] = tg * 64 + (F.tid >> 2); }
        __syncthreads();
    }
}

__device__ __forceinline__ LAS int* moe_tile_table(Frame& F, int l) {
    LAS int* tstart = (LAS int*)(F.lds + MISC_OFF + 512);
    const unsigned* gcnt = (const unsigned*)(F.ws() + WS_CTL) + CW_CNT + 64 * l;
    if (F.tid < 64) {
        const int e = F.lane & 31; const int cnt = (int)__hip_atomic_load(gcnt + e, __ATOMIC_RELAXED, __HIP_MEMORY_SCOPE_AGENT); const int mt = (cnt + 255) >> 8;
        int inc = mt;
#pragma unroll
        for (int o = 1; o < 32; o <<= 1) { const int t = __builtin_amdgcn_ds_bpermute(((F.lane - o) & 63) << 2, inc); if (e >= o) inc += t; }
        if (F.lane < 32) { tstart[80 + e] = cnt; tstart[40 + e] = mt; tstart[e] = inc - mt; if (e == 31) tstart[32] = inc; } }
    __syncthreads();
    return tstart;
}

__device__ __forceinline__ void phase_moe_combine(Frame& F, int l, bool table_live) {
    const bf16_t* X1 = (const bf16_t*)(F.ws() + WS_X1); bf16_t* X2 = (bf16_t*)(F.ws() + WS_X2); const unsigned char* YS = F.ws() + WS_YS;
    LAS int* tstart = table_live ? (LAS int*)(F.lds + MISC_OFF + 512) : moe_tile_table(F, l);
    const int* rt_e = (const int*)(F.ws() + WS_RT); const int* rt_rank = rt_e + TOK * TOPK; const float* rt_gate = (const float*)(F.ws() + WS_RT) + 2 * TOK * TOPK;
    bf16_t* XN = (bf16_t*)(F.ws() + WS_XN);
    const bool lastl = (l == DEPTH - 1);
    const float* gn = lastl ? F.in(IN_FING) : (F.in(IN_N1G) + (l + 1) * DM);
    const int gw = F.bid * 8 + F.wave, NGW = F.G * 8, lane = F.lane;
    typedef int i32x4 __attribute__((ext_vector_type(4)));
    i32x4 een[2], sln[2]; f32x4 gtn[2];
#pragma unroll
    for (int a = 0; a < 2; ++a) { const int t = min(gw + a * NGW, TOK - 1); een[a] = *(const i32x4*)(rt_e + (size_t)t * 4); sln[a] = *(const i32x4*)(rt_rank + (size_t)t * 4); gtn[a] = *(const f32x4*)(rt_gate + (size_t)t * 4); }
    for (int t0 = gw; t0 < TOK; t0 += 2 * NGW) {
        i32x4 sl[2]; f32x4 gt[2]; f32x4 v[2][4]; u32x4 xb[2][2]; u32x2 y[2][4][2];
#pragma unroll
        for (int a = 0; a < 2; ++a) { const int t = min(t0 + a * NGW, TOK - 1); const i32x4 ee = een[a]; sl[a] = sln[a]; gt[a] = gtn[a];
            sl[a].x += tstart[ee.x] * 256; sl[a].y += tstart[ee.y] * 256; sl[a].z += tstart[ee.z] * 256; sl[a].w += tstart[ee.w] * 256;
            const bf16_t* xr = X1 + (size_t)t * DM + lane * 8; xb[a][0] = __builtin_nontemporal_load((const u32x4*)xr); xb[a][1] = __builtin_nontemporal_load((const u32x4*)(xr + 512)); }
#pragma unroll
        for (int a = 0; a < 2; ++a)
#pragma unroll
            for (int k = 0; k < 4; ++k) { const unsigned char* yr = YS + (size_t)sl[a][k] * DM + lane * 8; y[a][k][0] = __builtin_nontemporal_load((const u32x2*)yr); y[a][k][1] = __builtin_nontemporal_load((const u32x2*)(yr + 512)); }
#pragma unroll
        for (int a = 0; a < 2; ++a) { const int t = min(t0 + 2 * NGW + a * NGW, TOK - 1); een[a] = *(const i32x4*)(rt_e + (size_t)t * 4); sln[a] = *(const i32x4*)(rt_rank + (size_t)t * 4); gtn[a] = *(const f32x4*)(rt_gate + (size_t)t * 4); }
#pragma unroll
        for (int a = 0; a < 2; ++a) { const int t = t0 + a * NGW; if (t >= TOK) break;
#pragma unroll
            for (int hf = 0; hf < 2; ++hf) { const u32x4 r = xb[a][hf]; v[a][2 * hf] = (f32x4){bflo(r.x), bfhi(r.x), bflo(r.y), bfhi(r.y)}; v[a][2 * hf + 1] = (f32x4){bflo(r.z), bfhi(r.z), bflo(r.w), bfhi(r.w)}; }
#pragma unroll
            for (int k = 0; k < 4; ++k) { const float g = gt[a][k];
#pragma unroll
                for (int hf = 0; hf < 2; ++hf) { const u32x2 yy = y[a][k][hf];
                    const f32x2 p0 = __builtin_amdgcn_cvt_pk_f32_fp8((int)yy.x, false), p1 = __builtin_amdgcn_cvt_pk_f32_fp8((int)yy.x, true), p2 = __builtin_amdgcn_cvt_pk_f32_fp8((int)yy.y, false), p3 = __builtin_amdgcn_cvt_pk_f32_fp8((int)yy.y, true);
                    v[a][2 * hf][0] += g * p0.x; v[a][2 * hf][1] += g * p0.y; v[a][2 * hf][2] += g * p1.x; v[a][2 * hf][3] += g * p1.y;
                    v[a][2 * hf + 1][0] += g * p2.x; v[a][2 * hf + 1][1] += g * p2.y; v[a][2 * hf + 1][2] += g * p3.x; v[a][2 * hf + 1][3] += g * p3.y; } }
            float ss = 0.f;
#pragma unroll
            for (int j = 0; j < 4; ++j) ss += (v[a][j].x * v[a][j].x + v[a][j].y * v[a][j].y) + (v[a][j].z * v[a][j].z + v[a][j].w * v[a][j].w);
            const float rs = rsqrtf(wave_sum(ss) * (1.f / DM) + EPS);
            const float* gr = gn + lane * 8; f32x4 o[4];
            o[0] = v[a][0] * rs * *(const f32x4*)gr; o[1] = v[a][1] * rs * *(const f32x4*)(gr + 4); o[2] = v[a][2] * rs * *(const f32x4*)(gr + 512); o[3] = v[a][3] * rs * *(const f32x4*)(gr + 516);
            if (lastl) { float* orow = F.out() + (size_t)t * DM + lane * 8; *(f32x4*)orow = o[0]; *(f32x4*)(orow + 4) = o[1]; *(f32x4*)(orow + 512) = o[2]; *(f32x4*)(orow + 516) = o[3]; }
            else { bf16_t* xr = X2 + (size_t)t * DM + lane * 8; u32x4 x0, x1;
                x0.x = cvtpk(v[a][0].x, v[a][0].y); x0.y = cvtpk(v[a][0].z, v[a][0].w); x0.z = cvtpk(v[a][1].x, v[a][1].y); x0.w = cvtpk(v[a][1].z, v[a][1].w);
                x1.x = cvtpk(v[a][2].x, v[a][2].y); x1.y = cvtpk(v[a][2].z, v[a][2].w); x1.z = cvtpk(v[a][3].x, v[a][3].y); x1.w = cvtpk(v[a][3].z, v[a][3].w);
                *(u32x4*)xr = x0; *(u32x4*)(xr + 512) = x1;
                if (lane == 0) ((float*)(F.ws() + WS_RS))[TOK + t] = rs; }
        }
    }
}

constexpr int PH_PER_LAYER = 8, N_PHASES = 1 + DEPTH * PH_PER_LAYER;

__global__ void __launch_bounds__(512, 2) enc_fwd(Args args) {
    extern __shared__ __attribute__((aligned(16))) unsigned char lds_raw[];
    Frame F;
    const int wave0 = __builtin_amdgcn_readfirstlane((int)threadIdx.x >> 6);
    F.lds = (LAS unsigned char*)lds_raw; F.lane = (int)__builtin_amdgcn_mbcnt_hi(~0u, __builtin_amdgcn_mbcnt_lo(~0u, 0u)); F.wave = wave0; F.tid = wave0 * 64 + F.lane; F.G = gridDim.x; F.bid = blockIdx.x;
    static_assert(sizeof(Args) == 168, "kernarg layout: in[18] | out | ws | ph_lo, ph_hi");
    F.kp = (const CAS unsigned char*)__builtin_amdgcn_kernarg_segment_ptr();
    const int lo = args.ph_lo, hi = args.ph_hi;
    volatile LAS unsigned* bst = (volatile LAS unsigned*)(F.lds + MISC_OFF + 64);
    if (F.tid < 2) bst[F.tid] = 0u;
    __syncthreads();
    XcdBarrier xbar; xbar.bar = (unsigned*)(F.ws() + WS_CTL) + CW_BAR; xbar.x = 0; xbar.st = bst;
    if (hi - lo > 1) xbar = xcd_barrier_post((unsigned*)(F.ws() + WS_CTL) + CW_BAR, bst, F.tid);
    for (int ph = lo; ph < hi; ++ph) {
        int phv = ph; asm volatile("" : "+s"(phv));
        { unsigned lz = 0u; asm volatile("" : "+v"(lz));
          int lv = (int)__builtin_amdgcn_mbcnt_hi(~0u, __builtin_amdgcn_mbcnt_lo(~0u, lz)); asm volatile("" : "+v"(lv)); F.lane = lv; F.wave = wave0; F.tid = wave0 * 64 + lv;
          int bv = blockIdx.x; asm volatile("" : "+s"(bv)); F.bid = bv;
          const CAS unsigned char* kpv = (const CAS unsigned char*)__builtin_amdgcn_kernarg_segment_ptr(); asm volatile("" : "+s"(kpv)); F.kp = kpv; }
        if (phv == 0) prologue(F);
#ifdef PROBE_VARIANT
        else if (phv >= 100) phase_mixers(F, 0, phv - 100);
#endif
        else {
            const int l = (phv - 1) / PH_PER_LAYER, k = (phv - 1) % PH_PER_LAYER;
            const int vcu = (F.G % 8 == 0) ? (F.bid % 8) * (F.G / 8) + F.bid / 8 : F.bid;
            if (k == 0) {
                { pg8::Gemm g{(const bf16_t*)(F.ws() + (l == 0 ? WS_XN : WS_X2)), (const bf16_t*)(F.ws() + WS_WIN) + (size_t)l * NIN * DM, DM, 0}; pg8::StaticOrder S; S.init(TOK, NIN, F.G, F.bid);
                  pg8::EpiProj E{(bf16_t*)(F.ws() + WS_PROJ), (const float*)(F.ws() + WS_COS), (const float*)(F.ws() + WS_SIN), (bf16_t*)(F.ws() + WS_QKVH), (const float*)(F.ws() + WS_RS) + (size_t)l * TOK};
                  pg8::gemm_phase<pg8::EpiProj, pg8::StaticOrder, true, true>(F.lds, F.tid, g, S, E); }
                if (l == 0) {
                    for (int ll = 0; ll < DEPTH; ++ll) {
                        pg8::Gemm g{(const bf16_t*)(F.ws() + WS_MEMN) + (size_t)ll * 512 * DM, (const bf16_t*)(F.ws() + WS_WMKV) + (size_t)ll * 512 * DM, DM, 0}; pg8::StaticOrder S; S.init(512, 512, F.G, (F.bid + F.G - 8 - 8 * ll) % F.G);
                        pg8::EpiBf16 E{(bf16_t*)(F.ws() + WS_MEMKV) + (size_t)ll * 512 * 512, 512, nullptr, 0, 1.0f};
                        pg8::gemm_phase<pg8::EpiBf16, pg8::StaticOrder, false, true>(F.lds, F.tid, g, S, E); }
                    { const int hb = F.G >> 1; if (F.bid >= hb) w8_static(F, 0, F.bid - hb, W8_GU_STEPS / 2, F.G - hb); }
                    { unsigned* ctl = (unsigned*)(F.ws() + WS_CTL); __syncthreads(); if (F.tid == 0) __hip_atomic_fetch_add(ctl + CW_DONE, 1u, __ATOMIC_RELAXED, __HIP_MEMORY_SCOPE_AGENT); w8_help(F, ctl + CW_W8NEXT, ctl + CW_DONE); }
                }
            } else if (k == 1) phase_mixers(F, l);
            else if (k == 2) phase_combine_norm(F, l);
            else if (k == 3) {
                pg8::Gemm g{(const bf16_t*)(F.ws() + WS_Y), (const bf16_t*)(F.ws() + WS_WOUT) + (size_t)l * DM * DM, DM, 0}; pg8::StaticOrder S; S.init(TOK, DM, F.G, F.bid);
                { pg8::EpiRes<true> E{F.ws() + (l == 0 ? WS_XN : WS_X2), (bf16_t*)(F.ws() + WS_X1)}; pg8::gemm_phase<pg8::EpiRes<true>, pg8::StaticOrder, false, true>(F.lds, F.tid, g, S, E); }
            } else if (k == 4) { if (l == 1) w8_help(F, (unsigned*)(F.ws() + WS_CTL) + CW_W8NEXT, nullptr, W8_Q_DN0 + W8_GU_STEPS); phase_router(F, l); }
            else if (k == 5) {
                LAS int* tstart = moe_tile_table(F, l);
                pg8::MoeOrder S{tstart, 8, 4, F.G, vcu};
                LAS int* gtok = (LAS int*)(F.lds + MISC_OFF + 4096);
                { const int* elist = (const int*)(F.ws() + WS_ELIST); int tkv[9];
#pragma unroll
                  for (int i = 0; i < 9; ++i) { pg8::Unit u; const bool ok = S.next(i, u); const int ee = ok ? u.e : 0, idx = ok ? (u.pm - tstart[ee]) * 256 + (F.tid & 255) : 0;
                      const int tk = elist[(size_t)ee * TOK + idx]; tkv[i] = (ok && idx < tstart[80 + ee]) ? tk : 0; }
                  if (F.tid < 256) {
#pragma unroll
                      for (int i = 0; i < 9; ++i) gtok[i * 256 + F.tid] = tkv[i]; }
                  __syncthreads(); }
                pg8::Gemm g{(const bf16_t*)(F.ws() + WS_H2), (const bf16_t*)(F.ws() + WS_WGU + (size_t)l * NE * 2048 * DM), DM, (size_t)2048 * DM, gtok};
                pg8::EpiSwiglu E{F.ws() + WS_ACT, F.in(IN_BGU) + (size_t)l * NE * 2048, 1.0f / W8SCALE};
                pg8::gemm_phase<pg8::EpiSwiglu, pg8::MoeOrder, true, true, true, true>(F.lds, F.tid, g, S, E);
                w8_help(F, (unsigned*)(F.ws() + WS_CTL) + CW_W8NEXT, nullptr, (l == 0) ? W8_Q_DN0 : W8_Q_TOTAL);
                if (l == 0) { unsigned* ctl = (unsigned*)(F.ws() + WS_CTL); __syncthreads(); if (F.tid == 0) __hip_atomic_fetch_add(ctl + CW_DONE + 64 * 5, 1u, __ATOMIC_RELAXED, __HIP_MEMORY_SCOPE_AGENT); w8_help(F, ctl + CW_W8NEXT, ctl + CW_DONE + 64 * 5); }
            } else if (k == 6) {
                LAS int* tstart = (ph - 1 >= lo) ? (LAS int*)(F.lds + MISC_OFF + 512) : moe_tile_table(F, l);
                pg8::Gemm g{(const bf16_t*)(F.ws() + WS_ACT), (const bf16_t*)(F.ws() + WS_WDN + (size_t)l * NE * DM * DM), DM, (size_t)DM * DM};
                pg8::MoeOrder S{tstart, 4, 8, F.G, vcu};
                pg8::EpiF8 E{F.ws() + WS_YS, DM, F.in(IN_BDN) + (size_t)l * NE * DM, DM, 1.0f / W8SCALE};
                pg8::gemm_phase<pg8::EpiF8, pg8::MoeOrder, true, true, true>(F.lds, F.tid, g, S, E);
                if (l == 0) { unsigned* ctl = (unsigned*)(F.ws() + WS_CTL); __syncthreads(); if (F.tid == 0) __hip_atomic_fetch_add(ctl + CW_DONE + 64 * 6, 1u, __ATOMIC_RELAXED, __HIP_MEMORY_SCOPE_AGENT); w8_help(F, ctl + CW_W8NEXT, ctl + CW_DONE + 64 * 6); }
            } else phase_moe_combine(F, l, ph - 2 >= lo);
        }
        if (ph + 1 < hi) { if (lo < 0) cg::this_grid().sync(); else { xbar.bar = (unsigned*)(F.ws() + WS_CTL) + CW_BAR; xcd_barrier(xbar, F.tid); } }
    }
}

extern "C" void kernel_launch(void* const* d_in, const int* in_sizes, int n_in, void* d_out, int out_size, void* d_ws, size_t ws_size, hipStream_t stream) {
    static int grid = 0;
    if (grid == 0) {
        if (n_in != 18 || in_sizes[0] != TOK * DM || out_size != TOK * DM || ws_size < WS_END) { fprintf(stderr, "kernel_launch: unexpected shapes / workspace (n_in %d, ws %zu)\n", n_in, ws_size); grid = -1; return; }
        int dev = 0, cus = 0, per_cu = 0;
        if (hipGetDevice(&dev) != hipSuccess || hipDeviceGetAttribute(&cus, hipDeviceAttributeMultiprocessorCount, dev) != hipSuccess) { grid = -1; return; }
        if (hipFuncSetAttribute((const void*)enc_fwd, hipFuncAttributeMaxDynamicSharedMemorySize, LDS_BYTES) != hipSuccess) { fprintf(stderr, "kernel_launch: hipFuncSetAttribute failed\n"); grid = -1; return; }
        if (hipOccupancyMaxActiveBlocksPerMultiprocessor(&per_cu, (const void*)enc_fwd, 512, LDS_BYTES) != hipSuccess || per_cu < 1) { fprintf(stderr, "kernel_launch: note: occupancy query says %d blocks/CU\n", per_cu); (void)hipGetLastError(); }
        grid = cus;
    }
    if (grid < 0) return;
    (void)hipMemsetAsync((char*)d_ws + WS_CTL, 0, CTL_BYTES, stream);
    Args a{};
    for (int i = 0; i < 18; ++i) a.in[i] = (const float*)d_in[i];
    a.out = (float*)d_out; a.ws = (unsigned char*)d_ws;
#if MK_ONE_LAUNCH
    a.ph_lo = 0; a.ph_hi = N_PHASES;
    void* kargs[] = {&a};
    hipError_t e = hipLaunchCooperativeKernel((const void*)enc_fwd, dim3(grid), dim3(512), kargs, LDS_BYTES, stream);
    if (e != hipSuccess) fprintf(stderr, "cooperative launch failed: %s (grid %d)\n", hipGetErrorString(e), grid);
#else
    for (int p = 0; p < N_PHASES; ++p) { a.ph_lo = p; a.ph_hi = p + 1; hipLaunchKernelGGL(enc_fwd, dim3(grid), dim3(512), LDS_BYTES, stream, a);
#ifdef PROBE_PH
        if (p == PROBE_PH) for (int r = 0; r < PROBE_REP; ++r) {
#ifdef PROBE_VARIANT
            a.ph_lo = PROBE_VARIANT; a.ph_hi = PROBE_VARIANT + 1;
#endif
            hipLaunchKernelGGL(enc_fwd, dim3(grid), dim3(512), LDS_BYTES, stream, a); }
#endif
    }
#endif
}
```
